# Optimizing an MI355X kernel written in HIP

```python
import jax, jax.numpy as jnp
from jax import lax
import numpy as np

D_MODEL = 2048
BATCH = 16
SEQ = 2048
DEPTH = 4

CHUNK = 64
N_EVEN = (DEPTH + 1) // 2
N_ODD = DEPTH // 2

SB_HEAD_DIM = 64
SB_WIDTH = D_MODEL // 2
SB_HEADS = SB_WIDTH // SB_HEAD_DIM
SB_BLOCK = 128

RW_HEAD_DIM = 64
RW_WIDTH = D_MODEL // 2
RW_HEADS = RW_WIDTH // RW_HEAD_DIM
DECAY_LORA = 64
ICL_LORA = 64
GATE_LORA = 160
LNX_EPS = 64e-5
RW_SHIFT_WIDTH = 3 * RW_WIDTH + DECAY_LORA + ICL_LORA + GATE_LORA

EVEN_IN_WIDTH = 3 * SB_WIDTH + RW_SHIFT_WIDTH
EVEN_OUT_WIDTH = SB_WIDTH + RW_WIDTH

SGU_WIDTH = D_MODEL
SGU_GROUPS = 8
SGU_BLOCK = 128
LN_EPS = 1e-5

FFN_HIDDEN = 4 * D_MODEL
RMS_EPS = 1e-6

kernel_name = "hybrid_stickbreak_rwkv7_sgu_stream_encoder"

F32 = jnp.float32


def rms_norm(x, g):
    x32 = x.astype(F32)
    y = x32 * lax.rsqrt(jnp.mean(x32 * x32, axis=-1, keepdims=True) + RMS_EPS)
    return (y * g.astype(F32)).astype(x.dtype)


def token_shift(z, mu):
    prev = jnp.pad(z[:, :-1], ((0, 0), (1, 0), (0, 0)))
    return z + (prev - z) * mu


def stick_breaking_attention(q, k, v):
    T, Dh = q.shape[2], q.shape[3]
    scale = Dh ** -0.5
    outs = []
    for blk in range(T // SB_BLOCK):
        q0 = blk * SB_BLOCK
        kv_len = q0 + SB_BLOCK
        qb = q[:, :, q0:kv_len].astype(F32)
        kb = k[:, :, :kv_len].astype(F32)
        vb = v[:, :, :kv_len].astype(F32)
        z = jnp.einsum('bhtd,bhsd->bhts', qb, kb) * scale
        t_pos = q0 + jnp.arange(SB_BLOCK)
        s_pos = jnp.arange(kv_len)
        visible = s_pos[None, :] < t_pos[:, None]
        log_keep = jnp.where(visible, jax.nn.log_sigmoid(-z), 0.0)
        tail = lax.cumsum(log_keep, axis=3, reverse=True)
        tail_excl = jnp.concatenate([tail[..., 1:], jnp.zeros_like(tail[..., :1])], axis=-1)
        w = jnp.where(visible, jnp.exp(jax.nn.log_sigmoid(z) + tail_excl), 0.0)
        outs.append(jnp.einsum('bhts,bhsd->bhtd', w, vb))
    return jnp.concatenate(outs, axis=2).astype(q.dtype)


def rwkv7_time_mix(zb, mu, w_up, w0, a_up, a0, g_up, k_k, k_a, r_k, lnx_w, lnx_b):
    B, T, _ = zb.shape
    zs = token_shift(zb, mu)
    idx = [RW_WIDTH, 2 * RW_WIDTH, 3 * RW_WIDTH, 3 * RW_WIDTH + DECAY_LORA,
           3 * RW_WIDTH + DECAY_LORA + ICL_LORA]
    r, k, v, xw, xa, xg = jnp.split(zs, idx, axis=-1)

    w_log = -jax.nn.softplus(-(w0 + jnp.tanh(xw) @ w_up).astype(F32)) - 0.5
    decay = jnp.exp(-jnp.exp(w_log))
    a = jax.nn.sigmoid((a0 + xa @ a_up).astype(F32))
    g = jax.nn.sigmoid(xg) @ g_up

    def heads(t):
        return t.reshape(B, T, RW_HEADS, RW_HEAD_DIM)

    r32 = r.astype(F32)
    k32 = k.astype(F32)
    v32 = heads(v.astype(F32))
    kk = heads(k32 * k_k.astype(F32))
    kk = kk / jnp.maximum(jnp.sqrt(jnp.sum(kk * kk, axis=-1, keepdims=True)), 1e-12)
    k_mod = heads(k32 * (1.0 + (a - 1.0) * k_a.astype(F32)))
    r_h = heads(r32)
    a_h = heads(a)
    w_h = heads(decay)

    def step(S, inp):
        r_t, w_t, k_t, v_t, kk_t, a_t = inp
        sa = jnp.einsum('bhvk,bhk->bhv', S, -kk_t)
        S = (S * w_t[:, :, None, :] + sa[..., None] * (kk_t * a_t)[:, :, None, :]
             + v_t[..., None] * k_t[:, :, None, :])
        y = jnp.einsum('bhvk,bhk->bhv', S, r_t)
        return S, y

    xs = tuple(jnp.moveaxis(t, 1, 0) for t in (r_h, w_h, k_mod, v32, kk, a_h))
    S0 = jnp.zeros((B, RW_HEADS, RW_HEAD_DIM, RW_HEAD_DIM), F32)
    _, y = lax.scan(step, S0, xs)
    y = jnp.moveaxis(y, 0, 1)

    mean = jnp.mean(y, axis=-1, keepdims=True)
    var = jnp.mean(jnp.square(y - mean), axis=-1, keepdims=True)
    y = ((y - mean) * lax.rsqrt(var + LNX_EPS)).reshape(B, T, RW_WIDTH)
    y = y * lnx_w.astype(F32) + lnx_b.astype(F32)
    bonus = jnp.sum(r_h * k_mod * r_k.astype(F32), axis=-1, keepdims=True) * v32
    y = (y + bonus.reshape(B, T, RW_WIDTH)) * g.astype(F32)
    return y.astype(zb.dtype)


def even_mixer(h, w_in, mu, w_up, w0, a_up, a0, g_up, k_k, k_a, r_k, lnx_w, lnx_b, w_out):
    B, T, _ = h.shape
    z = h @ w_in
    z_sb, z_rw = z[..., :3 * SB_WIDTH], z[..., 3 * SB_WIDTH:]
    q, k, v = jnp.split(z_sb, 3, axis=-1)

    def sb_heads(t):
        return t.reshape(B, T, SB_HEADS, SB_HEAD_DIM).transpose(0, 2, 1, 3)

    o_sb = stick_breaking_attention(sb_heads(q), sb_heads(k), sb_heads(v))
    o_sb = o_sb.transpose(0, 2, 1, 3).reshape(B, T, SB_WIDTH)
    o_rw = rwkv7_time_mix(z_rw, mu, w_up, w0, a_up, a0, g_up, k_k, k_a, r_k, lnx_w, lnx_b)
    return jnp.concatenate([o_sb.astype(h.dtype), o_rw.astype(h.dtype)], axis=-1) @ w_out


def odd_mixer(h, w_in, ln_g, ln_b, w_s, b_s, w_out):
    B, T, _ = h.shape
    zc = jax.nn.gelu(h @ w_in, approximate=False)
    u, v = jnp.split(zc, 2, axis=-1)
    v32 = v.astype(F32)
    mean = jnp.mean(v32, axis=-1, keepdims=True)
    var = jnp.mean(jnp.square(v32 - mean), axis=-1, keepdims=True)
    v32 = (v32 - mean) * lax.rsqrt(var + LN_EPS) * ln_g.astype(F32) + ln_b.astype(F32)
    nb = T // SGU_BLOCK
    v32 = v32.reshape(B, nb, SGU_BLOCK, SGU_GROUPS, SGU_WIDTH // SGU_GROUPS)
    chunk_id = jnp.arange(SGU_BLOCK) // CHUNK
    mask = chunk_id[None, :] <= chunk_id[:, None]
    ws = jnp.where(mask[None], w_s.astype(F32), 0.0)
    mixed = jnp.einsum('gts,bnsgc->bntgc', ws, v32) + b_s.astype(F32).T[None, None, :, :, None]
    y = u * mixed.reshape(B, T, SGU_WIDTH).astype(u.dtype)
    return y @ w_out


def squared_relu_mlp(h, w1, w2):
    return jnp.square(jax.nn.relu(h @ w1)) @ w2


def setup_inputs(seed: int = 0) -> dict:
    key = jax.random.key(seed)
    ks = jax.random.split(key, 32)
    n = jax.random.normal
    D = D_MODEL
    inp = {}
    inp["x"] = n(ks[0], (BATCH, SEQ, D), F32)
    inp["norm_mix"] = 1.0 + 0.02 * n(ks[1], (DEPTH, D), F32)
    inp["norm_ffn"] = 1.0 + 0.02 * n(ks[2], (DEPTH, D), F32)
    inp["norm_final"] = 1.0 + 0.02 * n(ks[3], (D,), F32)
    inp["even_w_in"] = n(ks[4], (N_EVEN, D, EVEN_IN_WIDTH), F32) * D ** -0.5
    inp["even_mu"] = jax.random.uniform(ks[5], (N_EVEN, RW_SHIFT_WIDTH), F32)
    inp["even_w_up"] = n(ks[6], (N_EVEN, DECAY_LORA, RW_WIDTH), F32) * 0.5 * DECAY_LORA ** -0.5
    inp["even_w0"] = 0.5 * n(ks[7], (N_EVEN, RW_WIDTH), F32)
    inp["even_a_up"] = n(ks[8], (N_EVEN, ICL_LORA, RW_WIDTH), F32) * ICL_LORA ** -0.5
    inp["even_a0"] = 0.1 * n(ks[9], (N_EVEN, RW_WIDTH), F32)
    inp["even_g_up"] = n(ks[10], (N_EVEN, GATE_LORA, RW_WIDTH), F32) * GATE_LORA ** -0.5
    inp["even_k_k"] = 0.85 + 0.02 * n(ks[11], (N_EVEN, RW_WIDTH), F32)
    inp["even_k_a"] = 1.0 + 0.02 * n(ks[12], (N_EVEN, RW_WIDTH), F32)
    inp["even_r_k"] = 0.1 * n(ks[13], (N_EVEN, RW_HEADS, RW_HEAD_DIM), F32)
    inp["even_lnx_w"] = 1.0 + 0.02 * n(ks[14], (N_EVEN, RW_WIDTH), F32)
    inp["even_lnx_b"] = 0.02 * n(ks[15], (N_EVEN, RW_WIDTH), F32)
    inp["even_w_out"] = n(ks[16], (N_EVEN, EVEN_OUT_WIDTH, D), F32) * EVEN_OUT_WIDTH ** -0.5
    inp["odd_w_in"] = n(ks[17], (N_ODD, D, 2 * SGU_WIDTH), F32) * D ** -0.5
    inp["odd_ln_g"] = 1.0 + 0.02 * n(ks[18], (N_ODD, SGU_WIDTH), F32)
    inp["odd_ln_b"] = 0.02 * n(ks[19], (N_ODD, SGU_WIDTH), F32)
    inp["odd_w_s"] = n(ks[20], (N_ODD, SGU_GROUPS, SGU_BLOCK, SGU_BLOCK), F32) * SGU_BLOCK ** -0.5
    inp["odd_b_s"] = 1.0 + 0.1 * n(ks[21], (N_ODD, SGU_GROUPS, SGU_BLOCK), F32)
    inp["odd_w_out"] = n(ks[22], (N_ODD, SGU_WIDTH, D), F32) * SGU_WIDTH ** -0.5
    inp["ffn_w1"] = n(ks[23], (DEPTH, D, FFN_HIDDEN), F32) * D ** -0.5
    inp["ffn_w2"] = n(ks[24], (DEPTH, FFN_HIDDEN, D), F32) * FFN_HIDDEN ** -0.5
    return inp


def reference(x, norm_mix, norm_ffn, norm_final,
              even_w_in, even_mu, even_w_up, even_w0, even_a_up, even_a0, even_g_up,
              even_k_k, even_k_a, even_r_k, even_lnx_w, even_lnx_b, even_w_out,
              odd_w_in, odd_ln_g, odd_ln_b, odd_w_s, odd_b_s, odd_w_out,
              ffn_w1, ffn_w2):
    for layer in range(DEPTH):
        i = layer // 2
        h = rms_norm(x, norm_mix[layer])
        if layer % 2 == 0:
            mix = even_mixer(h, even_w_in[i], even_mu[i], even_w_up[i], even_w0[i],
                             even_a_up[i], even_a0[i], even_g_up[i], even_k_k[i],
                             even_k_a[i], even_r_k[i], even_lnx_w[i], even_lnx_b[i],
                             even_w_out[i])
        else:
            mix = odd_mixer(h, odd_w_in[i], odd_ln_g[i], odd_ln_b[i], odd_w_s[i],
                            odd_b_s[i], odd_w_out[i])
        x = x + mix.astype(x.dtype)
        h = rms_norm(x, norm_ffn[layer])
        x = x + squared_relu_mlp(h, ffn_w1[layer], ffn_w2[layer]).astype(x.dtype)
    return rms_norm(x, norm_final)
```

```cpp
#include <hip/hip_runtime.h>
#include <cstdio>
#include <cstdint>
namespace pg8 {
#define PG8_LAS __attribute__((address_space(3)))
typedef unsigned short bf16_t;
typedef short bf16x8 __attribute__((ext_vector_type(8)));
typedef float f32x4 __attribute__((ext_vector_type(4)));
typedef unsigned u32x4 __attribute__((ext_vector_type(4)));
constexpr int BM = 256, BK = 64, HALF = 128, HTB = HALF * BK * 2  , STAGE_BYTES = 8 * HTB, NXCD = 8, WGM = 8;

__host__ __device__ __forceinline__ int lds_byte(int r, int c) { const int st = (r >> 4) * 2 + (c >> 5), rr = r & 15, cc = c & 31, ob = rr * 64 + cc * 2; return st * 1024 + (ob ^ (((ob >> 9) & 1) << 5)); }
__host__ __device__ __forceinline__ void stage_rc(int b, int& R, int& C) { const int st = b / 1024, sb = b % 1024, swz = sb ^ (((sb >> 9) & 1) << 5); R = (st >> 1) * 16 + swz / 64; C = (st & 1) * 32 + (swz % 64) / 2; }
__host__ __device__ __forceinline__ int perm32(int rho) { const int n = rho >> 4, i = rho & 15; return 8 * (i >> 2) + 4 * n + (i & 3); }

struct Unit { int pm, pn; };
struct Gemm { const bf16_t* A; const bf16_t* Bt; int M, N, K; };

struct StaticOrder {
    int nM, nN, nwg, G, c;
    __host__ __device__ void init(int M, int N, int G_, int c_) { nM = M / BM; nN = N / BM; nwg = nM * nN; G = G_; c = c_; }
    __host__ __device__ bool next(int i, Unit& u) const {
        const long L = (long)i * G + c; if (L >= nwg) return false;
        int wgid = (int)L; { const int q = nwg / NXCD, r = nwg % NXCD, xcd = wgid % NXCD, off = wgid / NXCD; wgid = (xcd < r ? xcd * (q + 1) : r * (q + 1) + (xcd - r) * q) + off; }
        const int nig = WGM * nN, gid = wgid / nig, fm = gid * WGM, gsz = (nM - fm) < WGM ? (nM - fm) : WGM;
        u.pm = fm + ((wgid % nig) % gsz); u.pn = (wgid % nig) / gsz; return true;
    }
    __device__ __forceinline__ void a_ready(const Unit&) const {}
    __device__ __forceinline__ void done(const Unit&) const {}
};

__device__ __forceinline__ unsigned cvt_pk_bf16(float lo, float hi) { unsigned r; asm volatile("v_cvt_pk_bf16_f32 %0, %1, %2" : "=v"(r) : "v"(lo), "v"(hi)); return r; }
typedef float f32x2 __attribute__((ext_vector_type(2)));
__device__ __forceinline__ f32x2 gelu_pk(f32x2 v) {
    const f32x2 av = __builtin_elementwise_abs(v), d = av * 0.2316418882f + 1.0f;
    f32x2 t; t.x = __builtin_amdgcn_rcpf(d.x); t.y = __builtin_amdgcn_rcpf(d.y);
    f32x2 q = t * 0.5307027145f + (-0.7265760135f); q = q * t + 0.7107068705f; q = q * t + (-0.142248368f); q = q * t + 0.127414796f; q = q * t;
    const f32x2 s = (v * v) * (-0.72134752044f);
    f32x2 e; e.x = __builtin_amdgcn_exp2f(s.x); e.y = __builtin_amdgcn_exp2f(s.y);
    const f32x2 m = v * (q * e), r = v - m;
    f32x2 o; o.x = v.x < 0.f ? m.x : r.x; o.y = v.y < 0.f ? m.y : r.y; return o;
}
template <int ACT> struct EpiAct {
    static constexpr bool PERM = true, AFTER_DRAIN = false;
    bf16_t* O; int ldc; int nscale; float scale0;
    __device__ __forceinline__ void operator()(const f32x4 (&acc)[2][2][4][2], const Unit& u, int wr, int wc, int fr, int fq) const {
        const int row0 = u.pm * BM + wr * 64 + fr; const int col0 = u.pn * BM + wc * 32 + 8 * fq;
        const float sc = (u.pn < nscale) ? scale0 : 1.f;
#pragma unroll
        for (int ai = 0; ai < 2; ++ai)
#pragma unroll
            for (int m = 0; m < 4; ++m) { bf16_t* rowp = O + (size_t)(row0 + ai * HALF + m * 16) * ldc + col0;
#pragma unroll
                for (int bj = 0; bj < 2; ++bj) { f32x4 v0 = acc[ai][bj][m][0], v1 = acc[ai][bj][m][1];
                    if (ACT == 1) { f32x2 a = gelu_pk((f32x2){v0[0], v0[1]}), b = gelu_pk((f32x2){v0[2], v0[3]}), c = gelu_pk((f32x2){v1[0], v1[1]}), d = gelu_pk((f32x2){v1[2], v1[3]});
                        v0 = (f32x4){a.x, a.y, b.x, b.y}; v1 = (f32x4){c.x, c.y, d.x, d.y}; }
                    if (ACT == 2) { const f32x4 z = {0.f, 0.f, 0.f, 0.f}; v0 = __builtin_elementwise_max(v0, z); v1 = __builtin_elementwise_max(v1, z); v0 = v0 * v0; v1 = v1 * v1; }
                    v0 = v0 * sc; v1 = v1 * sc; u32x4 w; w.x = cvt_pk_bf16(v0[0], v0[1]); w.y = cvt_pk_bf16(v0[2], v0[3]); w.z = cvt_pk_bf16(v1[0], v1[1]); w.w = cvt_pk_bf16(v1[2], v1[3]);
                    *(u32x4*)(rowp + bj * HALF) = w; } }
    }
};
struct EpiResid {
    static constexpr bool PERM = false, AFTER_DRAIN = false;
    const float* base; float* out; int ldc;
    __device__ __forceinline__ void operator()(const f32x4 (&acc)[2][2][4][2], const Unit& u, int wr, int wc, int fr, int fq) const {
        const int col0 = u.pn * BM + wc * 32 + 4 * fq;
#pragma unroll
        for (int ai = 0; ai < 2; ++ai)
#pragma unroll
            for (int m = 0; m < 4; ++m) { const size_t off = (size_t)(u.pm * BM + ai * HALF + wr * 64 + m * 16 + fr) * ldc + col0;
                f32x4 bs[2][2];
#pragma unroll
                for (int bj = 0; bj < 2; ++bj)
#pragma unroll
                    for (int n = 0; n < 2; ++n) bs[bj][n] = *(const f32x4*)(base + off + bj * HALF + n * 16);
#pragma unroll
                for (int bj = 0; bj < 2; ++bj)
#pragma unroll
                    for (int n = 0; n < 2; ++n) *(f32x4*)(out + off + bj * HALF + n * 16) = bs[bj][n] + acc[ai][bj][m][n];
                if (m & 1) asm volatile("" ::: "memory"); }
    }
};
template <class Epi, class Sched, bool ALIGN_EPI = false, bool SP2 = false>
__device__ __forceinline__ void gemm_phase(PG8_LAS unsigned char* lds, const Gemm g, const Sched& S, const Epi& E) {
    int tid_ = threadIdx.x; const bf16_t* gA_ = g.A; const bf16_t* gB_ = g.Bt; asm volatile("" : "+v"(tid_), "+s"(gA_), "+s"(gB_));
    const int tid = tid_, wid = __builtin_amdgcn_readfirstlane(tid >> 6), lane = tid & 63, wr = wid >> 2, wc = wid & 3, fr = lane & 15, fq = lane >> 4;
    const int K = g.K, nt = K / BK;
    unsigned voffA[2], voffB[2];
#pragma unroll
    for (int i = 0; i < 2; ++i) { int R, C; stage_rc(tid * 16 + i * 8192, R, C); const int Rb = Epi::PERM ? ((R & ~31) + perm32(R & 31)) : R;
        voffA[i] = (unsigned)(R * K + C) * 2u; voffB[i] = (unsigned)(Rb * K + C) * 2u; }
    const size_t kstep = (size_t)(BK * 2);
    const size_t hstep = (size_t)HALF * K * 2;
    const size_t tstep = 2 * hstep;
    const unsigned ldsw = (unsigned)wid * 1024u;
    const int aoff = lds_byte(wr * 64 + fr, fq * 8), boff = lds_byte(wc * 32 + fr, fq * 8);
#define PG8_SA(b, h) (((b) * 2 + (h)) * HTB)
#define PG8_SB(b, h) ((4 + (b) * 2 + (h)) * HTB)
#define PG8_STAGE(bufoff, gbase, voff) do { _Pragma("unroll") for (int _i = 0; _i < 2; ++_i) \
        __builtin_amdgcn_global_load_lds((const unsigned*)((const char*)(gbase) + (voff)[_i]), (PG8_LAS unsigned*)(lds + (bufoff) + ldsw + _i * 8192), 16, 0, 0); } while (0)
#define PG8_LDA(dst, b, h) do { _Pragma("unroll") for (int m = 0; m < 4; ++m) _Pragma("unroll") for (int k = 0; k < 2; ++k) dst[m][k] = *(const PG8_LAS bf16x8*)(lds + PG8_SA(b, h) + aoff + m * 2048 + k * 1024); } while (0)
#define PG8_LDB(dst, b, h) do { _Pragma("unroll") for (int n = 0; n < 2; ++n) _Pragma("unroll") for (int k = 0; k < 2; ++k) dst[n][k] = *(const PG8_LAS bf16x8*)(lds + PG8_SB(b, h) + boff + n * 2048 + k * 1024); } while (0)
#define PG8_MMA(ai, bj, At, Bt) do { __builtin_amdgcn_s_setprio(1); _Pragma("unroll") for (int m = 0; m < 4; ++m) _Pragma("unroll") for (int n = 0; n < 2; ++n) _Pragma("unroll") for (int k = 0; k < 2; ++k) \
        acc[ai][bj][m][n] = __builtin_amdgcn_mfma_f32_16x16x32_bf16(Bt[n][k], At[m][k], acc[ai][bj][m][n], 0, 0, 0); __builtin_amdgcn_s_setprio(0); } while (0)
#define PG8_WAIT_V(n) asm volatile("s_waitcnt vmcnt(" #n ")" ::: "memory")
#define PG8_WAIT_L(n) asm volatile("s_waitcnt lgkmcnt(" #n ")" ::: "memory")
#define PG8_BAR __builtin_amdgcn_s_barrier()
#define PG8_SCHED __builtin_amdgcn_sched_barrier(0)
    Unit cur, nxt; int ui = 0;
    if (!S.next(0, cur)) return;
    f32x4 acc[2][2][4][2];
#pragma unroll
    for (int a = 0; a < 2; ++a)
#pragma unroll
        for (int b = 0; b < 2; ++b)
#pragma unroll
            for (int m = 0; m < 4; ++m)
#pragma unroll
                for (int n = 0; n < 2; ++n) acc[a][b][m][n] = (f32x4){0.f, 0.f, 0.f, 0.f};
    bf16x8 At[4][2], B0[2][2], B1[2][2];
    const char* cA = (const char*)gA_ + (size_t)cur.pm * tstep; const char* cB = (const char*)gB_ + (size_t)cur.pn * tstep;
    S.a_ready(cur);
    if constexpr (SP2) {
        PG8_STAGE(PG8_SB(0, 0), cB, voffB); PG8_STAGE(PG8_SB(0, 1), cB + hstep, voffB); PG8_STAGE(PG8_SA(0, 0), cA, voffA); PG8_STAGE(PG8_SA(0, 1), cA + hstep, voffA);
        if (wr == 1) PG8_BAR;
        PG8_WAIT_V(2); PG8_BAR;
        PG8_STAGE(PG8_SB(1, 0), cB + kstep, voffB); PG8_STAGE(PG8_SA(1, 0), cA + kstep, voffA); PG8_STAGE(PG8_SB(1, 1), cB + hstep + kstep, voffB);
        PG8_WAIT_V(6); PG8_BAR;
    } else {
        PG8_STAGE(PG8_SB(0, 0), cB, voffB); PG8_STAGE(PG8_SA(0, 0), cA, voffA); PG8_STAGE(PG8_SB(0, 1), cB + hstep, voffB); PG8_STAGE(PG8_SA(0, 1), cA + hstep, voffA);
        if (wr == 1) PG8_BAR;
        PG8_WAIT_V(4); PG8_BAR;
        PG8_STAGE(PG8_SB(1, 0), cB + kstep, voffB); PG8_STAGE(PG8_SA(1, 0), cA + kstep, voffA); PG8_STAGE(PG8_SB(1, 1), cB + hstep + kstep, voffB);
        PG8_WAIT_V(6); PG8_BAR;
    }
    for (;;) {
        const bool has_next = S.next(ui + 1, nxt);
        const char* nA = has_next ? (const char*)gA_ + (size_t)nxt.pm * tstep : cA; const char* nB = has_next ? (const char*)gB_ + (size_t)nxt.pn * tstep : cB;
        for (int t = 0; t < nt; t += 2) {
            const bool last = (t == nt - 2);
            const char* a1 = cA + (size_t)(t + 1) * kstep;
            const char* a2 = last ? nA : cA + (size_t)(t + 2) * kstep; const char* b2 = last ? nB : cB + (size_t)(t + 2) * kstep;
            const char* a3 = a2 + kstep; const char* b3 = b2 + kstep;
            if (last && has_next) S.a_ready(nxt);
            if constexpr (SP2) {
            PG8_LDB(B0, 0, 0); PG8_LDB(B1, 0, 1); PG8_SCHED; PG8_LDA(At, 0, 0); PG8_STAGE(PG8_SA(1, 1), a1 + hstep, voffA);
            PG8_WAIT_V(8); PG8_WAIT_L(0); PG8_BAR; PG8_MMA(0, 0, At, B0); PG8_MMA(0, 1, At, B1); PG8_BAR; PG8_SCHED;
            PG8_LDA(At, 0, 1); PG8_STAGE(PG8_SB(0, 0), b2, voffB); PG8_STAGE(PG8_SB(0, 1), b2 + hstep, voffB); PG8_STAGE(PG8_SA(0, 0), a2, voffA);
            PG8_WAIT_V(8); PG8_WAIT_L(0); PG8_BAR; PG8_MMA(1, 0, At, B0); PG8_MMA(1, 1, At, B1); PG8_BAR; PG8_SCHED;
            PG8_LDB(B0, 1, 0); PG8_LDB(B1, 1, 1); PG8_SCHED; PG8_LDA(At, 1, 0); PG8_STAGE(PG8_SA(0, 1), a2 + hstep, voffA);
            PG8_WAIT_V(8); PG8_WAIT_L(0); PG8_BAR; PG8_MMA(0, 0, At, B0); PG8_MMA(0, 1, At, B1); PG8_BAR; PG8_SCHED;
            PG8_LDA(At, 1, 1); PG8_STAGE(PG8_SB(1, 0), b3, voffB); PG8_STAGE(PG8_SB(1, 1), b3 + hstep, voffB); PG8_STAGE(PG8_SA(1, 0), a3, voffA);
            PG8_WAIT_V(8); PG8_WAIT_L(0); PG8_BAR; PG8_MMA(1, 0, At, B0); PG8_MMA(1, 1, At, B1); PG8_BAR; PG8_SCHED;
            } else {
            PG8_LDB(B0, 0, 0); PG8_SCHED; PG8_LDA(At, 0, 0); PG8_STAGE(PG8_SA(1, 1), a1 + hstep, voffA);
            PG8_WAIT_L(8); PG8_BAR; PG8_WAIT_L(0); PG8_MMA(0, 0, At, B0); PG8_BAR; PG8_SCHED;
            PG8_LDB(B1, 0, 1); PG8_STAGE(PG8_SB(0, 0), b2, voffB);
            PG8_BAR; PG8_WAIT_L(0); PG8_MMA(0, 1, At, B1); PG8_BAR;
            PG8_LDA(At, 0, 1); PG8_STAGE(PG8_SA(0, 0), a2, voffA);
            PG8_BAR; PG8_WAIT_L(0); PG8_MMA(1, 0, At, B0); PG8_BAR; PG8_SCHED;
            PG8_STAGE(PG8_SB(0, 1), b2 + hstep, voffB);
            PG8_WAIT_V(6); PG8_BAR; PG8_MMA(1, 1, At, B1); PG8_BAR;
            PG8_LDB(B0, 1, 0); PG8_SCHED; PG8_LDA(At, 1, 0); PG8_STAGE(PG8_SA(0, 1), a2 + hstep, voffA);
            PG8_WAIT_L(8); PG8_BAR; PG8_WAIT_L(0); PG8_MMA(0, 0, At, B0); PG8_BAR; PG8_SCHED;
            PG8_LDB(B1, 1, 1); PG8_STAGE(PG8_SB(1, 0), b3, voffB);
            PG8_BAR; PG8_WAIT_L(0); PG8_MMA(0, 1, At, B1); PG8_BAR;
            PG8_LDA(At, 1, 1); PG8_STAGE(PG8_SA(1, 0), a3, voffA);
            PG8_BAR; PG8_WAIT_L(0); PG8_MMA(1, 0, At, B0); PG8_BAR; PG8_SCHED;
            PG8_STAGE(PG8_SB(1, 1), b3 + hstep, voffB);
            PG8_WAIT_V(6); PG8_BAR; PG8_MMA(1, 1, At, B1); PG8_BAR;
            }
        }
        if constexpr (ALIGN_EPI) { if (wr == 0) PG8_BAR; }
        if constexpr (!Epi::AFTER_DRAIN) { E(acc, cur, wr, wc, fr, fq); S.done(cur); }
        if (!has_next) break;
#pragma unroll
        for (int a = 0; a < 2; ++a)
#pragma unroll
            for (int b = 0; b < 2; ++b)
#pragma unroll
                for (int m = 0; m < 4; ++m)
#pragma unroll
                    for (int n = 0; n < 2; ++n) acc[a][b][m][n] = (f32x4){0.f, 0.f, 0.f, 0.f};
        cur = nxt; cA = nA; cB = nB; ++ui;
        if constexpr (ALIGN_EPI) { if (wr == 1) PG8_BAR; }
    }
    PG8_WAIT_V(0);
    if constexpr (!ALIGN_EPI) { if (wr == 0) PG8_BAR; }
    PG8_BAR;
    if constexpr (Epi::AFTER_DRAIN) { E.fused(acc, cur, wr, wc, fr, fq, lds, wid, lane); S.done(cur); }
#undef PG8_SA
#undef PG8_SB
#undef PG8_STAGE
#undef PG8_LDA
#undef PG8_LDB
#undef PG8_MMA
#undef PG8_WAIT_V
#undef PG8_WAIT_L
#undef PG8_BAR
#undef PG8_SCHED
}
}
#define GAS __attribute__((address_space(1)))
#define LAS __attribute__((address_space(3)))
typedef unsigned short bf16;
typedef unsigned v4u __attribute__((ext_vector_type(4)));
typedef float f32x4 __attribute__((ext_vector_type(4)));
typedef short bf16x8 __attribute__((ext_vector_type(8)));
typedef GAS unsigned gu32;
typedef GAS unsigned long long gu64;
#define RLX_AGENT __ATOMIC_RELAXED, __HIP_MEMORY_SCOPE_AGENT
#define LDS_WAIT() asm volatile("s_waitcnt lgkmcnt(0)" ::: "memory")
#define VM_WAIT() asm volatile("s_waitcnt vmcnt(0)" ::: "memory")
__device__ __forceinline__ unsigned long long rt() { return __builtin_amdgcn_s_memrealtime(); }
__device__ __forceinline__ unsigned f2bf(float f) { unsigned u = __builtin_bit_cast(unsigned, f); return (u + 0x7fffu + ((u >> 16) & 1u)) >> 16; }
__device__ __forceinline__ unsigned pk2(float lo, float hi) { return f2bf(lo) | (f2bf(hi) << 16); }

#define XB_TMO      128
#define XB_XCNT(j)  (256  + 64 * (j))
#define XB_XSUB(j)  (1280 + 64 * (j))
#define XB_XGEN(j)  (2304 + 64 * (j))
#define XB_TOP      3328
#define XB_TOPGEN   3392
#define XCD_BAR_WORDS 3456
#define XB_SPIN_CAP (1u << 18)

__device__ __forceinline__ unsigned xb_ld(unsigned* p)              { return __hip_atomic_load(p, __ATOMIC_RELAXED, __HIP_MEMORY_SCOPE_AGENT); }
__device__ __forceinline__ unsigned xb_add(unsigned* p, unsigned v) { return __hip_atomic_fetch_add(p, v, __ATOMIC_RELAXED, __HIP_MEMORY_SCOPE_AGENT); }
__device__ __forceinline__ unsigned xb_xcc_id() { return (unsigned)__builtin_amdgcn_s_getreg((3 << 11) | 20) & 0xFu; }
#define XB_SPIN(cond, bar) do { unsigned _sp = 0; while (cond) { __builtin_amdgcn_s_sleep(1); \
    if ((++_sp & 255u) == 0u) { if (xb_ld(&(bar)[XB_TMO])) break; if (_sp > XB_SPIN_CAP) { atomicAdd(&(bar)[XB_TMO], 1u); break; } } } } while (0)

struct XcdBarrier {
    unsigned* bar; unsigned x;
    volatile LAS unsigned* st;
};

__device__ __forceinline__ XcdBarrier xcd_barrier_post(unsigned* bar, volatile LAS unsigned* st) {
    XcdBarrier b; b.bar = bar; b.x = xb_xcc_id(); b.st = st;
    if (threadIdx.x == 0) (void)xb_add(&bar[XB_XCNT(b.x)], 1u);
    return b;
}
__device__ __forceinline__ void xcd_barrier_complete(unsigned* bar, unsigned x, unsigned& nloc, unsigned& nx) {
    const unsigned G = gridDim.x * gridDim.y * gridDim.z;
    unsigned sum, cnt, mine, sp = 0u;
    for (;;) {
        sum = 0u; cnt = 0u; mine = 0u;
#pragma unroll
        for (unsigned j = 0; j < 16; ++j) { const unsigned c = xb_ld(&bar[XB_XCNT(j)]); sum += c; cnt += (c > 0u) ? 1u : 0u; mine = (j == x) ? c : mine; }
        if (sum == G) break;
        __builtin_amdgcn_s_sleep(1);
        if ((++sp & 255u) == 0u) { if (xb_ld(&bar[XB_TMO])) break; if (sp > XB_SPIN_CAP) { atomicAdd(&bar[XB_TMO], 1u); break; } }
    }
    nloc = mine > 0u ? mine : 1u; nx = cnt > 0u ? cnt : 1u;
}

__device__ __forceinline__ void xcd_barrier(const XcdBarrier& b) {
    asm volatile("s_waitcnt vmcnt(0)" ::: "memory");
    __syncthreads();
    if (threadIdx.x == 0) {
        unsigned* bar = b.bar;
        __builtin_amdgcn_s_waitcnt(0);
        unsigned nloc = b.st[0], nx = b.st[1];
        if (nloc == 0u) { xcd_barrier_complete(bar, b.x, nloc, nx); b.st[0] = nloc; b.st[1] = nx; }
        const unsigned old = xb_add(&bar[XB_XSUB(b.x)], 1u);
        const unsigned gen = old / nloc;
        if (old + 1u == (gen + 1u) * nloc) {
            __builtin_amdgcn_fence(__ATOMIC_RELEASE, "agent");
            asm volatile("s_waitcnt vmcnt(0)" ::: "memory");
            const unsigned og = xb_add(&bar[XB_TOP], 1u);
            const unsigned tg = og / nx;
            if (og + 1u == (tg + 1u) * nx) xb_add(&bar[XB_TOPGEN], 1u);
            else XB_SPIN(xb_ld(&bar[XB_TOPGEN]) == tg, bar);
            __builtin_amdgcn_fence(__ATOMIC_ACQUIRE, "agent");
            xb_add(&bar[XB_XGEN(b.x)], 1u);
            asm volatile("s_waitcnt vmcnt(0)" ::: "memory");
        } else {
            XB_SPIN(xb_ld(&bar[XB_XGEN(b.x)]) == gen, bar);
            __builtin_amdgcn_fence(__ATOMIC_ACQUIRE, "agent");
            asm volatile("s_waitcnt vmcnt(0)" ::: "memory");
        }
    }
    __syncthreads();
}
__device__ __forceinline__ float wave_sum(float v) {
#pragma unroll
    for (int o = 1; o < 64; o <<= 1) v += __shfl_xor(v, o);
    return v;
}
__device__ __forceinline__ void p0_transpose_item(const float* W, int K, int N, bf16* WT, int row_off, LAS float* scr, int item, int lane) {
    const int nblk = N / 32, kb = item / nblk, nb = item % nblk, k0 = 64 * kb, n0 = 32 * nb;
#pragma unroll 8
    for (int i = 0; i < 32; ++i) { const int kk = 2 * i + (lane >> 5); scr[kk * 33 + (lane & 31)] = W[(size_t)(k0 + kk) * N + n0 + (lane & 31)]; }
    LDS_WAIT(); asm volatile("" ::: "memory");
    const int c = lane & 7;
#pragma unroll
    for (int j = 0; j < 4; ++j) { const int n = (lane >> 3) + 8 * j; const LAS float* s = scr + (8 * c) * 33 + n;
        v4u o; o.x = pk2(s[0 * 33], s[1 * 33]); o.y = pk2(s[2 * 33], s[3 * 33]); o.z = pk2(s[4 * 33], s[5 * 33]); o.w = pk2(s[6 * 33], s[7 * 33]);
        *(GAS v4u*)(WT + (size_t)(row_off + n0 + n) * K + k0 + 8 * c) = o; }
    LDS_WAIT(); asm volatile("" ::: "memory");
}
constexpr int NWAVES = 8;
constexpr int BATCH = 16, T = 2048, D = 2048, M = BATCH * T, DEPTH = 4, FF = 8192;
constexpr int EVEN_N = 6432, ZP = 6656;
constexpr int ZC_Q = 0, ZC_K = 1024, ZC_V = 2048, ZC_R = 3072, ZC_RK = 4096, ZC_RV = 5120, ZC_XW = 6144, ZC_XA = 6208, ZC_XG = 6272;
constexpr int RWS = 3360;
constexpr int NPH = 33;

constexpr size_t MiB = 1u << 20;
constexpr size_t WS_CTL = 0, CTL_ZERO_BYTES = 1 * MiB;
constexpr size_t WS_WA = 2 * MiB;
constexpr size_t WS_WB = 28 * MiB;
constexpr size_t WS_W1 = 36 * MiB;
constexpr size_t WS_W2 = 68 * MiB;
constexpr size_t WS_ST = 100 * MiB;
constexpr size_t WS_H = 104 * MiB;
constexpr size_t WS_BIG = 232 * MiB;
constexpr size_t WS_END = 744 * MiB;
constexpr int CW_BAR = 4096;

constexpr int RING_BYTES = 131072, LDSCTL_OFF = RING_BYTES, MISC_OFF = LDSCTL_OFF + 320, LDS_BYTES = 147456;

struct Args { const float* in[25]; float* out; unsigned char* ws; int ph_lo, ph_hi; };

__device__ __forceinline__ float bf2f(bf16 h) { return __uint_as_float((unsigned)h << 16); }
__device__ __forceinline__ float bflo(unsigned w) { return __uint_as_float(w << 16); }
__device__ __forceinline__ float bfhi(unsigned w) { return __uint_as_float(w & 0xffff0000u); }

__device__ __forceinline__ void rms_row_bf16(const float* xrow, const float* g, bf16* orow, int lane) {
    const GAS f32x4* xr = (const GAS f32x4*)xrow + lane; const GAS f32x4* gr = (const GAS f32x4*)g + lane;
    f32x4 v[8]; float s = 0.f;
#pragma unroll
    for (int j = 0; j < 8; ++j) { v[j] = xr[64 * j]; s += (v[j].x * v[j].x + v[j].y * v[j].y) + (v[j].z * v[j].z + v[j].w * v[j].w); }
    const float r = 1.0f / sqrtf(wave_sum(s) * (1.f / D) + 1e-6f);
    GAS unsigned long long* o8 = (GAS unsigned long long*)orow + lane;
#pragma unroll
    for (int j = 0; j < 8; ++j) { const f32x4 gv = gr[64 * j];
        o8[64 * j] = (unsigned long long)pk2(v[j].x * r * gv.x, v[j].y * r * gv.y) | ((unsigned long long)pk2(v[j].z * r * gv.z, v[j].w * r * gv.w) << 32); }
}
__device__ __forceinline__ void rms_row_f32(float* xrow, const float* g, int lane) {
    GAS f32x4* xr = (GAS f32x4*)xrow + lane; const GAS f32x4* gr = (const GAS f32x4*)g + lane;
    f32x4 v[8]; float s = 0.f;
#pragma unroll
    for (int j = 0; j < 8; ++j) { v[j] = xr[64 * j]; s += (v[j].x * v[j].x + v[j].y * v[j].y) + (v[j].z * v[j].z + v[j].w * v[j].w); }
    const float r = 1.0f / sqrtf(wave_sum(s) * (1.f / D) + 1e-6f);
#pragma unroll
    for (int j = 0; j < 8; ++j) { const f32x4 gv = gr[64 * j]; xr[64 * j] = v[j] * r * gv; }
}

__device__ __forceinline__ void prep_phase(const float* Win, int Nin, const float* Wout, const float* w1, const float* w2, const float* xc, const float* g, unsigned char* ws, bool even, LAS unsigned char* lds, int wave, int lane, int tid, int G) {
    LAS float* scr = (LAS float*)(lds + wave * 16384);
    const int gw = blockIdx.x * NWAVES + wave, NGW = G * NWAVES;
    bf16* WA = (bf16*)(ws + WS_WA); bf16* WB = (bf16*)(ws + WS_WB); bf16* W1 = (bf16*)(ws + WS_W1); bf16* W2 = (bf16*)(ws + WS_W2);
    const int I_in = (D / 64) * (Nin / 32), I_out = (D / 64) * (D / 32), I_1 = (D / 64) * (FF / 32), I_2 = (FF / 64) * (D / 32);
    const int total = I_in + I_out + I_1 + I_2;
    for (int it = gw; it < total; it += NGW) {
        int r = it;
        if (r < I_in) { p0_transpose_item(Win, D, Nin, WA, 0, scr, r, lane); continue; } r -= I_in;
        if (r < I_out) { p0_transpose_item(Wout, D, D, WB, 0, scr, r, lane); continue; } r -= I_out;
        if (r < I_1) { p0_transpose_item(w1, D, FF, W1, 0, scr, r, lane); continue; } r -= I_1;
        p0_transpose_item(w2, FF, D, W2, 0, scr, r, lane);
    }
    if (even) {
        GAS v4u* p = (GAS v4u*)(WA + (size_t)EVEN_N * D); const int n16 = (ZP - EVEN_N) * D * 2 / 16;
        for (int k = blockIdx.x * (NWAVES * 64) + tid; k < n16; k += G * NWAVES * 64) p[k] = (v4u){0u, 0u, 0u, 0u};
    }
    bf16* H = (bf16*)(ws + WS_H);
    for (int m = gw; m < M; m += NGW) rms_row_bf16(xc + (size_t)m * D, g, H + (size_t)m * D, lane);
}

__device__ __forceinline__ void attn_naive_phase(const bf16* Z, bf16* O, int wave, int lane, int G) {
    const int gw = __builtin_amdgcn_readfirstlane(blockIdx.x * NWAVES + wave), NW = G * NWAVES;
    for (int u = gw; u < BATCH * 16 * 32; u += NW) {
        const int bh = u >> 5, qbi = u & 31, rnd = (bh * 32) / NW; const int qb = (rnd & 1) ? 31 - qbi : qbi;
        const int b = bh >> 4, h = bh & 15, t = qb * 64 + lane;
        const bf16* qrow = Z + (size_t)(b * T + t) * ZP + ZC_Q + h * 64;
        float q[64], o[64];
#pragma unroll
        for (int c = 0; c < 8; ++c) { const v4u w = ((const GAS v4u*)qrow)[c];
            q[8 * c + 0] = bflo(w.x); q[8 * c + 1] = bfhi(w.x); q[8 * c + 2] = bflo(w.y); q[8 * c + 3] = bfhi(w.y); q[8 * c + 4] = bflo(w.z); q[8 * c + 5] = bfhi(w.z); q[8 * c + 6] = bflo(w.w); q[8 * c + 7] = bfhi(w.w); }
#pragma unroll
        for (int d = 0; d < 64; ++d) o[d] = 0.f;
        float R = 0.f;
        for (int s = qb * 64 + 62; s >= 0; --s) {
            const bf16* krow = Z + (size_t)(b * T + s) * ZP + ZC_K + h * 64; const bf16* vrow = krow + (ZC_V - ZC_K);
            float dot = 0.f;
#pragma unroll
            for (int c = 0; c < 8; ++c) { const v4u w = ((const GAS v4u*)krow)[c];
                dot += q[8 * c + 0] * bflo(w.x) + q[8 * c + 1] * bfhi(w.x) + q[8 * c + 2] * bflo(w.y) + q[8 * c + 3] * bfhi(w.y) + q[8 * c + 4] * bflo(w.z) + q[8 * c + 5] * bfhi(w.z) + q[8 * c + 6] * bflo(w.w) + q[8 * c + 7] * bfhi(w.w); }
            const float z = dot * 0.125f;
            const float lsp = fminf(z, 0.f) - log1pf(expf(-fabsf(z)));
            const float lsn = lsp - z;
            const bool vis = s < t;
            const float w = vis ? expf(lsp + R) : 0.f;
            R += vis ? lsn : 0.f;
#pragma unroll
            for (int c = 0; c < 8; ++c) { const v4u vw = ((const GAS v4u*)vrow)[c];
                o[8 * c + 0] += w * bflo(vw.x); o[8 * c + 1] += w * bfhi(vw.x); o[8 * c + 2] += w * bflo(vw.y); o[8 * c + 3] += w * bfhi(vw.y); o[8 * c + 4] += w * bflo(vw.z); o[8 * c + 5] += w * bfhi(vw.z); o[8 * c + 6] += w * bflo(vw.w); o[8 * c + 7] += w * bfhi(vw.w); }
        }
        bf16* orow = O + (size_t)(b * T + t) * D + h * 64;
#pragma unroll
        for (int c = 0; c < 8; ++c) { v4u w; w.x = pk2(o[8 * c + 0], o[8 * c + 1]); w.y = pk2(o[8 * c + 2], o[8 * c + 3]); w.z = pk2(o[8 * c + 4], o[8 * c + 5]); w.w = pk2(o[8 * c + 6], o[8 * c + 7]); ((GAS v4u*)orow)[c] = w; }
    }
}

__device__ __forceinline__ float rl(float x, int j) { return __int_as_float(__builtin_amdgcn_readlane(__float_as_int(x), j)); }
__device__ __forceinline__ float sigm(float x) { return 1.0f / (1.0f + expf(-x)); }
struct RwP { const float *mu, *w_up, *w0, *a_up, *a0, *g_up, *k_k, *k_a, *r_k, *lnx_w, *lnx_b; };
__device__ __forceinline__ void rwkv_naive_phase(const RwP p, const bf16* Z, bf16* O, LAS unsigned char* lds, int wave, int lane, int G) {
    if (wave != 0) return;
    LAS float* WUP = (LAS float*)lds; LAS float* AUP = WUP + 4096; LAS float* GUP = AUP + 4096; LAS float* VEC = GUP + 10240;
    const float *mu = p.mu, *w_up = p.w_up, *w0 = p.w0, *a_up = p.a_up, *a0 = p.a0, *g_up = p.g_up, *k_k = p.k_k, *k_a = p.k_a, *r_k = p.r_k, *lnx_w = p.lnx_w, *lnx_b = p.lnx_b;
    for (int u = blockIdx.x; u < BATCH * 16; u += G) {
        const int b = u >> 4, h = u & 15, hc = h * 64;
#pragma unroll 4
        for (int j = 0; j < 64; ++j) { WUP[j * 64 + lane] = w_up[j * 1024 + hc + lane]; AUP[j * 64 + lane] = a_up[j * 1024 + hc + lane]; }
#pragma unroll 4
        for (int j = 0; j < 160; ++j) GUP[j * 64 + lane] = g_up[j * 1024 + hc + lane];
        const float mu_r = mu[hc + lane], mu_k = mu[1024 + hc + lane], mu_v = mu[2048 + hc + lane], mu_w = mu[3072 + lane], mu_a = mu[3136 + lane];
        const float mu_g0 = mu[3200 + lane], mu_g1 = mu[3264 + lane], mu_g2 = (lane < 32) ? mu[3328 + lane] : 0.f;
        const float w0c = w0[hc + lane], a0c = a0[hc + lane], kkc = k_k[hc + lane], kac = k_a[hc + lane], rkc = r_k[hc + lane], lw = lnx_w[hc + lane], lb = lnx_b[hc + lane];
        float S[64];
#pragma unroll
        for (int k = 0; k < 64; ++k) S[k] = 0.f;
        float pr = 0.f, pk = 0.f, pv = 0.f, pw = 0.f, pa = 0.f, pg0 = 0.f, pg1 = 0.f, pg2 = 0.f;
        const bf16* row = Z + (size_t)(b * T) * ZP;
        bf16 nr = row[ZC_R + hc + lane], nk = row[ZC_RK + hc + lane], nv = row[ZC_RV + hc + lane], nw = row[ZC_XW + lane], na = row[ZC_XA + lane];
        bf16 ng0 = row[ZC_XG + lane], ng1 = row[ZC_XG + 64 + lane], ng2 = row[ZC_XG + 128 + (lane & 31)];
        for (int t = 0; t < T; ++t) {
            const float zr = bf2f(nr), zk = bf2f(nk), zv = bf2f(nv), zw = bf2f(nw), za = bf2f(na), zg0 = bf2f(ng0), zg1 = bf2f(ng1), zg2 = bf2f(ng2);
            if (t + 1 < T) { const bf16* rn = Z + (size_t)(b * T + t + 1) * ZP;
                nr = rn[ZC_R + hc + lane]; nk = rn[ZC_RK + hc + lane]; nv = rn[ZC_RV + hc + lane]; nw = rn[ZC_XW + lane]; na = rn[ZC_XA + lane];
                ng0 = rn[ZC_XG + lane]; ng1 = rn[ZC_XG + 64 + lane]; ng2 = rn[ZC_XG + 128 + (lane & 31)]; }
            const float r = zr + (pr - zr) * mu_r, k = zk + (pk - zk) * mu_k, vv = zv + (pv - zv) * mu_v, xw = zw + (pw - zw) * mu_w, xa = za + (pa - za) * mu_a;
            const float xg0 = zg0 + (pg0 - zg0) * mu_g0, xg1 = zg1 + (pg1 - zg1) * mu_g1, xg2 = zg2 + (pg2 - zg2) * mu_g2;
            pr = zr; pk = zk; pv = zv; pw = zw; pa = za; pg0 = zg0; pg1 = zg1; pg2 = zg2;
            const float tw = tanhf(xw), s0 = sigm(xg0), s1 = sigm(xg1), s2 = sigm(xg2);
            float accw = w0c, acca = a0c, accg = 0.f;
#pragma unroll 8
            for (int j = 0; j < 64; ++j) { accw += rl(tw, j) * WUP[j * 64 + lane]; acca += rl(xa, j) * AUP[j * 64 + lane]; }
#pragma unroll 8
            for (int j = 0; j < 64; ++j) { accg += rl(s0, j) * GUP[j * 64 + lane]; accg += rl(s1, j) * GUP[(64 + j) * 64 + lane]; }
#pragma unroll 8
            for (int j = 0; j < 32; ++j) accg += rl(s2, j) * GUP[(128 + j) * 64 + lane];
            const float nx = -accw; const float sp = fmaxf(nx, 0.f) + log1pf(expf(-fabsf(nx)));
            const float dec = expf(-expf(-sp - 0.5f));
            const float av = sigm(acca);
            float kk = k * kkc; const float n2 = wave_sum(kk * kk); kk = kk / fmaxf(sqrtf(n2), 1e-12f);
            const float kmod = k * (1.0f + (av - 1.0f) * kac);
            VEC[lane] = -kk; VEC[64 + lane] = dec; VEC[128 + lane] = kk * av; VEC[192 + lane] = kmod; VEC[256 + lane] = r;
            LDS_WAIT(); asm volatile("" ::: "memory");
            float sa = 0.f;
#pragma unroll
            for (int kq = 0; kq < 16; ++kq) { const f32x4 x = *(const LAS f32x4*)(VEC + 4 * kq); sa += S[4 * kq] * x.x + S[4 * kq + 1] * x.y + S[4 * kq + 2] * x.z + S[4 * kq + 3] * x.w; if ((kq & 3) == 3) asm volatile("" ::: "memory"); }
            float y = 0.f;
#pragma unroll
            for (int kq = 0; kq < 16; ++kq) { const f32x4 dw = *(const LAS f32x4*)(VEC + 64 + 4 * kq), bb = *(const LAS f32x4*)(VEC + 128 + 4 * kq), km = *(const LAS f32x4*)(VEC + 192 + 4 * kq), rr = *(const LAS f32x4*)(VEC + 256 + 4 * kq);
                S[4 * kq] = S[4 * kq] * dw.x + sa * bb.x + vv * km.x; S[4 * kq + 1] = S[4 * kq + 1] * dw.y + sa * bb.y + vv * km.y;
                S[4 * kq + 2] = S[4 * kq + 2] * dw.z + sa * bb.z + vv * km.z; S[4 * kq + 3] = S[4 * kq + 3] * dw.w + sa * bb.w + vv * km.w;
                y += S[4 * kq] * rr.x + S[4 * kq + 1] * rr.y + S[4 * kq + 2] * rr.z + S[4 * kq + 3] * rr.w; asm volatile("" ::: "memory"); }
            LDS_WAIT(); asm volatile("" ::: "memory");
            const float mean = wave_sum(y) * (1.f / 64.f); const float dy = y - mean; const float var = wave_sum(dy * dy) * (1.f / 64.f);
            const float yn = dy * (1.0f / sqrtf(var + 64e-5f)) * lw + lb;
            const float bonus = wave_sum(r * kmod * rkc) * vv;
            O[(size_t)(b * T + t) * D + 1024 + hc + lane] = (bf16)f2bf((yn + bonus) * accg);
        }
    }
}

__device__ __forceinline__ void sgu_stats_phase(const bf16* ZC, float* ST, int wave, int lane, int G) {
    const int gw = blockIdx.x * NWAVES + wave, NGW = G * NWAVES;
    for (int m = gw; m < M; m += NGW) {
        const GAS v4u* vr = (const GAS v4u*)(ZC + (size_t)m * 4096 + 2048) + lane;
        float x[32]; float s = 0.f;
#pragma unroll
        for (int j = 0; j < 4; ++j) { const v4u w = vr[64 * j];
            x[8 * j + 0] = bflo(w.x); x[8 * j + 1] = bfhi(w.x); x[8 * j + 2] = bflo(w.y); x[8 * j + 3] = bfhi(w.y); x[8 * j + 4] = bflo(w.z); x[8 * j + 5] = bfhi(w.z); x[8 * j + 6] = bflo(w.w); x[8 * j + 7] = bfhi(w.w); }
#pragma unroll
        for (int j = 0; j < 32; ++j) s += x[j];
        const float mean = wave_sum(s) * (1.f / 2048.f); float q = 0.f;
#pragma unroll
        for (int j = 0; j < 32; ++j) { const float d = x[j] - mean; q += d * d; }
        const float rstd = 1.0f / sqrtf(wave_sum(q) * (1.f / 2048.f) + 1e-5f);
        if (lane == 0) { ST[2 * m] = mean; ST[2 * m + 1] = rstd; }
    }
}
__device__ __forceinline__ void sgu_mix_naive_phase(const float* ln_g, const float* ln_b, const float* w_s, const float* b_s, const bf16* ZC, const float* ST, bf16* O, int tid, int G) {
    const int c = tid & 255, th = __builtin_amdgcn_readfirstlane(tid >> 8);
    for (int u = blockIdx.x; u < 2048; u += G) {
        const int bn = u >> 3, g = u & 7;
        const float lg = ln_g[g * 256 + c], lb = ln_b[g * 256 + c];
        float xh[128];
#pragma unroll
        for (int s = 0; s < 128; ++s) { const size_t row = (size_t)bn * 128 + s;
            const float v = bf2f(ZC[row * 4096 + 2048 + g * 256 + c]); const float mean = ST[2 * row], rstd = ST[2 * row + 1];
            xh[s] = (s < 64 * (th + 1)) ? (v - mean) * rstd * lg + lb : 0.f; if ((s & 7) == 7) asm volatile("" ::: "memory"); }
        for (int tt = 0; tt < 64; ++tt) { const int t = th * 64 + tt; const float* wrow = w_s + ((size_t)g * 128 + t) * 128;
            float acc = 0.f;
#pragma unroll
            for (int s = 0; s < 128; ++s) acc += wrow[s] * xh[s];
            acc += b_s[g * 128 + t];
            const size_t row = (size_t)bn * 128 + t;
            O[row * D + g * 256 + c] = (bf16)f2bf(bf2f(ZC[row * 4096 + g * 256 + c]) * acc); }
    }
}

#ifndef MK_ONE_LAUNCH
#define MK_ONE_LAUNCH 0
#endif
__global__ void __launch_bounds__(NWAVES * 64, 2) fwd(Args a) {
    extern __shared__ __attribute__((aligned(16))) unsigned char lds_raw[];
    LAS unsigned char* lds = (LAS unsigned char*)lds_raw;
    const int tid0 = threadIdx.x, wave = __builtin_amdgcn_readfirstlane(tid0 >> 6), G = gridDim.x;
    for (int u = tid0; u < (LDS_BYTES - LDSCTL_OFF) / 4; u += NWAVES * 64) ((LAS unsigned*)(lds + LDSCTL_OFF))[u] = 0u;
    __syncthreads();
    XcdBarrier bar; bar.bar = (unsigned*)(a.ws + WS_CTL) + CW_BAR; bar.x = 0; bar.st = nullptr;
    if (MK_ONE_LAUNCH) bar = xcd_barrier_post((unsigned*)(a.ws + WS_CTL) + CW_BAR, (volatile LAS unsigned*)(lds + MISC_OFF) + 8);
    const int lo = a.ph_lo, hi = a.ph_hi;
#define IN(k) (lo <= (k) && (k) < hi)
#define SEAM(k) do { if (MK_ONE_LAUNCH && IN(k) && IN((k) + 1)) xcd_barrier(bar); } while (0)
    bf16* H = (bf16*)(a.ws + WS_H); bf16* BIG = (bf16*)(a.ws + WS_BIG); float* ST = (float*)(a.ws + WS_ST);
    bf16* WA = (bf16*)(a.ws + WS_WA); bf16* WB = (bf16*)(a.ws + WS_WB); bf16* W1 = (bf16*)(a.ws + WS_W1); bf16* W2 = (bf16*)(a.ws + WS_W2);
#pragma unroll 1
    for (int L = 0; L < DEPTH; ++L) {
        const int pb = 8 * L, i = L >> 1; const bool even = !(L & 1);
        int tid = tid0; asm volatile("" : "+v"(tid));
        const int lane = tid & 63;
        if (IN(pb + 0)) {
            const float* Win; const float* Wout; int Nin;
            if (even) { Win = a.in[4] + (size_t)i * D * EVEN_N; Wout = a.in[16] + (size_t)i * D * D; Nin = EVEN_N; } else { Win = a.in[17] + (size_t)i * D * 4096; Wout = a.in[22] + (size_t)i * D * D; Nin = 4096; }
            const float* xc = a.out; if (L == 0) xc = a.in[0];
            prep_phase(Win, Nin, Wout, a.in[23] + (size_t)L * D * FF, a.in[24] + (size_t)L * FF * D, xc, a.in[1] + (size_t)L * D, a.ws, even, lds, wave, lane, tid, G); SEAM(pb + 0); }
        if (IN(pb + 1)) {
            if (even) { pg8::Gemm g{H, WA, M, ZP, D}; pg8::StaticOrder S; S.init(M, ZP, G, (int)blockIdx.x); pg8::EpiAct<0> E{BIG, ZP, 0, 1.f};
                pg8::gemm_phase<pg8::EpiAct<0>, pg8::StaticOrder, true, true>(lds, g, S, E); }
            else { pg8::Gemm g{H, WA, M, 4096, D}; pg8::StaticOrder S; S.init(M, 4096, G, (int)blockIdx.x); pg8::EpiAct<1> E{BIG, 4096, 0, 1.f};
                pg8::gemm_phase<pg8::EpiAct<1>, pg8::StaticOrder, true, true>(lds, g, S, E); }
            SEAM(pb + 1);
        }
        if (IN(pb + 2)) { if (even) attn_naive_phase(BIG, H, wave, lane, G); else sgu_stats_phase(BIG, ST, wave, lane, G); SEAM(pb + 2); }
        if (IN(pb + 3)) {
            if (even) { const RwP p{a.in[5] + (size_t)i * RWS, a.in[6] + (size_t)i * 65536, a.in[7] + (size_t)i * 1024, a.in[8] + (size_t)i * 65536, a.in[9] + (size_t)i * 1024, a.in[10] + (size_t)i * 163840,
                    a.in[11] + (size_t)i * 1024, a.in[12] + (size_t)i * 1024, a.in[13] + (size_t)i * 1024, a.in[14] + (size_t)i * 1024, a.in[15] + (size_t)i * 1024};
                (void)p;   }
            else sgu_mix_naive_phase(a.in[18] + (size_t)i * 2048, a.in[19] + (size_t)i * 2048, a.in[20] + (size_t)i * 131072, a.in[21] + (size_t)i * 1024, BIG, ST, H, tid, G);
            SEAM(pb + 3); }
        if (IN(pb + 4)) { pg8::Gemm g{H, WB, M, D, D}; pg8::StaticOrder S; S.init(M, D, G, (int)blockIdx.x); const float* rb = a.out; if (L == 0) rb = a.in[0]; pg8::EpiResid E{rb, a.out, D};
            pg8::gemm_phase<pg8::EpiResid, pg8::StaticOrder, true, true>(lds, g, S, E); SEAM(pb + 4); }
        if (IN(pb + 5)) { const int gw = blockIdx.x * NWAVES + wave, NGW = G * NWAVES; const float* gn = a.in[2] + (size_t)L * D;
            for (int m = gw; m < M; m += NGW) rms_row_bf16(a.out + (size_t)m * D, gn, H + (size_t)m * D, lane);
            SEAM(pb + 5); }
        if (IN(pb + 6)) { pg8::Gemm g{H, W1, M, FF, D}; pg8::StaticOrder S; S.init(M, FF, G, (int)blockIdx.x); pg8::EpiAct<2> E{BIG, FF, 0, 1.f};
            pg8::gemm_phase<pg8::EpiAct<2>, pg8::StaticOrder, true, true>(lds, g, S, E); SEAM(pb + 6); }
        if (IN(pb + 7)) { pg8::Gemm g{BIG, W2, M, D, FF}; pg8::StaticOrder S; S.init(M, D, G, (int)blockIdx.x); pg8::EpiResid E{a.out, a.out, D};
            pg8::gemm_phase<pg8::EpiResid, pg8::StaticOrder, true, true>(lds, g, S, E); SEAM(pb + 7); }
    }
    if (IN(32)) { const int gw = blockIdx.x * NWAVES + wave, NGW = G * NWAVES, lane = tid0 & 63;
        for (int m = gw; m < M; m += NGW) rms_row_f32(a.out + (size_t)m * D, a.in[3], lane); }
#undef IN
#undef SEAM
}

__global__ void __launch_bounds__(64) rwkv_naive_kernel(Args a, int i) {
    extern __shared__ __attribute__((aligned(16))) unsigned char lds_raw2[];
    const RwP p{a.in[5] + (size_t)i * RWS, a.in[6] + (size_t)i * 65536, a.in[7] + (size_t)i * 1024, a.in[8] + (size_t)i * 65536, a.in[9] + (size_t)i * 1024, a.in[10] + (size_t)i * 163840,
                a.in[11] + (size_t)i * 1024, a.in[12] + (size_t)i * 1024, a.in[13] + (size_t)i * 1024, a.in[14] + (size_t)i * 1024, a.in[15] + (size_t)i * 1024};
    rwkv_naive_phase(p, (const bf16*)(a.ws + WS_BIG), (bf16*)(a.ws + WS_H), (LAS unsigned char*)lds_raw2, 0, (int)threadIdx.x, (int)gridDim.x);
}
extern "C" void kernel_launch(void* const* d_in, const int* in_sizes, int n_in, void* d_out, int out_size, void* d_ws, size_t ws_size, hipStream_t stream) {
    static int grid = 0;
    if (grid == 0) {
        if (n_in != 25 || out_size != M * D || ws_size < WS_END) { fprintf(stderr, "kernel_launch: unexpected shapes (n_in %d, out %d, ws %zu)\n", n_in, out_size, ws_size); grid = -1; return; }
        int dev = 0, cus = 0, per_cu = 0;
        if (hipGetDevice(&dev) != hipSuccess || hipDeviceGetAttribute(&cus, hipDeviceAttributeMultiprocessorCount, dev) != hipSuccess) { grid = -1; return; }
        (void)hipFuncSetAttribute((const void*)rwkv_naive_kernel, hipFuncAttributeMaxDynamicSharedMemorySize, 80 * 1024);
        if (hipFuncSetAttribute((const void*)fwd, hipFuncAttributeMaxDynamicSharedMemorySize, LDS_BYTES) != hipSuccess) { fprintf(stderr, "kernel_launch: hipFuncSetAttribute failed\n"); grid = -1; return; }
        if (hipOccupancyMaxActiveBlocksPerMultiprocessor(&per_cu, (const void*)fwd, NWAVES * 64, LDS_BYTES) != hipSuccess || per_cu < 1) fprintf(stderr, "kernel_launch: occupancy query reports %d\n", per_cu);
        (void)hipGetLastError();
        grid = cus;
    }
    if (grid < 0) return;
    (void)hipMemsetAsync((char*)d_ws + WS_CTL, 0, CTL_ZERO_BYTES, stream);
    Args a{};
    for (int i = 0; i < 25; ++i) a.in[i] = (const float*)d_in[i];
    a.out = (float*)d_out; a.ws = (unsigned char*)d_ws;
#if MK_ONE_LAUNCH
    a.ph_lo = 0; a.ph_hi = NPH;
    hipLaunchKernelGGL(fwd, dim3(grid), dim3(NWAVES * 64), LDS_BYTES, stream, a);
#else
    for (int p = 0; p < NPH; ++p) { a.ph_lo = p; a.ph_hi = p + 1;
        if (p < 32 && (p & 7) == 3 && ((p >> 3) & 1) == 0) hipLaunchKernelGGL(rwkv_naive_kernel, dim3(BATCH * 16), dim3(64), 80 * 1024, stream, a, p >> 4);
        else hipLaunchKernelGGL(fwd, dim3(grid), dim3(NWAVES * 64), LDS_BYTES, stream, a); }
#endif
}
```

```cpp
#include <hip/hip_runtime.h>
#include <cstdio>
#include <cstdint>
namespace pg8 {
#define PG8_LAS __attribute__((address_space(3)))
typedef unsigned short bf16_t;
typedef short bf16x8 __attribute__((ext_vector_type(8)));
typedef float f32x4 __attribute__((ext_vector_type(4)));
typedef unsigned u32x4 __attribute__((ext_vector_type(4)));
constexpr int BM = 256, BK = 64, HALF = 128, HTB = HALF * BK * 2  , STAGE_BYTES = 8 * HTB, NXCD = 8, WGM = 8;

__host__ __device__ __forceinline__ int lds_byte(int r, int c) { const int st = (r >> 4) * 2 + (c >> 5), rr = r & 15, cc = c & 31, ob = rr * 64 + cc * 2; return st * 1024 + (ob ^ (((ob >> 9) & 1) << 5)); }
__host__ __device__ __forceinline__ void stage_rc(int b, int& R, int& C) { const int st = b / 1024, sb = b % 1024, swz = sb ^ (((sb >> 9) & 1) << 5); R = (st >> 1) * 16 + swz / 64; C = (st & 1) * 32 + (swz % 64) / 2; }
__host__ __device__ __forceinline__ int perm32(int rho) { const int n = rho >> 4, i = rho & 15; return 8 * (i >> 2) + 4 * n + (i & 3); }

struct Unit { int pm, pn; };
struct Gemm { const bf16_t* A; const bf16_t* Bt; int M, N, K; };

struct StaticOrder {
    int nM, nN, nwg, G, c;
    int wgm = 4;
    __host__ __device__ void init(int M, int N, int G_, int c_, int wgm_ = 4) { nM = M / BM; nN = N / BM; nwg = nM * nN; G = G_; c = c_; wgm = wgm_; }
    __host__ __device__ bool next(int i, Unit& u) const {
        const long L = (long)i * G + c; if (L >= nwg) return false;
        int wgid = (int)L; { const int q = nwg / NXCD, r = nwg % NXCD, xcd = wgid % NXCD, off = wgid / NXCD; wgid = (xcd < r ? xcd * (q + 1) : r * (q + 1) + (xcd - r) * q) + off; }
        const int nig = wgm * nN, gid = wgid / nig, fm = gid * wgm, gsz = (nM - fm) < wgm ? (nM - fm) : wgm;
        u.pm = fm + ((wgid % nig) % gsz); u.pn = (wgid % nig) / gsz; return true;
    }
    __device__ __forceinline__ void a_ready(const Unit&) const {}
    __device__ __forceinline__ void done(const Unit&) const {}
};

__device__ __forceinline__ unsigned cvt_pk_bf16(float lo, float hi) { unsigned r; asm volatile("v_cvt_pk_bf16_f32 %0, %1, %2" : "=v"(r) : "v"(lo), "v"(hi)); return r; }
typedef float f32x2 __attribute__((ext_vector_type(2)));
__device__ __forceinline__ f32x2 gelu_pk(f32x2 v) {
    const f32x2 av = __builtin_elementwise_abs(v), d = av * 0.2316418882f + 1.0f;
    f32x2 t; t.x = __builtin_amdgcn_rcpf(d.x); t.y = __builtin_amdgcn_rcpf(d.y);
    f32x2 q = t * 0.5307027145f + (-0.7265760135f); q = q * t + 0.7107068705f; q = q * t + (-0.142248368f); q = q * t + 0.127414796f; q = q * t;
    const f32x2 s = (v * v) * (-0.72134752044f);
    f32x2 e; e.x = __builtin_amdgcn_exp2f(s.x); e.y = __builtin_amdgcn_exp2f(s.y);
    const f32x2 m = v * (q * e), r = v - m;
    f32x2 o; o.x = v.x < 0.f ? m.x : r.x; o.y = v.y < 0.f ? m.y : r.y; return o;
}
constexpr int LX_RED = 135168;
constexpr int LX_RS = 139264;
template <class Sched> __device__ __forceinline__ int rs_table(const float* ssq, const Sched& S, PG8_LAS unsigned char* lds0, int tid) {
    Unit ua, ub; if (!S.next(0, ua)) return 0;
    ub = ua; S.next((S.nwg - 1 - S.c) / S.G, ub);
    const int row = ((tid < BM) ? ua.pm : ub.pm) * BM + (tid & (BM - 1));
    const f32x4* p = (const f32x4*)(ssq + (size_t)row * 8); const f32x4 a = p[0], b = p[1];
    ((PG8_LAS float*)(lds0 + LX_RS))[tid] = __builtin_amdgcn_rsqf((((a[0] + a[1]) + (a[2] + a[3])) + ((b[0] + b[1]) + (b[2] + b[3]))) * (1.0f / 2048.0f) + 1e-6f);
    return ua.pm;
}
template <int ACT> struct EpiActS {
    static constexpr bool PERM = true, AFTER_DRAIN = false;
    bf16_t* O; int ldc; int nscale; float scale0; const PG8_LAS float* rs_tab; int pm0;
    __device__ __forceinline__ void operator()(const f32x4 (&acc)[2][2][4][2], const Unit& u, int wr, int wc, int fr, int fq) const {
        const int row0 = u.pm * BM + wr * 64 + fr; const int col0 = u.pn * BM + wc * 32 + 8 * fq;
        const float sc = (u.pn < nscale) ? scale0 : 1.f;
        float rs[2][4];
        const PG8_LAS float* rt = rs_tab + ((u.pm == pm0) ? 0 : BM) + wr * 64 + fr;
#pragma unroll
        for (int ai = 0; ai < 2; ++ai)
#pragma unroll
            for (int m = 0; m < 4; ++m) rs[ai][m] = rt[ai * HALF + m * 16];
#pragma unroll
        for (int ai = 0; ai < 2; ++ai)
#pragma unroll
            for (int m = 0; m < 4; ++m) { bf16_t* rowp = O + (size_t)(row0 + ai * HALF + m * 16) * ldc + col0; const float rsv = rs[ai][m];
#pragma unroll
                for (int bj = 0; bj < 2; ++bj) { f32x4 v0 = acc[ai][bj][m][0] * rsv, v1 = acc[ai][bj][m][1] * rsv;
                    if (ACT == 1) { f32x2 a = gelu_pk((f32x2){v0[0], v0[1]}), b = gelu_pk((f32x2){v0[2], v0[3]}), c = gelu_pk((f32x2){v1[0], v1[1]}), d = gelu_pk((f32x2){v1[2], v1[3]});
                        v0 = (f32x4){a.x, a.y, b.x, b.y}; v1 = (f32x4){c.x, c.y, d.x, d.y}; }
                    if (ACT == 2) { const f32x4 z = {0.f, 0.f, 0.f, 0.f}; v0 = __builtin_elementwise_max(v0, z); v1 = __builtin_elementwise_max(v1, z); v0 = v0 * v0; v1 = v1 * v1; }
                    if (ACT == 0) { v0 = v0 * sc; v1 = v1 * sc; }
                    u32x4 w; w.x = cvt_pk_bf16(v0[0], v0[1]); w.y = cvt_pk_bf16(v0[2], v0[3]); w.z = cvt_pk_bf16(v1[0], v1[1]); w.w = cvt_pk_bf16(v1[2], v1[3]);
                    *(u32x4*)(rowp + bj * HALF) = w; } }
    }
};
struct EpiResidB {
    static constexpr bool PERM = true, AFTER_DRAIN = false;
    bf16_t* xb; float* ssq; int ldc; PG8_LAS unsigned char* lds0;
    __device__ __forceinline__ void operator()(const f32x4 (&acc)[2][2][4][2], const Unit& u, int wr, int wc, int fr, int fq) const {
        const int col0 = u.pn * BM + wc * 32 + 8 * fq;
        PG8_LAS float* RED = (PG8_LAS float*)(lds0 + LX_RED);
#pragma unroll
        for (int ai = 0; ai < 2; ++ai)
#pragma unroll
            for (int m = 0; m < 4; ++m) { const int rl = ai * HALF + wr * 64 + m * 16 + fr; const size_t off = (size_t)(u.pm * BM + rl) * ldc + col0;
                u32x4 b[2];
#pragma unroll
                for (int bj = 0; bj < 2; ++bj) b[bj] = *(const u32x4*)(xb + off + bj * HALF);
                float q = 0.f;
#pragma unroll
                for (int bj = 0; bj < 2; ++bj) {
                    f32x4 o0 = {__uint_as_float(b[bj].x << 16), __uint_as_float(b[bj].x & 0xffff0000u), __uint_as_float(b[bj].y << 16), __uint_as_float(b[bj].y & 0xffff0000u)};
                    f32x4 o1 = {__uint_as_float(b[bj].z << 16), __uint_as_float(b[bj].z & 0xffff0000u), __uint_as_float(b[bj].w << 16), __uint_as_float(b[bj].w & 0xffff0000u)};
                    o0 = o0 + acc[ai][bj][m][0]; o1 = o1 + acc[ai][bj][m][1];
                    q += ((o0[0] * o0[0] + o0[1] * o0[1]) + (o0[2] * o0[2] + o0[3] * o0[3])) + ((o1[0] * o1[0] + o1[1] * o1[1]) + (o1[2] * o1[2] + o1[3] * o1[3]));
                    u32x4 w; w.x = cvt_pk_bf16(o0[0], o0[1]); w.y = cvt_pk_bf16(o0[2], o0[3]); w.z = cvt_pk_bf16(o1[0], o1[1]); w.w = cvt_pk_bf16(o1[2], o1[3]);
                    *(u32x4*)(xb + off + bj * HALF) = w; }
                { auto r16 = __builtin_amdgcn_permlane16_swap(__float_as_uint(q), __float_as_uint(q), false, false); q = __uint_as_float(r16[0]) + __uint_as_float(r16[1]);
                  auto r32 = __builtin_amdgcn_permlane32_swap(__float_as_uint(q), __float_as_uint(q), false, false); q = __uint_as_float(r32[0]) + __uint_as_float(r32[1]); }
                if (fq == 0) RED[rl * 4 + wc] = q;
                if (m & 1) asm volatile("" ::: "memory"); }
        asm volatile("s_waitcnt lgkmcnt(0)\n\ts_barrier" ::: "memory");
        const int t = (wr * 4 + wc) * 64 + fq * 16 + fr;
        if (t < BM) { const f32x4 r4 = *(const PG8_LAS f32x4*)(RED + t * 4); ssq[(size_t)(u.pm * BM + t) * 8 + u.pn] = (r4[0] + r4[1]) + (r4[2] + r4[3]); }
    }
};
template <class Epi, class Sched, bool ALIGN_EPI = false, bool SP2 = false>
__device__ __forceinline__ void gemm_phase(PG8_LAS unsigned char* lds, const Gemm g, const Sched& S, const Epi& E, int tid_in) {
    int tid_ = tid_in; const bf16_t* gA_ = g.A; const bf16_t* gB_ = g.Bt; asm volatile("" : "+v"(tid_), "+s"(gA_), "+s"(gB_));
    const int tid = tid_, wid = __builtin_amdgcn_readfirstlane(tid >> 6), lane = tid & 63, wr = wid >> 2, wc = wid & 3, fr = lane & 15, fq = lane >> 4;
    const int K = g.K, nt = K / BK;
    unsigned voffA[2], voffB[2];
#pragma unroll
    for (int i = 0; i < 2; ++i) { int R, C; stage_rc(tid * 16 + i * 8192, R, C); const int Rb = Epi::PERM ? ((R & ~31) + perm32(R & 31)) : R;
        voffA[i] = (unsigned)(R * K + C) * 2u; voffB[i] = (unsigned)(Rb * K + C) * 2u; }
    const size_t kstep = (size_t)(BK * 2);
    const size_t hstep = (size_t)HALF * K * 2;
    const size_t tstep = 2 * hstep;
    const unsigned ldsw = (unsigned)wid * 1024u;
    const int aoff = lds_byte(wr * 64 + fr, fq * 8), boff = lds_byte(wc * 32 + fr, fq * 8);
#define PG8_SA(b, h) (((b) * 2 + (h)) * HTB)
#define PG8_SB(b, h) ((4 + (b) * 2 + (h)) * HTB)
#define PG8_STAGE(bufoff, gbase, voff) do { _Pragma("unroll") for (int _i = 0; _i < 2; ++_i) \
        __builtin_amdgcn_global_load_lds((const unsigned*)((const char*)(gbase) + (voff)[_i]), (PG8_LAS unsigned*)(lds + (bufoff) + ldsw + _i * 8192), 16, 0, 0); } while (0)
#define PG8_LDA(dst, b, h) do { _Pragma("unroll") for (int m = 0; m < 4; ++m) _Pragma("unroll") for (int k = 0; k < 2; ++k) dst[m][k] = *(const PG8_LAS bf16x8*)(lds + PG8_SA(b, h) + aoff + m * 2048 + k * 1024); } while (0)
#define PG8_LDB(dst, b, h) do { _Pragma("unroll") for (int n = 0; n < 2; ++n) _Pragma("unroll") for (int k = 0; k < 2; ++k) dst[n][k] = *(const PG8_LAS bf16x8*)(lds + PG8_SB(b, h) + boff + n * 2048 + k * 1024); } while (0)
#define PG8_MMA(ai, bj, At, Bt) do { __builtin_amdgcn_s_setprio(1); _Pragma("unroll") for (int m = 0; m < 4; ++m) _Pragma("unroll") for (int n = 0; n < 2; ++n) _Pragma("unroll") for (int k = 0; k < 2; ++k) \
        acc[ai][bj][m][n] = __builtin_amdgcn_mfma_f32_16x16x32_bf16(Bt[n][k], At[m][k], acc[ai][bj][m][n], 0, 0, 0); __builtin_amdgcn_s_setprio(0); } while (0)
#define PG8_WAIT_V(n) asm volatile("s_waitcnt vmcnt(" #n ")" ::: "memory")
#define PG8_WAIT_L(n) asm volatile("s_waitcnt lgkmcnt(" #n ")" ::: "memory")
#define PG8_BAR __builtin_amdgcn_s_barrier()
#define PG8_SCHED __builtin_amdgcn_sched_barrier(0)
    Unit cur, nxt; int ui = 0;
    if (!S.next(0, cur)) return;
    f32x4 acc[2][2][4][2];
#pragma unroll
    for (int a = 0; a < 2; ++a)
#pragma unroll
        for (int b = 0; b < 2; ++b)
#pragma unroll
            for (int m = 0; m < 4; ++m)
#pragma unroll
                for (int n = 0; n < 2; ++n) acc[a][b][m][n] = (f32x4){0.f, 0.f, 0.f, 0.f};
    bf16x8 At[4][2], B0[2][2], B1[2][2];
    const char* cA = (const char*)gA_ + (size_t)cur.pm * tstep; const char* cB = (const char*)gB_ + (size_t)cur.pn * tstep;
    S.a_ready(cur);
    if constexpr (SP2) {
        PG8_STAGE(PG8_SB(0, 0), cB, voffB); PG8_STAGE(PG8_SB(0, 1), cB + hstep, voffB); PG8_STAGE(PG8_SA(0, 0), cA, voffA); PG8_STAGE(PG8_SA(0, 1), cA + hstep, voffA);
        if (wr == 1) PG8_BAR;
        PG8_WAIT_V(2); PG8_BAR;
        PG8_STAGE(PG8_SB(1, 0), cB + kstep, voffB); PG8_STAGE(PG8_SA(1, 0), cA + kstep, voffA); PG8_STAGE(PG8_SB(1, 1), cB + hstep + kstep, voffB);
        PG8_WAIT_V(6); PG8_BAR;
    } else {
        PG8_STAGE(PG8_SB(0, 0), cB, voffB); PG8_STAGE(PG8_SA(0, 0), cA, voffA); PG8_STAGE(PG8_SB(0, 1), cB + hstep, voffB); PG8_STAGE(PG8_SA(0, 1), cA + hstep, voffA);
        if (wr == 1) PG8_BAR;
        PG8_WAIT_V(4); PG8_BAR;
        PG8_STAGE(PG8_SB(1, 0), cB + kstep, voffB); PG8_STAGE(PG8_SA(1, 0), cA + kstep, voffA); PG8_STAGE(PG8_SB(1, 1), cB + hstep + kstep, voffB);
        PG8_WAIT_V(6); PG8_BAR;
    }
    for (;;) {
        const bool has_next = S.next(ui + 1, nxt);
        const char* nA = has_next ? (const char*)gA_ + (size_t)nxt.pm * tstep : cA; const char* nB = has_next ? (const char*)gB_ + (size_t)nxt.pn * tstep : cB;
        for (int t = 0; t < nt; t += 2) {
            const bool last = (t == nt - 2);
            const char* a1 = cA + (size_t)(t + 1) * kstep;
            const char* a2 = last ? nA : cA + (size_t)(t + 2) * kstep; const char* b2 = last ? nB : cB + (size_t)(t + 2) * kstep;
            const char* a3 = a2 + kstep; const char* b3 = b2 + kstep;
            if (last && has_next) S.a_ready(nxt);
            if constexpr (SP2) {
            PG8_LDB(B0, 0, 0); PG8_LDB(B1, 0, 1); PG8_SCHED; PG8_LDA(At, 0, 0); PG8_STAGE(PG8_SA(1, 1), a1 + hstep, voffA);
            PG8_WAIT_V(8); PG8_WAIT_L(0); PG8_BAR; PG8_MMA(0, 0, At, B0); PG8_MMA(0, 1, At, B1); PG8_BAR; PG8_SCHED;
            PG8_LDA(At, 0, 1); PG8_STAGE(PG8_SB(0, 0), b2, voffB); PG8_STAGE(PG8_SB(0, 1), b2 + hstep, voffB); PG8_STAGE(PG8_SA(0, 0), a2, voffA);
            PG8_WAIT_V(8); PG8_WAIT_L(0); PG8_BAR; PG8_MMA(1, 0, At, B0); PG8_MMA(1, 1, At, B1); PG8_BAR; PG8_SCHED;
            PG8_LDB(B0, 1, 0); PG8_LDB(B1, 1, 1); PG8_SCHED; PG8_LDA(At, 1, 0); PG8_STAGE(PG8_SA(0, 1), a2 + hstep, voffA);
            PG8_WAIT_V(8); PG8_WAIT_L(0); PG8_BAR; PG8_MMA(0, 0, At, B0); PG8_MMA(0, 1, At, B1); PG8_BAR; PG8_SCHED;
            PG8_LDA(At, 1, 1); PG8_STAGE(PG8_SB(1, 0), b3, voffB); PG8_STAGE(PG8_SB(1, 1), b3 + hstep, voffB); PG8_STAGE(PG8_SA(1, 0), a3, voffA);
            PG8_WAIT_V(8); PG8_WAIT_L(0); PG8_BAR; PG8_MMA(1, 0, At, B0); PG8_MMA(1, 1, At, B1); PG8_BAR; PG8_SCHED;
            } else {
            PG8_LDB(B0, 0, 0); PG8_SCHED; PG8_LDA(At, 0, 0); PG8_STAGE(PG8_SA(1, 1), a1 + hstep, voffA);
            PG8_WAIT_L(8); PG8_BAR; PG8_WAIT_L(0); PG8_MMA(0, 0, At, B0); PG8_BAR; PG8_SCHED;
            PG8_LDB(B1, 0, 1); PG8_STAGE(PG8_SB(0, 0), b2, voffB);
            PG8_BAR; PG8_WAIT_L(0); PG8_MMA(0, 1, At, B1); PG8_BAR;
            PG8_LDA(At, 0, 1); PG8_STAGE(PG8_SA(0, 0), a2, voffA);
            PG8_BAR; PG8_WAIT_L(0); PG8_MMA(1, 0, At, B0); PG8_BAR; PG8_SCHED;
            PG8_STAGE(PG8_SB(0, 1), b2 + hstep, voffB);
            PG8_WAIT_V(6); PG8_BAR; PG8_MMA(1, 1, At, B1); PG8_BAR;
            PG8_LDB(B0, 1, 0); PG8_SCHED; PG8_LDA(At, 1, 0); PG8_STAGE(PG8_SA(0, 1), a2 + hstep, voffA);
            PG8_WAIT_L(8); PG8_BAR; PG8_WAIT_L(0); PG8_MMA(0, 0, At, B0); PG8_BAR; PG8_SCHED;
            PG8_LDB(B1, 1, 1); PG8_STAGE(PG8_SB(1, 0), b3, voffB);
            PG8_BAR; PG8_WAIT_L(0); PG8_MMA(0, 1, At, B1); PG8_BAR;
            PG8_LDA(At, 1, 1); PG8_STAGE(PG8_SA(1, 0), a3, voffA);
            PG8_BAR; PG8_WAIT_L(0); PG8_MMA(1, 0, At, B0); PG8_BAR; PG8_SCHED;
            PG8_STAGE(PG8_SB(1, 1), b3 + hstep, voffB);
            PG8_WAIT_V(6); PG8_BAR; PG8_MMA(1, 1, At, B1); PG8_BAR;
            }
        }
        if constexpr (ALIGN_EPI) { if (wr == 0) PG8_BAR; }
        if constexpr (!Epi::AFTER_DRAIN) { E(acc, cur, wr, wc, fr, fq); S.done(cur); }
        if (!has_next) break;
#pragma unroll
        for (int a = 0; a < 2; ++a)
#pragma unroll
            for (int b = 0; b < 2; ++b)
#pragma unroll
                for (int m = 0; m < 4; ++m)
#pragma unroll
                    for (int n = 0; n < 2; ++n) acc[a][b][m][n] = (f32x4){0.f, 0.f, 0.f, 0.f};
        cur = nxt; cA = nA; cB = nB; ++ui;
        if constexpr (ALIGN_EPI) { if (wr == 1) PG8_BAR; }
    }
    PG8_WAIT_V(0);
    if constexpr (!ALIGN_EPI) { if (wr == 0) PG8_BAR; }
    PG8_BAR;
    if constexpr (Epi::AFTER_DRAIN) { E.fused(acc, cur, wr, wc, fr, fq, lds, wid, lane); S.done(cur); }
#undef PG8_SA
#undef PG8_SB
#undef PG8_STAGE
#undef PG8_LDA
#undef PG8_LDB
#undef PG8_MMA
#undef PG8_WAIT_V
#undef PG8_WAIT_L
#undef PG8_BAR
#undef PG8_SCHED
}
}
#define GAS __attribute__((address_space(1)))
#define LAS __attribute__((address_space(3)))
typedef unsigned short bf16;
typedef unsigned v4u __attribute__((ext_vector_type(4)));
typedef float f32x4 __attribute__((ext_vector_type(4)));
typedef short bf16x8 __attribute__((ext_vector_type(8)));
typedef GAS unsigned gu32;
typedef GAS unsigned long long gu64;
#define RLX_AGENT __ATOMIC_RELAXED, __HIP_MEMORY_SCOPE_AGENT
#define LDS_WAIT() asm volatile("s_waitcnt lgkmcnt(0)" ::: "memory")
#define VM_WAIT() asm volatile("s_waitcnt vmcnt(0)" ::: "memory")
__device__ __forceinline__ unsigned long long rt() { return __builtin_amdgcn_s_memrealtime(); }
typedef __bf16 bfx2_t __attribute__((ext_vector_type(2)));
typedef float f32x2_t __attribute__((ext_vector_type(2)));
__device__ __forceinline__ unsigned pk2(float lo, float hi) { return __builtin_bit_cast(unsigned, __builtin_convertvector((f32x2_t){lo, hi}, bfx2_t)); }
__device__ __forceinline__ unsigned f2bf(float f) { return pk2(f, 0.f) & 0xffffu; }

#define XB_TMO      128
#define XB_XCNT(j)  (256  + 64 * (j))
#define XB_XSUB(j)  (1280 + 64 * (j))
#define XB_XGEN(j)  (2304 + 64 * (j))
#define XB_TOP      3328
#define XB_TOPGEN   3392
#define XCD_BAR_WORDS 3456
#define XB_SPIN_CAP (1u << 18)

__device__ __forceinline__ unsigned xb_ld(unsigned* p)              { return __hip_atomic_load(p, __ATOMIC_RELAXED, __HIP_MEMORY_SCOPE_AGENT); }
__device__ __forceinline__ unsigned xb_add(unsigned* p, unsigned v) { return __hip_atomic_fetch_add(p, v, __ATOMIC_RELAXED, __HIP_MEMORY_SCOPE_AGENT); }
__device__ __forceinline__ unsigned xb_xcc_id() { return (unsigned)__builtin_amdgcn_s_getreg((3 << 11) | 20) & 0xFu; }
#define XB_SPIN(cond, bar) do { unsigned _sp = 0; while (cond) { __builtin_amdgcn_s_sleep(1); \
    if ((++_sp & 255u) == 0u) { if (xb_ld(&(bar)[XB_TMO])) break; if (_sp > XB_SPIN_CAP) { atomicAdd(&(bar)[XB_TMO], 1u); break; } } } } while (0)

struct XcdBarrier {
    unsigned* bar; unsigned x;
    volatile LAS unsigned* st;
};

__device__ __forceinline__ XcdBarrier xcd_barrier_post(unsigned* bar, volatile LAS unsigned* st) {
    XcdBarrier b; b.bar = bar; b.x = xb_xcc_id(); b.st = st;
    if (threadIdx.x == 0) (void)xb_add(&bar[XB_XCNT(b.x)], 1u);
    return b;
}
__device__ __forceinline__ void xcd_barrier_complete(unsigned* bar, unsigned x, unsigned& nloc, unsigned& nx) {
    const unsigned G = gridDim.x * gridDim.y * gridDim.z;
    unsigned sum, cnt, mine, sp = 0u;
    for (;;) {
        sum = 0u; cnt = 0u; mine = 0u;
#pragma unroll
        for (unsigned j = 0; j < 16; ++j) { const unsigned c = xb_ld(&bar[XB_XCNT(j)]); sum += c; cnt += (c > 0u) ? 1u : 0u; mine = (j == x) ? c : mine; }
        if (sum == G) break;
        __builtin_amdgcn_s_sleep(1);
        if ((++sp & 255u) == 0u) { if (xb_ld(&bar[XB_TMO])) break; if (sp > XB_SPIN_CAP) { atomicAdd(&bar[XB_TMO], 1u); break; } }
    }
    nloc = mine > 0u ? mine : 1u; nx = cnt > 0u ? cnt : 1u;
}

__device__ __forceinline__ void xcd_barrier(const XcdBarrier& b) {
    asm volatile("s_waitcnt vmcnt(0)" ::: "memory");
    __syncthreads();
    if (threadIdx.x == 0) {
        unsigned* bar = b.bar;
        __builtin_amdgcn_s_waitcnt(0);
        unsigned nloc = b.st[0], nx = b.st[1];
        if (nloc == 0u) { xcd_barrier_complete(bar, b.x, nloc, nx); b.st[0] = nloc; b.st[1] = nx; }
        const unsigned old = xb_add(&bar[XB_XSUB(b.x)], 1u);
        const unsigned gen = old / nloc;
        if (old + 1u == (gen + 1u) * nloc) {
            __builtin_amdgcn_fence(__ATOMIC_RELEASE, "agent");
            asm volatile("s_waitcnt vmcnt(0)" ::: "memory");
            const unsigned og = xb_add(&bar[XB_TOP], 1u);
            const unsigned tg = og / nx;
            if (og + 1u == (tg + 1u) * nx) xb_add(&bar[XB_TOPGEN], 1u);
            else XB_SPIN(xb_ld(&bar[XB_TOPGEN]) == tg, bar);
            __builtin_amdgcn_fence(__ATOMIC_ACQUIRE, "agent");
            xb_add(&bar[XB_XGEN(b.x)], 1u);
            asm volatile("s_waitcnt vmcnt(0)" ::: "memory");
        } else {
            XB_SPIN(xb_ld(&bar[XB_XGEN(b.x)]) == gen, bar);
            __builtin_amdgcn_fence(__ATOMIC_ACQUIRE, "agent");
            asm volatile("s_waitcnt vmcnt(0)" ::: "memory");
        }
    }
    __syncthreads();
}
template <int CTRL> __device__ __forceinline__ float dpp_mov(float x) { return __int_as_float(__builtin_amdgcn_update_dpp(0, __float_as_int(x), CTRL, 0xF, 0xF, true)); }
__device__ __forceinline__ float sum_xor16(float x) { auto r = __builtin_amdgcn_permlane16_swap(__float_as_uint(x), __float_as_uint(x), false, false); return __uint_as_float(r[0]) + __uint_as_float(r[1]); }
__device__ __forceinline__ float sum_xor32(float x) { auto r = __builtin_amdgcn_permlane32_swap(__float_as_uint(x), __float_as_uint(x), false, false); return __uint_as_float(r[0]) + __uint_as_float(r[1]); }
__device__ __forceinline__ float wave_sum(float v) {
    v += dpp_mov<0xB1>(v); v += dpp_mov<0x4E>(v); v += dpp_mov<0x141>(v); v += dpp_mov<0x140>(v);
    return sum_xor32(sum_xor16(v));
}
__device__ __forceinline__ void transpose64_item(const float* W, int K, int N, bf16* WT, LAS unsigned char* img, int item, int lane, const float* gk) {
    const int nblk = (N + 63) >> 6, kb = item / nblk, nb = item - kb * nblk, k0 = 64 * kb, n0 = 64 * nb;
    const int kl = lane >> 4, n4 = (lane & 15) * 4; const bool live = n0 + n4 < N;
    f32x4 v[16];
#pragma unroll
    for (int j = 0; j < 16; ++j) v[j] = live ? *(const GAS f32x4*)(W + (size_t)(k0 + 4 * j + kl) * N + n0 + n4) : (f32x4){0.f, 0.f, 0.f, 0.f};
#pragma unroll
    for (int j = 0; j < 16; ++j) { const int kk = 4 * j + kl; const float g = gk ? gk[k0 + kk] : 1.0f; const f32x4 x = v[j] * g;
        LAS unsigned char* p = img + n4 * 132 + kk * 2;
        *(LAS unsigned short*)(p) = (unsigned short)f2bf(x.x); *(LAS unsigned short*)(p + 132) = (unsigned short)f2bf(x.y); *(LAS unsigned short*)(p + 264) = (unsigned short)f2bf(x.z); *(LAS unsigned short*)(p + 396) = (unsigned short)f2bf(x.w); }
    LDS_WAIT(); asm volatile("" ::: "memory");
    const int c = lane & 7;
#pragma unroll
    for (int jj = 0; jj < 8; ++jj) { const int n = (lane >> 3) + 8 * jj;
        const LAS unsigned* q = (const LAS unsigned*)(img + n * 132 + c * 16); v4u o; o.x = q[0]; o.y = q[1]; o.z = q[2]; o.w = q[3];
        if (n0 + n < N) *(GAS v4u*)(WT + (size_t)(n0 + n) * K + k0 + 8 * c) = o; }
    LDS_WAIT(); asm volatile("" ::: "memory");
}
constexpr int NWAVES = 8;
constexpr int BATCH = 16, T = 2048, D = 2048, M = BATCH * T, DEPTH = 4, FF = 8192;
constexpr int EVEN_N = 6432, ZP = 6656;
constexpr int ZC_Q = 0, ZC_K = 1024, ZC_V = 2048, ZC_R = 3072, ZC_RK = 4096, ZC_RV = 5120, ZC_XW = 6144, ZC_XA = 6208, ZC_XG = 6272;
constexpr int RWS = 3360;
constexpr int NPH = 33;

constexpr size_t MiB = 1u << 20;
constexpr size_t WS_CTL = 0, CTL_ZERO_BYTES = 1 * MiB;
constexpr size_t WS_WA = 2 * MiB;
constexpr size_t WS_WB = 28 * MiB;
constexpr size_t WS_W1 = 36 * MiB;
constexpr size_t WS_W2 = 68 * MiB;
constexpr size_t WS_H = 104 * MiB;
constexpr size_t WS_BIG = 232 * MiB;
constexpr size_t WS_SSQ = 101 * MiB;
constexpr size_t WS_XB = 744 * MiB;
constexpr size_t WS_END = 872 * MiB;
constexpr int CW_BAR = 4096;

constexpr int RING_BYTES = 131072, LDSCTL_OFF = RING_BYTES, MISC_OFF = LDSCTL_OFF + 320, LDS_BYTES = 147456;

struct Args { const float* in[25]; float* out; unsigned char* ws; int ph_lo, ph_hi; };

__device__ __forceinline__ v4u zero4() { unsigned z; asm volatile("v_mov_b32 %0, 0" : "=v"(z)); return (v4u){z, z, z, z}; }
__device__ __forceinline__ float bf2f(bf16 h) { return __uint_as_float((unsigned)h << 16); }
__device__ __forceinline__ float bflo(unsigned w) { return __uint_as_float(w << 16); }
__device__ __forceinline__ float bfhi(unsigned w) { return __uint_as_float(w & 0xffff0000u); }

__device__ __forceinline__ void rms_row_out(const bf16* xrow, const float* g, float* orow, int lane) {
    const GAS v4u* xr = (const GAS v4u*)xrow + lane; const GAS f32x4* gr = (const GAS f32x4*)g + 2 * lane; GAS f32x4* o = (GAS f32x4*)orow + 2 * lane;
    f32x4 v[8]; float s = 0.f;
#pragma unroll
    for (int j = 0; j < 4; ++j) { const v4u w = xr[64 * j]; v[2 * j] = (f32x4){bflo(w.x), bfhi(w.x), bflo(w.y), bfhi(w.y)}; v[2 * j + 1] = (f32x4){bflo(w.z), bfhi(w.z), bflo(w.w), bfhi(w.w)};
        s += ((v[2 * j].x * v[2 * j].x + v[2 * j].y * v[2 * j].y) + (v[2 * j].z * v[2 * j].z + v[2 * j].w * v[2 * j].w)) + ((v[2 * j + 1].x * v[2 * j + 1].x + v[2 * j + 1].y * v[2 * j + 1].y) + (v[2 * j + 1].z * v[2 * j + 1].z + v[2 * j + 1].w * v[2 * j + 1].w)); }
    const float r = 1.0f / sqrtf(wave_sum(s) * (1.f / D) + 1e-6f);
#pragma unroll
    for (int j = 0; j < 4; ++j) { o[128 * j] = v[2 * j] * r * gr[128 * j]; o[128 * j + 1] = v[2 * j + 1] * r * gr[128 * j + 1]; }
}
__device__ __forceinline__ void prep_phase(const float* Win, int Nin, const float* Wout, const float* w1, const float* w2, const float* x0, const float* gmix, const float* gffn, unsigned char* ws, bool even, LAS unsigned char* lds, int wave, int lane, int tid, int G) {
    const int gw = blockIdx.x * NWAVES + wave, NGW = G * NWAVES;
    bf16* WA = (bf16*)(ws + WS_WA); bf16* WB = (bf16*)(ws + WS_WB); bf16* W1 = (bf16*)(ws + WS_W1); bf16* W2 = (bf16*)(ws + WS_W2);
    const int I_in = (D / 64) * ((Nin + 63) / 64), I_out = (D / 64) * (D / 64), I_1 = (D / 64) * (FF / 64), I_2 = (FF / 64) * (D / 64);
    LAS unsigned char* const img = lds + wave * 16384;
    const int total = I_in + I_out + I_1 + I_2;
    for (int it = gw; it < total; it += NGW) {
        int r = it;
        if (r < I_in) { transpose64_item(Win, D, Nin, WA, img, r, lane, gmix); continue; } r -= I_in;
        if (r < I_out) { transpose64_item(Wout, D, D, WB, img, r, lane, nullptr); continue; } r -= I_out;
        if (r < I_1) { transpose64_item(w1, D, FF, W1, img, r, lane, gffn); continue; } r -= I_1;
        transpose64_item(w2, FF, D, W2, img, r, lane, nullptr);
    }
    if (even) {
        GAS v4u* p = (GAS v4u*)(WA + (size_t)EVEN_N * D); const int n16 = (ZP - EVEN_N) * D * 2 / 16;
        for (int k = blockIdx.x * (NWAVES * 64) + tid; k < n16; k += G * NWAVES * 64) p[k] = zero4();
    }
    if (x0) {
        bf16* XB = (bf16*)(ws + WS_XB); float* SSQ = (float*)(ws + WS_SSQ);
        for (int m = gw; m < M; m += NGW) {
            const GAS f32x4* xr = (const GAS f32x4*)(x0 + (size_t)m * D) + lane; GAS unsigned long long* o8 = (GAS unsigned long long*)(XB + (size_t)m * D) + lane;
            float s = 0.f;
#pragma unroll
            for (int j = 0; j < 8; ++j) { const f32x4 v = xr[64 * j]; s += (v.x * v.x + v.y * v.y) + (v.z * v.z + v.w * v.w);
                o8[64 * j] = (unsigned long long)pk2(v.x, v.y) | ((unsigned long long)pk2(v.z, v.w) << 32); }
            s = wave_sum(s);
            if (lane < 8) SSQ[(size_t)m * 8 + lane] = lane == 0 ? s : 0.f;
        }
    }
}

__device__ __forceinline__ float rl(float x, int j) { return __int_as_float(__builtin_amdgcn_readlane(__float_as_int(x), j)); }

namespace rw {
constexpr int CH = 32;
constexpr int L_X = 0, L_RKV = 32768, L_DAG = 57344, L_ACT = 81920, L_SC = 101888, L_PREV = 102400, L_MU = 104320, L_CST = 106240;
constexpr int ACT_WS = 144, ACT_GS = 336;
constexpr int L_ACTW = L_ACT, L_ACTA = L_ACT + 32 * ACT_WS, L_ACTG = L_ACT + 64 * ACT_WS, L_Y = L_ACT;
constexpr float LOG2E = 1.4426950408889634f, LN2 = 0.6931471805599453f;
typedef float f32x2 __attribute__((ext_vector_type(2)));
__device__ __forceinline__ float ex2(float x) { return __builtin_amdgcn_exp2f(x); }
__device__ __forceinline__ float lg2(float x) { return __builtin_amdgcn_logf(x); }
__device__ __forceinline__ float rcp(float x) { return __builtin_amdgcn_rcpf(x); }
__device__ __forceinline__ float sigmoid_f(float x) { return rcp(1.0f + ex2(-x * LOG2E)); }
template <int CTRL> __device__ __forceinline__ float dppf(float x) { return __int_as_float(__builtin_amdgcn_update_dpp(0, __float_as_int(x), CTRL, 0xF, 0xF, true)); }
__device__ __forceinline__ float row16_sum(float x) { x += dppf<0xB1>(x); x += dppf<0x4E>(x); x += dppf<0x141>(x); x += dppf<0x140>(x); return x; }
#define FMUL(a, b) ({ float d_; asm("v_mul_f32 %0, %1, %2" : "=v"(d_) : "v"(a), "v"(b)); d_; })
#define FFMA(a, b, c) ({ float d_; asm("v_fma_f32 %0, %1, %2, %3" : "=v"(d_) : "v"(a), "v"(b), "v"(c)); d_; })
#define RW_BAR() asm volatile("s_waitcnt lgkmcnt(0)\n\ts_barrier" ::: "memory")
struct Params { const float *mu, *w_up, *w0, *a_up, *a0, *g_up, *k_k, *k_a, *r_k, *lnx_w, *lnx_b; };

__device__ __forceinline__ bf16x8 load_bfrag(const float* W, int k0, int col) {
    float w[8];
#pragma unroll
    for (int j = 0; j < 8; ++j) w[j] = W[(size_t)(k0 + j) * 1024 + col];
    v4u p; p.x = pk2(w[0], w[1]); p.y = pk2(w[2], w[3]); p.z = pk2(w[4], w[5]); p.w = pk2(w[6], w[7]);
    return __builtin_bit_cast(bf16x8, p);
}
__device__ __forceinline__ int colbase(int chunk, int hc) { return chunk < 24 ? ZC_R + (chunk >> 3) * 1024 + hc + 8 * (chunk & 7) : ZC_XW + 8 * (chunk - 24); }
}
namespace rw2 {
constexpr int CH = 16;
constexpr int L_X = 0, L_RKV = 15360, L_E1 = 27648, L_ACT = 44032, L_OPS = 54016, L_BKT = 63232, L_SVT = 68352, L_LB = 73472, L_LKA = 74496, L_LRA = 75776, L_S0 = 77056,
              L_RHS = 86272, L_Y = 90368, L_SC = 94464, L_PREV = 94720, L_MU = 96640, L_CST = 98560;
constexpr int ACT_WS = 144, ACT_GS = 336, OPS = 144, T32S = 80;
constexpr int L_ACTW = L_ACT, L_ACTA = L_ACT + 16 * ACT_WS, L_ACTG = L_ACT + 32 * ACT_WS;
constexpr int L_KT = L_OPS, L_BT = L_OPS + 2304, L_KK = L_OPS + 4608, L_RT = L_OPS + 6912;
using rw::LOG2E; using rw::LN2; using rw::ex2; using rw::lg2; using rw::rcp; using rw::sigmoid_f; using rw::row16_sum; using rw::load_bfrag; using rw::colbase; using rw::Params;
#define RW2_BAR() asm volatile("s_waitcnt lgkmcnt(0)\n\ts_barrier" ::: "memory")
__device__ __forceinline__ bf16x8 ldfrag(const LAS unsigned char* p) { return *(const LAS bf16x8*)p; }
__device__ __forceinline__ void st16(LAS unsigned char* p, float x) { *(LAS unsigned short*)p = (unsigned short)f2bf(x); }
}
namespace rw9 {
typedef short s16x4 __attribute__((ext_vector_type(4)));
typedef __bf16 bfx4 __attribute__((ext_vector_type(4)));
__device__ __forceinline__ s16x4 pk4(const f32x4 x) { return __builtin_bit_cast(s16x4, __builtin_convertvector(x, bfx4)); }
constexpr int CH = 16, NCH = T / CH;
constexpr int A_RK = 0  , A_E1 = 12288  , A_ACT = 28672, A_MU = 38656, A_CST = 40576, A_END = 41856;
constexpr int H_OPS = 0, H_BKT = 9216, H_SVT = 14336, H_VF = 19456, H_GV = 23552, H_DC = 27648, H_SC = 27904, H_SIZE = 28160;
constexpr int H_BASE = A_END;
constexpr int B_S0 = H_BASE + 2 * H_SIZE, B_RHS = B_S0 + 9216  , B_Y = B_RHS + 4096, B_RK2 = B_Y + 4096  , B_END = B_RK2 + 12288;
static_assert(B_END <= 131072, "RWKV LDS map");
constexpr int ACT_WS = 144, ACT_GS = 336, OPS = 144, T32S = 80;
constexpr int A_ACTW = A_ACT, A_ACTA = A_ACT + 16 * ACT_WS, A_ACTG = A_ACT + 32 * ACT_WS;
using rw::LOG2E; using rw::LN2; using rw::ex2; using rw::lg2; using rw::rcp; using rw::sigmoid_f; using rw::row16_sum; using rw::load_bfrag; using rw::colbase; using rw::Params;
using rw2::ldfrag; using rw2::st16;
#define RW9_BAR() asm volatile("s_waitcnt lgkmcnt(0)\n\ts_barrier" ::: "memory")

__device__ __forceinline__ void rwkv_phase(const Params p, const bf16* Z, bf16* O, LAS unsigned char* lds, int tid_in, int u0, int ustep) {
    const int wave = __builtin_amdgcn_readfirstlane(tid_in >> 6);
    LAS float* E1 = (LAS float*)(lds + A_E1); LAS float* CUM = E1 + 1024; LAS float* AV = E1 + 2048; LAS float* GVa = E1 + 3072;
    LAS float* MU = (LAS float*)(lds + A_MU); LAS float* CST = (LAS float*)(lds + A_CST);
    LAS float* Yf = (LAS float*)(lds + B_Y); LAS float* Yf1 = (LAS float*)(lds + B_RHS);
    for (int u = u0; u < BATCH * 16; u += ustep) {
        const int b = u >> 4, h = u & 15, hc = h * 64;
        int tid = tid_in; asm volatile("" : "+v"(tid)); int lane = tid & 63;
        const int ct = wave & 3;
        bf16x8 Bw[2], Ba[2], Bg[5];
        { const int fn = lane & 15, fq = lane >> 4;
          if (wave < 4) {
#pragma unroll
              for (int ks = 0; ks < 2; ++ks) { Bw[ks] = load_bfrag(p.w_up, 32 * ks + 8 * fq, hc + 16 * ct + fn); Ba[ks] = load_bfrag(p.a_up, 32 * ks + 8 * fq, hc + 16 * ct + fn); }
          } else {
#pragma unroll
              for (int ks = 0; ks < 5; ++ks) Bg[ks] = load_bfrag(p.g_up, 32 * ks + 8 * fq, hc + 16 * ct + fn);
          } }
        const float w0c = p.w0[hc + 16 * ct + (lane & 15)], a0c = p.a0[hc + 16 * ct + (lane & 15)];
        if (tid < 480) { const int chunk = tid >> 3, j = tid & 7; const int mi = chunk < 24 ? (chunk >> 3) * 1024 + hc + 8 * (chunk & 7) + j : 3072 + 8 * (chunk - 24) + j; MU[tid] = p.mu[mi]; }
        if (tid < 320) { const int a = tid >> 6, j = tid & 63; const float* src = a == 0 ? p.k_k : a == 1 ? p.k_a : a == 2 ? p.r_k : a == 3 ? p.lnx_w : p.lnx_b; CST[tid] = src[hc + j]; }
        for (int q = tid; q < 576 + 640; q += NWAVES * 64) {
            const int off = q < 576 ? B_S0 + q * 16 : (q < 896 ? H_BASE + H_SVT + (q - 576) * 16 : H_BASE + H_SIZE + H_SVT + (q - 896) * 16); *(LAS v4u*)(lds + off) = zero4(); }
        f32x4 sacc0 = {0.f, 0.f, 0.f, 0.f}, sacc1 = {0.f, 0.f, 0.f, 0.f};
        v4u own[2], prv[2];
        const bf16* zb = Z + (size_t)(b * T) * ZP;
#define RW9_ITEMS() int it_t[2], it_c[2]; bool it_ok[2]; \
        if (tid < 384) { it_t[0] = tid / 24; it_c[0] = tid - 24 * it_t[0]; } else { it_t[0] = (tid - 384) >> 3; it_c[0] = 24 + (tid & 7); } it_ok[0] = true; \
        if (tid < 128) { it_t[1] = tid >> 3; it_c[1] = 32 + (tid & 7); it_ok[1] = true; } else { const int q_ = tid - 128; it_t[1] = q_ / 20; it_c[1] = 40 + q_ - 20 * it_t[1]; it_ok[1] = tid < 448; if (!it_ok[1]) { it_t[1] = 0; it_c[1] = 40; } }
#define RW9_FETCH(cc) _Pragma("unroll") for (int i = 0; i < 2; ++i) { const int ta = (cc) * CH + it_t[i]; const int cb = colbase(it_c[i], hc); \
            own[i] = it_ok[i] ? *(const GAS v4u*)(zb + (size_t)ta * ZP + cb) : zero4(); prv[i] = (it_ok[i] && ta > 0) ? *(const GAS v4u*)(zb + (size_t)(ta - 1) * ZP + cb) : zero4(); }
        { RW9_ITEMS(); RW9_FETCH(0); }
        f32x4 yacc = {0.f, 0.f, 0.f, 0.f}, racc = {0.f, 0.f, 0.f, 0.f};
        RW9_BAR();
        for (int it = -1; it <= NCH + 1; ++it) {
            tid = tid_in; asm volatile("" : "+v"(tid)); lane = tid & 63;
            const int fn = lane & 15, fq = lane >> 4, c4 = (tid & 15) * 4, tq = tid >> 4;
            const bool doA = it >= 0 && it < NCH, doB = it >= 1 && it <= NCH, doP2 = it + 1 < NCH, doPost = it >= 2;
            LAS unsigned char* const HA = lds + H_BASE + (it & 1) * H_SIZE;
            LAS unsigned char* const HB = lds + H_BASE + ((it & 1) ^ 1) * H_SIZE;
            if (doA) {
                if (wave < 4) {
                    f32x4 aw = {0.f, 0.f, 0.f, 0.f}, aa = aw;
#pragma unroll
                    for (int ks = 0; ks < 2; ++ks) {
                        aw = __builtin_amdgcn_mfma_f32_16x16x32_bf16(ldfrag(lds + A_ACTW + fn * ACT_WS + (32 * ks + 8 * fq) * 2), Bw[ks], aw, 0, 0, 0);
                        aa = __builtin_amdgcn_mfma_f32_16x16x32_bf16(ldfrag(lds + A_ACTA + fn * ACT_WS + (32 * ks + 8 * fq) * 2), Ba[ks], aa, 0, 0, 0); }
                    float e[4], cs[4];
#pragma unroll
                    for (int r = 0; r < 4; ++r) e[r] = 0.6065306597126334f * rcp(1.0f + ex2(-(aw[r] + w0c) * LOG2E));
                    cs[0] = e[0]; cs[1] = cs[0] + e[1]; cs[2] = cs[1] + e[2]; cs[3] = cs[2] + e[3];
                    const float run = cs[3];
                    float offs;
                    { auto r16 = __builtin_amdgcn_permlane16_swap(__float_as_uint(run), __float_as_uint(run), false, false);
                      const float ev = __uint_as_float(r16[0]), od = __uint_as_float(r16[1]);
                      const float ps = ev + od; auto r32 = __builtin_amdgcn_permlane32_swap(__float_as_uint(ps), __float_as_uint(ps), false, false);
                      offs = ((fq & 1) ? ev : 0.f) + ((fq & 2) ? __uint_as_float(r32[0]) : 0.f); }
#pragma unroll
                    for (int r = 0; r < 4; ++r) { const int idx = (4 * fq + r) * 64 + 16 * ct + fn; E1[idx] = e[r]; CUM[idx] = cs[r] + offs; AV[idx] = sigmoid_f(aa[r] + a0c); }
                } else {
                    f32x4 ag = {0.f, 0.f, 0.f, 0.f};
#pragma unroll
                    for (int ks = 0; ks < 5; ++ks) ag = __builtin_amdgcn_mfma_f32_16x16x32_bf16(ldfrag(lds + A_ACTG + fn * ACT_GS + (32 * ks + 8 * fq) * 2), Bg[ks], ag, 0, 0, 0);
                    #pragma unroll
                    for (int r = 0; r < 4; ++r) GVa[(4 * fq + r) * 64 + 16 * ct + fn] = ag[r];
                }
            }
            if (doB) {
                if (wave >= 4) {
                    const int vt = wave - 4;
                    f32x4 gkt = {0.f, 0.f, 0.f, 0.f}, grbt = gkt, grkt = gkt, gb = gkt, gbt = gkt; yacc = gkt; racc = gkt;
#pragma unroll
                    for (int ks = 0; ks < 2; ++ks) {
                        const bf16x8 fkt = ldfrag(HB + H_OPS + fn * OPS + (32 * ks + 8 * fq) * 2), fbt = ldfrag(HB + H_OPS + 2304 + fn * OPS + (32 * ks + 8 * fq) * 2);
                        const bf16x8 fkk = ldfrag(HB + H_OPS + 4608 + fn * OPS + (32 * ks + 8 * fq) * 2), frt = ldfrag(HB + H_OPS + 6912 + fn * OPS + (32 * ks + 8 * fq) * 2);
                        const bf16x8 sb_ = ldfrag(lds + B_S0 + (16 * vt + fn) * OPS + (32 * ks + 8 * fq) * 2);
                        gkt = __builtin_amdgcn_mfma_f32_16x16x32_bf16(fkk, fkt, gkt, 0, 0, 0);
                        grbt = __builtin_amdgcn_mfma_f32_16x16x32_bf16(fbt, frt, grbt, 0, 0, 0);
                        grkt = __builtin_amdgcn_mfma_f32_16x16x32_bf16(fkk, frt, grkt, 0, 0, 0);
                        yacc = __builtin_amdgcn_mfma_f32_16x16x32_bf16(frt, sb_, yacc, 0, 0, 0);
                        racc = __builtin_amdgcn_mfma_f32_16x16x32_bf16(fkt, sb_, racc, 0, 0, 0);
                        gb = __builtin_amdgcn_mfma_f32_16x16x32_bf16(fkt, fbt, gb, 0, 0, 0);
                        gbt = __builtin_amdgcn_mfma_f32_16x16x32_bf16(fbt, fkt, gbt, 0, 0, 0); }
                    racc = -racc;
                    f32x4 lkA, lrbA, lrkA;
#pragma unroll
                    for (int r = 0; r < 4; ++r) { const int i_ = 4 * fq + r; lkA[r] = (i_ < fn) ? -gkt[r] : 0.f; lrbA[r] = (i_ <= fn) ? grbt[r] : 0.f; lrkA[r] = (i_ <= fn) ? grkt[r] : 0.f; }
                    const s16x4 vB = *(const LAS s16x4*)(HB + H_SVT + (16 * vt + fn) * T32S + 32 + 8 * fq);
                    racc = __builtin_amdgcn_mfma_f32_16x16x16bf16_1k(pk4(lkA), vB, racc, 0, 0, 0);
                    { f32x4 Lm, Lt, Im;
#pragma unroll
                      for (int r = 0; r < 4; ++r) { const int t = 4 * fq + r; Lm[r] = (fn < t) ? gb[r] : 0.f; Lt[r] = (t < fn) ? gbt[r] : 0.f; Im[r] = (t == fn) ? 1.f : 0.f; }
                      const f32x4 z4 = {0.f, 0.f, 0.f, 0.f};
#define RW9_MM(MT, N) __builtin_amdgcn_mfma_f32_16x16x16bf16_1k(pk4(MT), pk4(N), z4, 0, 0, 0)
                      const f32x4 L2 = RW9_MM(Lt, Lm), L2t = RW9_MM(Lm, Lt);
                      const f32x4 L4 = RW9_MM(L2t, L2), L4t = RW9_MM(L2, L2t);
                      const f32x4 L8 = RW9_MM(L4t, L4);
                      const f32x4 F = RW9_MM(Im + L4t, Im + L8);
                      const f32x4 E = RW9_MM(Im + L2t, F) - Im;
                      const f32x4 ImLt = Im - Lt;
                      const f32x4 TT = ImLt + RW9_MM(E, ImLt);
#undef RW9_MM
                      f32x4 sa = z4;
#pragma unroll
                      for (int r = 0; r < 4; ++r) sa = __builtin_amdgcn_mfma_f32_16x16x4f32(TT[r], racc[r], sa, 0, 0, 0);
                      const s16x4 saB = pk4(sa);
                      yacc = __builtin_amdgcn_mfma_f32_16x16x16bf16_1k(pk4(lrbA), saB, yacc, 0, 0, 0);
                      yacc = __builtin_amdgcn_mfma_f32_16x16x16bf16_1k(pk4(lrkA), vB, yacc, 0, 0, 0);
                      LAS float* Yw = (it & 1) ? Yf1 : Yf;
#pragma unroll
                      for (int r = 0; r < 4; ++r) Yw[(4 * fq + r) * 64 + 16 * vt + fn] = yacc[r];
                      *(LAS s16x4*)(HB + H_SVT + (16 * vt + fn) * T32S + 8 * fq) = saB; }
                }
            }
            if (doPost && wave < 4) {
                const f32x4 lw = *(const LAS f32x4*)(CST + 192 + c4), lb = *(const LAS f32x4*)(CST + 256 + c4);
                const f32x4 y4 = *(const LAS f32x4*)(((it & 1) ? Yf : Yf1) + tq * 64 + c4), v4 = *(const LAS f32x4*)((LAS float*)(HA + H_VF) + tq * 64 + c4), g4 = *(const LAS f32x4*)((LAS float*)(HA + H_GV) + tq * 64 + c4);
                const float bo = ((const LAS float*)(HA + H_SC))[tq];
                const float mean = row16_sum((y4.x + y4.y) + (y4.z + y4.w)) * (1.f / 64.f);
                const f32x4 d = y4 - mean;
                const float var = row16_sum((d.x * d.x + d.y * d.y) + (d.z * d.z + d.w * d.w)) * (1.f / 64.f);
                const float rstd = __builtin_amdgcn_rsqf(var + 64e-5f);
                const f32x4 o = (d * rstd * lw + lb + v4 * bo) * g4;
                GAS unsigned long long* dst = (GAS unsigned long long*)(O + (size_t)(b * T + (it - 2) * CH + tq) * D + 1024 + hc + c4);
                *dst = (unsigned long long)pk2(o.x, o.y) | ((unsigned long long)pk2(o.z, o.w) << 32);
            }
            RW9_BAR();
            if (doA && wave < 4) {
                const LAS float* Rf = (const LAS float*)(lds + ((it & 1) ? B_RK2 : A_RK)); const LAS float* Kf = Rf + 1024; const LAS float* Vfa = Rf + 2048;
                const f32x4 kkc = *(const LAS f32x4*)(CST + c4), kac = *(const LAS f32x4*)(CST + 64 + c4), rkc = *(const LAS f32x4*)(CST + 128 + c4);
                const f32x4 k4 = *(const LAS f32x4*)(Kf + tq * 64 + c4), r4 = *(const LAS f32x4*)(Rf + tq * 64 + c4), v4 = *(const LAS f32x4*)(Vfa + tq * 64 + c4);
                *(LAS f32x4*)((LAS float*)(HA + H_VF) + tq * 64 + c4) = v4; *(LAS f32x4*)((LAS float*)(HA + H_GV) + tq * 64 + c4) = *(const LAS f32x4*)(GVa + tq * 64 + c4);
                const f32x4 e4 = *(const LAS f32x4*)(E1 + tq * 64 + c4), cm = *(const LAS f32x4*)(CUM + tq * 64 + c4), a4 = *(const LAS f32x4*)(AV + tq * 64 + c4);
                f32x4 kk = k4 * kkc;
                const float ss = row16_sum((kk.x * kk.x + kk.y * kk.y) + (kk.z * kk.z + kk.w * kk.w));
                const float inv = ss > 1e-24f ? __builtin_amdgcn_rsqf(ss) : 1e12f;
                kk = kk * inv;
                const f32x4 kmod = k4 * (1.0f + (a4 - 1.0f) * kac);
                const f32x4 bv = kk * a4;
                const f32x4 bo4 = kmod * r4 * rkc;
                const float bo = row16_sum((bo4.x + bo4.y) + (bo4.z + bo4.w));
                if ((tid & 15) == 0) ((LAS float*)(HA + H_SC))[tq] = bo;
                f32x4 em, ep, emx;
#pragma unroll
                for (int j = 0; j < 4; ++j) { em[j] = ex2(-cm[j] * LOG2E); ep[j] = rcp(em[j]); emx[j] = ex2((e4[j] - cm[j]) * LOG2E); }
                if (tq == CH - 1) *(LAS f32x4*)((LAS float*)(HA + H_DC) + c4) = em;
                const f32x4 okt = kk * emx, obt = bv * ep, okk = kmod * ep, ort = r4 * em;
                typedef unsigned u32x2 __attribute__((ext_vector_type(2)));
                *(LAS u32x2*)(HA + H_OPS + tq * OPS + c4 * 2) = (u32x2){pk2(okt.x, okt.y), pk2(okt.z, okt.w)};
                *(LAS u32x2*)(HA + H_OPS + 2304 + tq * OPS + c4 * 2) = (u32x2){pk2(obt.x, obt.y), pk2(obt.z, obt.w)};
                *(LAS u32x2*)(HA + H_OPS + 4608 + tq * OPS + c4 * 2) = (u32x2){pk2(okk.x, okk.y), pk2(okk.z, okk.w)};
                *(LAS u32x2*)(HA + H_OPS + 6912 + tq * OPS + c4 * 2) = (u32x2){pk2(ort.x, ort.y), pk2(ort.z, ort.w)};
#pragma unroll
                for (int j = 0; j < 4; ++j) { st16(HA + H_BKT + (c4 + j) * T32S + tq * 2, obt[j]); st16(HA + H_BKT + (c4 + j) * T32S + 32 + tq * 2, okk[j]); st16(HA + H_SVT + (c4 + j) * T32S + 32 + tq * 2, v4[j]); }
            }
            if (doB) {
                const int id0 = 2 * wave, vt = id0 >> 2, kt0 = id0 & 3;
                const bf16x8 af = ldfrag(HB + H_SVT + (16 * vt + fn) * T32S + fq * 16);
                const LAS float* DC = (const LAS float*)(HB + H_DC);
                sacc0 = __builtin_amdgcn_mfma_f32_16x16x32_bf16(af, ldfrag(HB + H_BKT + (16 * kt0 + fn) * T32S + fq * 16), sacc0, 0, 0, 0);
                sacc1 = __builtin_amdgcn_mfma_f32_16x16x32_bf16(af, ldfrag(HB + H_BKT + (16 * kt0 + 16 + fn) * T32S + fq * 16), sacc1, 0, 0, 0);
                sacc0 = sacc0 * DC[16 * kt0 + fn]; sacc1 = sacc1 * DC[16 * kt0 + 16 + fn];
#pragma unroll
                for (int r = 0; r < 4; ++r) { st16(lds + B_S0 + (16 * vt + 4 * fq + r) * OPS + (16 * kt0 + fn) * 2, sacc0[r]); st16(lds + B_S0 + (16 * vt + 4 * fq + r) * OPS + (16 * kt0 + 16 + fn) * 2, sacc1[r]); }
            }
            if (doP2) {
                LAS float* Rf = (LAS float*)(lds + ((it & 1) ? A_RK : B_RK2)); LAS float* Vfa = Rf + 2048;
                RW9_ITEMS();
#pragma unroll
                for (int i = 0; i < 2; ++i) if (it_ok[i]) {
                    const int t = it_t[i], chunk = it_c[i];
                    const f32x4 m0 = *(const LAS f32x4*)(MU + chunk * 8), m1 = *(const LAS f32x4*)(MU + chunk * 8 + 4);
                    float x[8];
                    { const unsigned cw[4] = {own[i].x, own[i].y, own[i].z, own[i].w}; const unsigned pw[4] = {prv[i].x, prv[i].y, prv[i].z, prv[i].w}; const float mm[8] = {m0.x, m0.y, m0.z, m0.w, m1.x, m1.y, m1.z, m1.w};
#pragma unroll
                      for (int j = 0; j < 4; ++j) { const float a0 = bflo(cw[j]), a1 = bfhi(cw[j]), q0 = bflo(pw[j]), q1 = bfhi(pw[j]);
                          x[2 * j] = a0 + (q0 - a0) * mm[2 * j]; x[2 * j + 1] = a1 + (q1 - a1) * mm[2 * j + 1]; } }
                    if (chunk < 24) { LAS float* dst = (chunk < 16 ? Rf + (chunk >> 3) * 1024 : Vfa) + t * 64 + 8 * (chunk & 7);
                        *(LAS f32x4*)dst = (f32x4){x[0], x[1], x[2], x[3]}; *(LAS f32x4*)(dst + 4) = (f32x4){x[4], x[5], x[6], x[7]}; }
                    else {
                        float y[8];
                        if (chunk < 32) {
#pragma unroll
                            for (int j = 0; j < 8; ++j) y[j] = 1.0f - 2.0f * rcp(ex2(x[j] * (2.0f * LOG2E)) + 1.0f);
                        } else if (chunk < 40) {
#pragma unroll
                            for (int j = 0; j < 8; ++j) y[j] = x[j];
                        } else {
#pragma unroll
                            for (int j = 0; j < 8; ++j) y[j] = sigmoid_f(x[j]);
                        }
                        v4u o; o.x = pk2(y[0], y[1]); o.y = pk2(y[2], y[3]); o.z = pk2(y[4], y[5]); o.w = pk2(y[6], y[7]);
                        const int off = chunk < 32 ? A_ACTW + t * ACT_WS + (chunk - 24) * 16 : chunk < 40 ? A_ACTA + t * ACT_WS + (chunk - 32) * 16 : A_ACTG + t * ACT_GS + (chunk - 40) * 16;
                        *(LAS v4u*)(lds + off) = o;
                    }
                }
                if (it + 2 < NCH) { RW9_FETCH(it + 2); }
            }
            RW9_BAR();
        }
    }
}
}
namespace sb {
using f32x16 = __attribute__((ext_vector_type(16))) float;
using s16x4 = __attribute__((ext_vector_type(4))) short;
constexpr int NSLOT = 3, SLOTB = 16384;
constexpr int LDS_K = 0, LDS_V = NSLOT * SLOTB, LDS_OST = 2 * NSLOT * SLOTB, LDS_CNT = LDS_OST + 8 * 4096;
constexpr float QSCALE = 0.125f * 1.4426950408889634f;
__device__ __forceinline__ int crow(int r, int hi) { return (r & 3) + 8 * (r >> 2) + 4 * hi; }
__device__ __forceinline__ void glds16(const void* gsrc, unsigned lds_dst) { unsigned keep;
    asm volatile("s_mov_b32 %0, m0\n\ts_mov_b32 m0, %2\n\ts_nop 0\n\tglobal_load_lds_dwordx4 %1, off\n\ts_mov_b32 m0, %0" : "=&s"(keep) : "v"(gsrc), "s"(lds_dst) : "memory"); }
#define SB_WAIT_BAR(N) asm volatile("s_waitcnt vmcnt(" #N ") lgkmcnt(0)\n\ts_barrier" ::: "memory")

__device__ __forceinline__ void qkt(f32x16& p0, f32x16& p1, const LAS unsigned char* Kslot, const bf16x8* qr, int r32, int hi) {
    const LAS unsigned char* kb = Kslot + hi * 1024 + r32 * 16;
    p0 = f32x16{}; p1 = f32x16{};
#pragma unroll
    for (int d0 = 0; d0 < 4; ++d0) {
        const bf16x8 b0 = *(const LAS bf16x8*)(kb + d0 * 2048);
        const bf16x8 b1 = *(const LAS bf16x8*)(kb + d0 * 2048 + 512);
        p0 = __builtin_amdgcn_mfma_f32_32x32x16_bf16(b0, qr[d0], p0, 0, 0, 0);
        p1 = __builtin_amdgcn_mfma_f32_32x32x16_bf16(b1, qr[d0], p1, 0, 0, 0);
    }
}
__device__ __forceinline__ void pv(f32x16* o, unsigned vb, bf16x8 pa0, bf16x8 pa1, bf16x8 pa2, bf16x8 pa3) {
#pragma unroll
    for (int d0 = 0; d0 < 2; ++d0) { s16x4 lo[4], hi[4];
#pragma unroll
        for (int ks = 0; ks < 4; ++ks) {
            asm volatile("ds_read_b64_tr_b16 %0,%1 offset:%c2" : "=&v"(lo[ks]) : "v"(vb), "i"(d0 * 4096 + ks * 1024) : "memory");
            asm volatile("ds_read_b64_tr_b16 %0,%1 offset:%c2" : "=&v"(hi[ks]) : "v"(vb), "i"(d0 * 4096 + ks * 1024 + 512) : "memory"); }
        asm volatile("s_waitcnt lgkmcnt(0)" ::: "memory"); __builtin_amdgcn_sched_barrier(0);
#define SB_PK(k) (bf16x8){lo[k][0], lo[k][1], lo[k][2], lo[k][3], hi[k][0], hi[k][1], hi[k][2], hi[k][3]}
        o[d0] = __builtin_amdgcn_mfma_f32_32x32x16_bf16(pa0, SB_PK(0), o[d0], 0, 0, 0);
        o[d0] = __builtin_amdgcn_mfma_f32_32x32x16_bf16(pa1, SB_PK(1), o[d0], 0, 0, 0);
        o[d0] = __builtin_amdgcn_mfma_f32_32x32x16_bf16(pa2, SB_PK(2), o[d0], 0, 0, 0);
        o[d0] = __builtin_amdgcn_mfma_f32_32x32x16_bf16(pa3, SB_PK(3), o[d0], 0, 0, 0);
#undef SB_PK
    }
}
__device__ __forceinline__ unsigned cvtpk(float lo, float hi) { unsigned r; asm("v_cvt_pk_bf16_f32 %0, %1, %2" : "=v"(r) : "v"(lo), "v"(hi)); return r; }

template <bool MASK> __device__ __forceinline__ void sb_weights(f32x16& P0, f32x16& P1, float& Pr, int kvrel0, int hi) {
#pragma unroll
    for (int r = 0; r < 32; ++r) {
        const float z = r < 16 ? P0[r] : P1[r - 16];
        float kp = __builtin_amdgcn_rcpf(1.0f + __builtin_amdgcn_exp2f(z));
        if (MASK) { if (kvrel0 >= -((r & 3) + 8 * ((r & 15) >> 2) + 32 * (r >> 4))) kp = 1.0f; }
        if (r < 16) P0[r] = kp; else P1[r - 16] = kp;
    }
#define SB_KP(r) ((r) < 16 ? P0[(r)] : P1[(r) - 16])
    float gt[8];
#pragma unroll
    for (int g = 0; g < 8; ++g) gt[g] = (SB_KP(4 * g + 3) * SB_KP(4 * g + 2)) * (SB_KP(4 * g + 1) * SB_KP(4 * g));
    float sg[8]; float run = Pr;
#pragma unroll
    for (int g = 7; g >= 0; --g) {
        auto rr = __builtin_amdgcn_permlane32_swap(__float_as_uint(gt[g]), __float_as_uint(gt[g]), false, false);
        const float lo_t = __uint_as_float(rr[0]), up_t = __uint_as_float(rr[1]);
        const float s_up = run;
        const float s_lo = run * up_t;
        run = s_lo * lo_t;
        sg[g] = hi ? s_up : s_lo;
    }
    Pr = run;
#pragma unroll
    for (int g = 0; g < 8; ++g) {
        const float t4 = sg[g], t3 = t4 * SB_KP(4 * g + 3), t2 = t3 * SB_KP(4 * g + 2), t1 = t2 * SB_KP(4 * g + 1), t0 = t1 * SB_KP(4 * g);
        const float w3 = t4 - t3, w2 = t3 - t2, w1 = t2 - t1, w0 = t1 - t0;
        if (g < 4) { P0[4 * g] = w0; P0[4 * g + 1] = w1; P0[4 * g + 2] = w2; P0[4 * g + 3] = w3; } else { P1[4 * g - 16] = w0; P1[4 * g - 15] = w1; P1[4 * g - 14] = w2; P1[4 * g - 13] = w3; }
    }
#undef SB_KP
}

__device__ __forceinline__ void attn_unit(int b, int h, int qb, const bf16* Z, bf16* O, LAS unsigned char* lds, int tid_in) {
    int tid = tid_in; asm volatile("" : "+v"(tid));
    const int lane = tid & 63, r32 = lane & 31, hi = lane >> 5; const int wid = __builtin_amdgcn_readfirstlane(tid >> 6);
    const size_t rowbase = (size_t)b * T; const int q0 = qb * 256;
    const bf16* Qw = Z + (rowbase + q0 + wid * 32) * ZP + ZC_Q + h * 64;
    const bf16* Kh = Z + rowbase * ZP + ZC_K + h * 64; const bf16* Vh = Z + rowbase * ZP + ZC_V + h * 64;
    const unsigned lds0 = (unsigned)(size_t)lds;
    LAS unsigned* CNT = (LAS unsigned*)(lds + LDS_CNT);
    if (tid < 3) CNT[tid] = 0u;
    const bf16* ksrc = Kh + (size_t)lane * ZP + wid * 8;
    const bf16* vsrc = Vh + (size_t)(16 * (wid & 3) + (lane >> 2)) * ZP + (wid >> 2) * 32 + (lane & 3) * 8;
    const unsigned kdst = lds0 + LDS_K + wid * 1024, vdst = lds0 + LDS_V + wid * 1024;
#define SB_DMA_K(j, so) glds16(ksrc + (size_t)(j) * 64 * ZP, (unsigned)__builtin_amdgcn_readfirstlane(kdst + (so)))
#define SB_DMA_V(j, so) glds16(vsrc + (size_t)(j) * 64 * ZP, (unsigned)__builtin_amdgcn_readfirstlane(vdst + (so)))
    const int NT = (q0 + 256) / 128;
#define SB_DMA2(J, so) do { SB_DMA_K(2 * (J) + 1, (so)); SB_DMA_V(2 * (J) + 1, (so)); SB_DMA_K(2 * (J), (so) + 8192); SB_DMA_V(2 * (J), (so) + 8192); } while (0)
    SB_DMA2(NT - 1, 0); if (NT > 1) SB_DMA2(NT - 2, SLOTB);
    bf16x8 qr[4];
#pragma unroll
    for (int d0 = 0; d0 < 4; ++d0) qr[d0] = *(const GAS bf16x8*)(Qw + (size_t)r32 * ZP + d0 * 16 + hi * 8);
    asm volatile("" : "+v"(qr[0]), "+v"(qr[1]), "+v"(qr[2]), "+v"(qr[3]));
    f32x16 o[2]; o[0] = f32x16{}; o[1] = f32x16{};
    float Pr = 1.0f; bool wdone = false;
    const int tq = q0 + wid * 32 + r32, tmin = q0 + wid * 32, tmax = tmin + 31;
    const unsigned vb0 = lds0 + LDS_V + ((lane >> 4) & 1) * 32 + (lane & 3) * 8 + (4 * hi + ((lane & 15) >> 2)) * 64;
    int so_cur = 0, so_n2 = 2 * SLOTB;
    for (int i = 0; i < NT; ++i) {
        const int j = NT - 1 - i;
        if (i + 1 < NT) { SB_WAIT_BAR(4); } else { SB_WAIT_BAR(0); }
        if (i > 0) { const unsigned votes = CNT[(i - 1) % 3]; if (votes == 8u) break; }
        if (tid == 0) CNT[(i + 1) % 3] = 0u;
        if (i + 2 < NT) SB_DMA2(j - 2, so_n2);
#pragma unroll
        for (int sub = 0; sub < 2; ++sub) {
            const int kv0 = 128 * j + 64 * (1 - sub), so_t = so_cur + sub * 8192;
            if (kv0 < tmax && !wdone) {
                f32x16 P0, P1;
                qkt(P0, P1, lds + LDS_K + so_t, qr, r32, hi);
                if (kv0 + 63 >= tmin) sb_weights<true>(P0, P1, Pr, kv0 - tq + 4 * hi, hi); else sb_weights<false>(P0, P1, Pr, 0, hi);
                v4u pw0, pw1, pw2, pw3;
                pw0.x = cvtpk(P0[0], P0[1]); pw0.y = cvtpk(P0[2], P0[3]); pw0.z = cvtpk(P0[4], P0[5]); pw0.w = cvtpk(P0[6], P0[7]);
                pw1.x = cvtpk(P0[8], P0[9]); pw1.y = cvtpk(P0[10], P0[11]); pw1.z = cvtpk(P0[12], P0[13]); pw1.w = cvtpk(P0[14], P0[15]);
                pw2.x = cvtpk(P1[0], P1[1]); pw2.y = cvtpk(P1[2], P1[3]); pw2.z = cvtpk(P1[4], P1[5]); pw2.w = cvtpk(P1[6], P1[7]);
                pw3.x = cvtpk(P1[8], P1[9]); pw3.y = cvtpk(P1[10], P1[11]); pw3.z = cvtpk(P1[12], P1[13]); pw3.w = cvtpk(P1[14], P1[15]);
                pv(o, vb0 + so_t, __builtin_bit_cast(bf16x8, pw0), __builtin_bit_cast(bf16x8, pw1), __builtin_bit_cast(bf16x8, pw2), __builtin_bit_cast(bf16x8, pw3));
                wdone = __all(Pr == 0.0f);
            }
        }
        if (wdone && lane == 0) __hip_atomic_fetch_add(CNT + (i % 3), 1u, __ATOMIC_RELAXED, __HIP_MEMORY_SCOPE_WORKGROUP);
        so_cur = (so_cur == 2 * SLOTB) ? 0 : so_cur + SLOTB; so_n2 = (so_n2 == 2 * SLOTB) ? 0 : so_n2 + SLOTB;
    }
    { LAS bf16* stg = (LAS bf16*)(lds + LDS_OST) + wid * 2048;
#pragma unroll
      for (int r = 0; r < 16; ++r) { const int orow = crow(r, hi);
#pragma unroll
          for (int d0 = 0; d0 < 2; ++d0) stg[orow * 64 + d0 * 32 + r32] = (bf16)f2bf(o[d0][r]); }
      asm volatile("s_waitcnt lgkmcnt(0)" ::: "memory");
      bf16* Ow = O + (rowbase + q0 + wid * 32) * D + h * 64;
#pragma unroll
      for (int i = 0; i < 4; ++i) { const int row = i * 8 + (lane >> 3), ch = lane & 7; const v4u v = *(const LAS v4u*)(stg + row * 64 + ch * 8); *(GAS v4u*)(Ow + (size_t)row * D + ch * 8) = v; } }
    asm volatile("s_waitcnt vmcnt(0) lgkmcnt(0)\n\ts_barrier" ::: "memory");
#undef SB_DMA2
#undef SB_DMA_K
#undef SB_DMA_V
}
__device__ __forceinline__ void attn_phase(const bf16* Z, bf16* O, LAS unsigned char* lds, int tid, int G) {
    for (int bh = blockIdx.x; bh < BATCH * 16; bh += G)
        for (int qb = 7; qb >= 0; --qb) attn_unit(bh >> 4, bh & 15, qb, Z, O, lds, tid);
}
}
namespace sg {
using f32x16 = __attribute__((ext_vector_type(16))) float;
using s16x4 = __attribute__((ext_vector_type(4))) short;
typedef unsigned u32x2 __attribute__((ext_vector_type(2)));
constexpr int XS_STRIDE = 576, WS_STRIDE = 272, PT_STRIDE = 36  ;
static_assert(8 * 64 * PT_STRIDE * 4 <= 128 * XS_STRIDE, "patches fit the X image");
constexpr int L_XS = 0, L_WS = 128 * XS_STRIDE, L_STAT = L_WS + 128 * WS_STRIDE, L_BS = L_STAT + 1024;
#define SG_BAR() asm volatile("s_waitcnt lgkmcnt(0)\n\ts_barrier" ::: "memory")
__device__ __forceinline__ int crow(int r, int hi) { return (r & 3) + 8 * (r >> 2) + 4 * hi; }

__device__ __forceinline__ void sgu_phase(const float* ln_g, const float* ln_b, const float* w_s, const float* b_s, const bf16* ZC, bf16* O, LAS unsigned char* lds, int tid_in, int G) {
    LAS float* STAT = (LAS float*)(lds + L_STAT); LAS float* BS = (LAS float*)(lds + L_BS);
    for (int bn = blockIdx.x; bn < BATCH * 16; bn += G) {
        int tid = tid_in; asm volatile("" : "+v"(tid));
        const int lane = tid & 63, wave = __builtin_amdgcn_readfirstlane(tid >> 6), r32 = lane & 31, hi = lane >> 5;
        const size_t rowbase = (size_t)bn * 128;
#pragma unroll 2
        for (int rr = 0; rr < 16; ++rr) {
            const int row = 16 * wave + rr;
            const GAS v4u* vr = (const GAS v4u*)(ZC + (rowbase + row) * 4096 + 2048) + lane;
            float x[32]; float s = 0.f;
#pragma unroll
            for (int j = 0; j < 4; ++j) { const v4u w = vr[64 * j];
                x[8 * j + 0] = bflo(w.x); x[8 * j + 1] = bfhi(w.x); x[8 * j + 2] = bflo(w.y); x[8 * j + 3] = bfhi(w.y); x[8 * j + 4] = bflo(w.z); x[8 * j + 5] = bfhi(w.z); x[8 * j + 6] = bflo(w.w); x[8 * j + 7] = bfhi(w.w); }
#pragma unroll
            for (int j = 0; j < 32; ++j) s += x[j];
            const float mean = wave_sum(s) * (1.f / 2048.f); float q = 0.f;
#pragma unroll
            for (int j = 0; j < 32; ++j) { const float d = x[j] - mean; q += d * d; }
            const float rstd = 1.0f / sqrtf(wave_sum(q) * (1.f / 2048.f) + 1e-5f);
            if (lane == 0) { STAT[2 * row] = mean; STAT[2 * row + 1] = rstd; }
        }
        SG_BAR();
        const int cc = tid & 31;
        v4u xv[8];
#define SG_FETCH(gg) do { unsigned vo_ = (unsigned)(((tid >> 5) * 4096 + 8 * cc) * 2); asm volatile("" : "+v"(vo_));     \
            const GAS unsigned char* zb_ = (const GAS unsigned char*)(ZC + rowbase * 4096 + 2048 + 256 * (gg)); \
            _Pragma("unroll") for (int i = 0; i < 8; ++i) xv[i] = *(const GAS v4u*)(zb_ + (size_t)i * (16 * 4096 * 2) + vo_); } while (0)
        SG_FETCH(0);
#pragma unroll 1
        for (int g = 0; g < 8; ++g) {
            f32x4 wv[8];
#pragma unroll
            for (int i = 0; i < 8; ++i) { const int id = tid + 512 * i, s = id >> 5; wv[i] = *(const GAS f32x4*)(w_s + ((size_t)g * 128 + s) * 128 + 4 * cc); }
            const f32x4 lg0 = *(const GAS f32x4*)(ln_g + 256 * g + 8 * cc), lg1 = *(const GAS f32x4*)(ln_g + 256 * g + 8 * cc + 4);
            const f32x4 lb0 = *(const GAS f32x4*)(ln_b + 256 * g + 8 * cc), lb1 = *(const GAS f32x4*)(ln_b + 256 * g + 8 * cc + 4);
            if (tid < 128) BS[tid] = b_s[g * 128 + tid];
#pragma unroll
            for (int i = 0; i < 8; ++i) { const int id = tid + 512 * i, s = id >> 5;
                const float mean = STAT[2 * s], rstd = STAT[2 * s + 1];
                const v4u w = xv[i];
                const f32x4 a0 = ((f32x4){bflo(w.x), bfhi(w.x), bflo(w.y), bfhi(w.y)} - mean) * rstd * lg0 + lb0;
                const f32x4 a1 = ((f32x4){bflo(w.z), bfhi(w.z), bflo(w.w), bfhi(w.w)} - mean) * rstd * lg1 + lb1;
                v4u o; o.x = pk2(a0.x, a0.y); o.y = pk2(a0.z, a0.w); o.z = pk2(a1.x, a1.y); o.w = pk2(a1.z, a1.w);
                *(LAS v4u*)(lds + L_XS + s * XS_STRIDE + cc * 16) = o;
                u32x2 p; p.x = pk2(wv[i].x, wv[i].y); p.y = pk2(wv[i].z, wv[i].w);
                *(LAS u32x2*)(lds + L_WS + s * WS_STRIDE + cc * 8) = p; }
            SG_BAR();
            if (g < 7) SG_FETCH(g + 1);
            f32x16 acc[4];
#pragma unroll
            for (int tt = 0; tt < 4; ++tt) acc[tt] = f32x16{};
            const unsigned xb = (unsigned)(size_t)(lds + L_XS) + (8 * hi + ((lane & 15) >> 2)) * XS_STRIDE + (32 * wave + 16 * ((lane >> 4) & 1) + 4 * (lane & 3)) * 2;
            const unsigned xb4 = xb + 4 * XS_STRIDE;
            const LAS unsigned char* wb = lds + L_WS + r32 * WS_STRIDE + 16 * hi;
#pragma unroll
            for (int ks = 0; ks < 8; ++ks) {
                s16x4 lo, up;
                asm volatile("ds_read_b64_tr_b16 %0,%1 offset:%c2" : "=&v"(lo) : "v"(xb), "i"(ks * 16 * XS_STRIDE) : "memory");
                asm volatile("ds_read_b64_tr_b16 %0,%1 offset:%c2" : "=&v"(up) : "v"(xb4), "i"(ks * 16 * XS_STRIDE) : "memory");
                bf16x8 af[4];
#pragma unroll
                for (int tt = 0; tt < 4; ++tt) if (tt >= 2 || ks < 4) af[tt] = *(const LAS bf16x8*)(wb + tt * 32 * WS_STRIDE + ks * 32);
                asm volatile("s_waitcnt lgkmcnt(0)" ::: "memory"); __builtin_amdgcn_sched_barrier(0);
                const bf16x8 bfr = (bf16x8){lo[0], lo[1], lo[2], lo[3], up[0], up[1], up[2], up[3]};
#pragma unroll
                for (int tt = 0; tt < 4; ++tt) if (tt >= 2 || ks < 4) acc[tt] = __builtin_amdgcn_mfma_f32_32x32x16_bf16(af[tt], bfr, acc[tt], 0, 0, 0);
            }
            const size_t ccol = (size_t)(256 * g + 32 * wave + 8 * (lane & 3));
            v4u uq[4];
#pragma unroll
            for (int j = 0; j < 4; ++j) uq[j] = *(const GAS v4u*)(ZC + (rowbase + 16 * j + (lane >> 2)) * 4096 + ccol);
            SG_BAR();
            LAS float* PT = (LAS float*)(lds + L_XS + wave * (64 * PT_STRIDE * 4));
#pragma unroll
            for (int half = 0; half < 2; ++half) {
#pragma unroll
                for (int t2 = 0; t2 < 2; ++t2)
#pragma unroll
                    for (int r = 0; r < 16; ++r) { const int tl = 32 * t2 + crow(r, hi); PT[tl * PT_STRIDE + r32] = acc[2 * half + t2][r] + BS[64 * half + tl]; }
                asm volatile("s_waitcnt lgkmcnt(0)" ::: "memory");
                v4u un[4];
                if (half == 0) {
#pragma unroll
                    for (int j = 0; j < 4; ++j) un[j] = *(const GAS v4u*)(ZC + (rowbase + 64 + 16 * j + (lane >> 2)) * 4096 + ccol); }
#pragma unroll
                for (int j = 0; j < 4; ++j) { const int tl = 16 * j + (lane >> 2);
                    const f32x4 m0 = *(const LAS f32x4*)(PT + tl * PT_STRIDE + 8 * (lane & 3)), m1 = *(const LAS f32x4*)(PT + tl * PT_STRIDE + 8 * (lane & 3) + 4);
                    const v4u w = uq[j];
                    v4u o; o.x = pk2(m0.x * bflo(w.x), m0.y * bfhi(w.x)); o.y = pk2(m0.z * bflo(w.y), m0.w * bfhi(w.y)); o.z = pk2(m1.x * bflo(w.z), m1.y * bfhi(w.z)); o.w = pk2(m1.z * bflo(w.w), m1.w * bfhi(w.w));
                    *(GAS v4u*)(O + (rowbase + 64 * half + tl) * D + ccol) = o; }
                if (half == 0) {
#pragma unroll
                    for (int j = 0; j < 4; ++j) uq[j] = un[j]; }
                asm volatile("s_waitcnt lgkmcnt(0)" ::: "memory");
            }
            SG_BAR();
        }
    }
}
}
#define AS4 __attribute__((address_space(4)))
__device__ __forceinline__ const AS4 unsigned char* kargs() { const AS4 unsigned char* kp = (const AS4 unsigned char*)__builtin_amdgcn_kernarg_segment_ptr(); asm volatile("" : "+s"(kp)); return kp; }
__device__ __forceinline__ const float* arg_in(int k) { return *(const float* const AS4*)(kargs() + 8 * k); }
__device__ __forceinline__ float* arg_out() { return *(float* const AS4*)(kargs() + 200); }
__device__ __forceinline__ unsigned char* arg_ws() { return *(unsigned char* const AS4*)(kargs() + 208); }
static_assert(sizeof(Args) == 224, "Args layout: in[25] | out | ws | ph_lo | ph_hi");
#ifndef MK_ONE_LAUNCH
#define MK_ONE_LAUNCH 1
#endif
#ifndef MK_PROBE_DUP
#define MK_PROBE_DUP 0
#endif
#define DUP(k) for (int rep_ = 0; rep_ < 1 + ((MK_PROBE_DUP >> (k)) & 1); ++rep_)
__global__ void __launch_bounds__(NWAVES * 64, 2) fwd(Args a) {
    extern __shared__ __attribute__((aligned(16))) unsigned char lds_raw[];
    LAS unsigned char* lds = (LAS unsigned char*)lds_raw;
    const int wave = __builtin_amdgcn_readfirstlane((int)threadIdx.x >> 6), G = gridDim.x;
    for (int u = threadIdx.x; u < (LDS_BYTES - LDSCTL_OFF) / 4; u += NWAVES * 64) ((LAS unsigned*)(lds + LDSCTL_OFF))[u] = 0u;
    __syncthreads();
    XcdBarrier bar; bar.bar = (unsigned*)(arg_ws() + WS_CTL) + CW_BAR; bar.x = 0; bar.st = nullptr;
    if (MK_ONE_LAUNCH) bar = xcd_barrier_post((unsigned*)(arg_ws() + WS_CTL) + CW_BAR, (volatile LAS unsigned*)(lds + MISC_OFF) + 8);
    const int lo = a.ph_lo, hi = a.ph_hi;
#define IN(k) (lo <= (k) && (k) < hi)
#define SEAM(k) do { if (MK_ONE_LAUNCH && IN(k) && IN((k) + 1)) xcd_barrier(bar); } while (0)
#pragma unroll 1
    for (int L = 0; L < DEPTH; ++L) {
        const int pb = 8 * L, i = L >> 1; const bool even = !(L & 1);
#define FRESH_TID() int lane; asm volatile("v_mbcnt_lo_u32_b32 %0, -1, 0\n\tv_mbcnt_hi_u32_b32 %0, -1, %0" : "=v"(lane)); const int tid = wave * 64 + lane; (void)tid
        unsigned char* const ws = arg_ws();
        bf16* const H = (bf16*)(ws + WS_H); bf16* const BIG = (bf16*)(ws + WS_BIG);
        if (IN(pb + 0)) { FRESH_TID();
            const float* Win; const float* Wout; int Nin;
            if (even) { Win = arg_in(4) + (size_t)i * D * EVEN_N; Wout = arg_in(16) + (size_t)i * D * D; Nin = EVEN_N; } else { Win = arg_in(17) + (size_t)i * D * 4096; Wout = arg_in(22) + (size_t)i * D * D; Nin = 4096; }
            const float* x0 = nullptr; if (L == 0) x0 = arg_in(0);
            DUP(0) prep_phase(Win, Nin, Wout, arg_in(23) + (size_t)L * D * FF, arg_in(24) + (size_t)L * FF * D, x0, arg_in(1) + (size_t)L * D, arg_in(2) + (size_t)L * D, ws, even, lds, wave, lane, tid, G); SEAM(pb + 0); }
        if (IN(pb + 1)) { FRESH_TID();
            bf16* const WA = (bf16*)(ws + WS_WA);
            bf16* const XB = (bf16*)(ws + WS_XB); const float* const SSQ = (const float*)(ws + WS_SSQ);
            if (even) { pg8::Gemm g{XB, WA, M, ZP, D}; pg8::StaticOrder S; S.init(M, ZP, G, (int)blockIdx.x, 8); const int pm0 = pg8::rs_table(SSQ, S, lds, tid); pg8::EpiActS<0> E{BIG, ZP, 4, sb::QSCALE, (const LAS float*)(lds + pg8::LX_RS), pm0};
                DUP(5) pg8::gemm_phase<pg8::EpiActS<0>, pg8::StaticOrder, true, true>(lds, g, S, E, tid); }
            else { pg8::Gemm g{XB, WA, M, 4096, D}; pg8::StaticOrder S; S.init(M, 4096, G, (int)blockIdx.x, 8); const int pm0 = pg8::rs_table(SSQ, S, lds, tid); pg8::EpiActS<1> E{BIG, 4096, 0, 1.f, (const LAS float*)(lds + pg8::LX_RS), pm0};
                DUP(5) pg8::gemm_phase<pg8::EpiActS<1>, pg8::StaticOrder, true, true>(lds, g, S, E, tid); }
            SEAM(pb + 1);
        }
        if (IN(pb + 2)) { FRESH_TID();
            if (even) { DUP(1) sb::attn_phase(BIG, H, lds, tid, G); }
            else DUP(3) sg::sgu_phase(arg_in(18) + (size_t)i * 2048, arg_in(19) + (size_t)i * 2048, arg_in(20) + (size_t)i * 131072, arg_in(21) + (size_t)i * 1024, BIG, H, lds, tid, G);
        }
        if (IN(pb + 3)) { FRESH_TID();
            if (even) { const rw::Params q{arg_in(5) + (size_t)i * RWS, arg_in(6) + (size_t)i * 65536, arg_in(7) + (size_t)i * 1024, arg_in(8) + (size_t)i * 65536, arg_in(9) + (size_t)i * 1024, arg_in(10) + (size_t)i * 163840,
                    arg_in(11) + (size_t)i * 1024, arg_in(12) + (size_t)i * 1024, arg_in(13) + (size_t)i * 1024, arg_in(14) + (size_t)i * 1024, arg_in(15) + (size_t)i * 1024};
                DUP(2) rw9::rwkv_phase(q, BIG, H, lds, tid, (int)blockIdx.x, G); }
            SEAM(pb + 3); }
        if (IN(pb + 4)) { FRESH_TID(); pg8::Gemm g{H, (bf16*)(ws + WS_WB), M, D, D}; pg8::StaticOrder S; S.init(M, D, G, (int)blockIdx.x); pg8::EpiResidB E{(bf16*)(ws + WS_XB), (float*)(ws + WS_SSQ), D, lds};
            pg8::gemm_phase<pg8::EpiResidB, pg8::StaticOrder, true, true>(lds, g, S, E, tid); SEAM(pb + 4); }
        if (IN(pb + 6)) { FRESH_TID(); pg8::Gemm g{(bf16*)(ws + WS_XB), (bf16*)(ws + WS_W1), M, FF, D}; pg8::StaticOrder S; S.init(M, FF, G, (int)blockIdx.x, 8); const int pm0 = pg8::rs_table((const float*)(ws + WS_SSQ), S, lds, tid); pg8::EpiActS<2> E{BIG, FF, 0, 1.f, (const LAS float*)(lds + pg8::LX_RS), pm0};
            DUP(6) pg8::gemm_phase<pg8::EpiActS<2>, pg8::StaticOrder, true, true>(lds, g, S, E, tid); SEAM(pb + 6); }
        if (IN(pb + 7)) { FRESH_TID(); pg8::Gemm g{BIG, (bf16*)(ws + WS_W2), M, D, FF}; pg8::StaticOrder S; S.init(M, D, G, (int)blockIdx.x); pg8::EpiResidB E{(bf16*)(ws + WS_XB), (float*)(ws + WS_SSQ), D, lds};
            pg8::gemm_phase<pg8::EpiResidB, pg8::StaticOrder, true, true>(lds, g, S, E, tid); SEAM(pb + 7); }
    }
    if (IN(32)) { const int gw = blockIdx.x * NWAVES + wave, NGW = G * NWAVES; int lane; asm volatile("v_mbcnt_lo_u32_b32 %0, -1, 0\n\tv_mbcnt_hi_u32_b32 %0, -1, %0" : "=v"(lane)); float* const xo = arg_out(); const float* gf = arg_in(3); const bf16* const XB = (const bf16*)(arg_ws() + WS_XB);
        for (int m = gw; m < M; m += NGW) rms_row_out(XB + (size_t)m * D, gf, xo + (size_t)m * D, lane); }
#undef IN
#undef SEAM
}

extern "C" void kernel_launch(void* const* d_in, const int* in_sizes, int n_in, void* d_out, int out_size, void* d_ws, size_t ws_size, hipStream_t stream) {
    static int grid = 0;
    if (grid == 0) {
        if (n_in != 25 || out_size != M * D || ws_size < WS_END) { fprintf(stderr, "kernel_launch: unexpected shapes (n_in %d, out %d, ws %zu)\n", n_in, out_size, ws_size); grid = -1; return; }
        int dev = 0, cus = 0, per_cu = 0;
        if (hipGetDevice(&dev) != hipSuccess || hipDeviceGetAttribute(&cus, hipDeviceAttributeMultiprocessorCount, dev) != hipSuccess) { grid = -1; return; }
        if (hipFuncSetAttribute((const void*)fwd, hipFuncAttributeMaxDynamicSharedMemorySize, LDS_BYTES) != hipSuccess) { fprintf(stderr, "kernel_launch: hipFuncSetAttribute failed\n"); grid = -1; return; }
        if (hipOccupancyMaxActiveBlocksPerMultiprocessor(&per_cu, (const void*)fwd, NWAVES * 64, LDS_BYTES) != hipSuccess || per_cu < 1) fprintf(stderr, "kernel_launch: occupancy query reports %d\n", per_cu);
        (void)hipGetLastError();
        grid = cus;
    }
    if (grid < 0) return;
    (void)hipMemsetAsync((char*)d_ws + WS_CTL, 0, CTL_ZERO_BYTES, stream);
    Args a{};
    for (int i = 0; i < 25; ++i) a.in[i] = (const float*)d_in[i];
    a.out = (float*)d_out; a.ws = (unsigned char*)d_ws;
#if MK_ONE_LAUNCH
    a.ph_lo = 0; a.ph_hi = NPH;
    hipLaunchKernelGGL(fwd, dim3(grid), dim3(NWAVES * 64), LDS_BYTES, stream, a);
#else
    for (int p = 0; p < NPH; ++p) { a.ph_lo = p; a.ph_hi = p + 1;
        hipLaunchKernelGGL(fwd, dim3(grid), dim3(NWAVES * 64), LDS_BYTES, stream, a); }
#endif
}
```

```cpp
#include <hip/hip_runtime.h>
#include <cstdio>
#include <cstdint>
namespace pg8 {
#define PG8_LAS __attribute__((address_space(3)))
typedef unsigned short bf16_t;
typedef short bf16x8 __attribute__((ext_vector_type(8)));
typedef float f32x4 __attribute__((ext_vector_type(4)));
typedef unsigned u32x4 __attribute__((ext_vector_type(4)));
constexpr int BM = 256, BK = 64, HALF = 128, HTB = HALF * BK * 2  , STAGE_BYTES = 8 * HTB, NXCD = 8, WGM = 8;

__host__ __device__ __forceinline__ int lds_byte(int r, int c) { const int st = (r >> 4) * 2 + (c >> 5), rr = r & 15, cc = c & 31, ob = rr * 64 + cc * 2; return st * 1024 + (ob ^ (((ob >> 9) & 1) << 5)); }
__host__ __device__ __forceinline__ void stage_rc(int b, int& R, int& C) { const int st = b / 1024, sb = b % 1024, swz = sb ^ (((sb >> 9) & 1) << 5); R = (st >> 1) * 16 + swz / 64; C = (st & 1) * 32 + (swz % 64) / 2; }
__host__ __device__ __forceinline__ int perm32(int rho) { const int n = rho >> 4, i = rho & 15; return 8 * (i >> 2) + 4 * n + (i & 3); }

struct Unit { int pm, pn; };
struct Gemm { const bf16_t* A; const bf16_t* Bt; int M, N, K; };

struct StaticOrder {
    int nM, nN, nwg, G, c;
    int wgm = 4;
    __host__ __device__ void init(int M, int N, int G_, int c_, int wgm_ = 4) { nM = M / BM; nN = N / BM; nwg = nM * nN; G = G_; c = c_; wgm = wgm_; }
    __host__ __device__ bool next(int i, Unit& u) const {
        const long L = (long)i * G + c; if (L >= nwg) return false;
        int wgid = (int)L; { const int q = nwg / NXCD, r = nwg % NXCD, xcd = wgid % NXCD, off = wgid / NXCD; wgid = (xcd < r ? xcd * (q + 1) : r * (q + 1) + (xcd - r) * q) + off; }
        const int nig = wgm * nN, gid = wgid / nig, fm = gid * wgm, gsz = (nM - fm) < wgm ? (nM - fm) : wgm;
        u.pm = fm + ((wgid % nig) % gsz); u.pn = (wgid % nig) / gsz; return true;
    }
    __device__ __forceinline__ void a_ready(const Unit&) const {}
    __device__ __forceinline__ void done(const Unit&) const {}
};

__device__ __forceinline__ unsigned cvt_pk_bf16(float lo, float hi) { unsigned r; asm volatile("v_cvt_pk_bf16_f32 %0, %1, %2" : "=v"(r) : "v"(lo), "v"(hi)); return r; }
typedef float f32x2 __attribute__((ext_vector_type(2)));
__device__ __forceinline__ f32x2 gelu_pk(f32x2 v) {
    const f32x2 av = __builtin_elementwise_abs(v), d = av * 0.2316418882f + 1.0f;
    f32x2 t; t.x = __builtin_amdgcn_rcpf(d.x); t.y = __builtin_amdgcn_rcpf(d.y);
    f32x2 q = t * 0.5307027145f + (-0.7265760135f); q = q * t + 0.7107068705f; q = q * t + (-0.142248368f); q = q * t + 0.127414796f; q = q * t;
    const f32x2 s = (v * v) * (-0.72134752044f);
    f32x2 e; e.x = __builtin_amdgcn_exp2f(s.x); e.y = __builtin_amdgcn_exp2f(s.y);
    const f32x2 m = v * (q * e), r = v - m;
    f32x2 o; o.x = v.x < 0.f ? m.x : r.x; o.y = v.y < 0.f ? m.y : r.y; return o;
}
constexpr int LX_RED = 135168;
constexpr int LX_RS = 139264;
template <class Sched> __device__ __forceinline__ int rs_table(const float* ssq, const Sched& S, PG8_LAS unsigned char* lds0, int tid) {
    Unit ua, ub; if (!S.next(0, ua)) return 0;
    ub = ua; S.next((S.nwg - 1 - S.c) / S.G, ub);
    const int row = ((tid < BM) ? ua.pm : ub.pm) * BM + (tid & (BM - 1));
    const f32x4* p = (const f32x4*)(ssq + (size_t)row * 8); const f32x4 a = p[0], b = p[1];
    ((PG8_LAS float*)(lds0 + LX_RS))[tid] = __builtin_amdgcn_rsqf((((a[0] + a[1]) + (a[2] + a[3])) + ((b[0] + b[1]) + (b[2] + b[3]))) * (1.0f / 2048.0f) + 1e-6f);
    return ua.pm;
}
template <int ACT> struct EpiActS {
    static constexpr bool PERM = true, AFTER_DRAIN = false;
    bf16_t* O; int ldc; int nscale; float scale0; const PG8_LAS float* rs_tab; int pm0;
    __device__ __forceinline__ void operator()(const f32x4 (&acc)[2][2][4][2], const Unit& u, int wr, int wc, int fr, int fq) const {
        const int row0 = u.pm * BM + wr * 64 + fr; const int col0 = u.pn * BM + wc * 32 + 8 * fq;
        const float sc = (u.pn < nscale) ? scale0 : 1.f;
        float rs[2][4];
        const PG8_LAS float* rt = rs_tab + ((u.pm == pm0) ? 0 : BM) + wr * 64 + fr;
#pragma unroll
        for (int ai = 0; ai < 2; ++ai)
#pragma unroll
            for (int m = 0; m < 4; ++m) rs[ai][m] = rt[ai * HALF + m * 16];
#pragma unroll
        for (int ai = 0; ai < 2; ++ai)
#pragma unroll
            for (int m = 0; m < 4; ++m) { bf16_t* rowp = O + (size_t)(row0 + ai * HALF + m * 16) * ldc + col0; const float rsv = rs[ai][m];
#pragma unroll
                for (int bj = 0; bj < 2; ++bj) { f32x4 v0 = acc[ai][bj][m][0] * rsv, v1 = acc[ai][bj][m][1] * rsv;
                    if (ACT == 1) { f32x2 a = gelu_pk((f32x2){v0[0], v0[1]}), b = gelu_pk((f32x2){v0[2], v0[3]}), c = gelu_pk((f32x2){v1[0], v1[1]}), d = gelu_pk((f32x2){v1[2], v1[3]});
                        v0 = (f32x4){a.x, a.y, b.x, b.y}; v1 = (f32x4){c.x, c.y, d.x, d.y}; }
                    if (ACT == 2) { const f32x4 z = {0.f, 0.f, 0.f, 0.f}; v0 = __builtin_elementwise_max(v0, z); v1 = __builtin_elementwise_max(v1, z); v0 = v0 * v0; v1 = v1 * v1; }
                    if (ACT == 0) { v0 = v0 * sc; v1 = v1 * sc; }
                    u32x4 w; w.x = cvt_pk_bf16(v0[0], v0[1]); w.y = cvt_pk_bf16(v0[2], v0[3]); w.z = cvt_pk_bf16(v1[0], v1[1]); w.w = cvt_pk_bf16(v1[2], v1[3]);
                    *(u32x4*)(rowp + bj * HALF) = w; } }
    }
};
struct EpiResidB {
    static constexpr bool PERM = true, AFTER_DRAIN = false;
    bf16_t* xb; float* ssq; int ldc; PG8_LAS unsigned char* lds0;
    __device__ __forceinline__ void operator()(const f32x4 (&acc)[2][2][4][2], const Unit& u, int wr, int wc, int fr, int fq) const {
        const int col0 = u.pn * BM + wc * 32 + 8 * fq;
        PG8_LAS float* RED = (PG8_LAS float*)(lds0 + LX_RED);
#pragma unroll
        for (int ai = 0; ai < 2; ++ai)
#pragma unroll
            for (int m = 0; m < 4; ++m) { const int rl = ai * HALF + wr * 64 + m * 16 + fr; const size_t off = (size_t)(u.pm * BM + rl) * ldc + col0;
                u32x4 b[2];
#pragma unroll
                for (int bj = 0; bj < 2; ++bj) b[bj] = *(const u32x4*)(xb + off + bj * HALF);
                float q = 0.f;
#pragma unroll
                for (int bj = 0; bj < 2; ++bj) {
                    f32x4 o0 = {__uint_as_float(b[bj].x << 16), __uint_as_float(b[bj].x & 0xffff0000u), __uint_as_float(b[bj].y << 16), __uint_as_float(b[bj].y & 0xffff0000u)};
                    f32x4 o1 = {__uint_as_float(b[bj].z << 16), __uint_as_float(b[bj].z & 0xffff0000u), __uint_as_float(b[bj].w << 16), __uint_as_float(b[bj].w & 0xffff0000u)};
                    o0 = o0 + acc[ai][bj][m][0]; o1 = o1 + acc[ai][bj][m][1];
                    q += ((o0[0] * o0[0] + o0[1] * o0[1]) + (o0[2] * o0[2] + o0[3] * o0[3])) + ((o1[0] * o1[0] + o1[1] * o1[1]) + (o1[2] * o1[2] + o1[3] * o1[3]));
                    u32x4 w; w.x = cvt_pk_bf16(o0[0], o0[1]); w.y = cvt_pk_bf16(o0[2], o0[3]); w.z = cvt_pk_bf16(o1[0], o1[1]); w.w = cvt_pk_bf16(o1[2], o1[3]);
                    *(u32x4*)(xb + off + bj * HALF) = w; }
                { auto r16 = __builtin_amdgcn_permlane16_swap(__float_as_uint(q), __float_as_uint(q), false, false); q = __uint_as_float(r16[0]) + __uint_as_float(r16[1]);
                  auto r32 = __builtin_amdgcn_permlane32_swap(__float_as_uint(q), __float_as_uint(q), false, false); q = __uint_as_float(r32[0]) + __uint_as_float(r32[1]); }
                if (fq == 0) RED[rl * 4 + wc] = q;
                if (m & 1) asm volatile("" ::: "memory"); }
        asm volatile("s_waitcnt lgkmcnt(0)\n\ts_barrier" ::: "memory");
        const int t = (wr * 4 + wc) * 64 + fq * 16 + fr;
        if (t < BM) { const f32x4 r4 = *(const PG8_LAS f32x4*)(RED + t * 4); ssq[(size_t)(u.pm * BM + t) * 8 + u.pn] = (r4[0] + r4[1]) + (r4[2] + r4[3]); }
    }
};
template <class Epi, class Sched, bool ALIGN_EPI = false, bool SP2 = false>
__device__ __forceinline__ void gemm_phase(PG8_LAS unsigned char* lds, const Gemm g, const Sched& S, const Epi& E, int tid_in) {
    int tid_ = tid_in; const bf16_t* gA_ = g.A; const bf16_t* gB_ = g.Bt; asm volatile("" : "+v"(tid_), "+s"(gA_), "+s"(gB_));
    const int tid = tid_, wid = __builtin_amdgcn_readfirstlane(tid >> 6), lane = tid & 63, wr = wid >> 2, wc = wid & 3, fr = lane & 15, fq = lane >> 4;
    const int K = g.K, nt = K / BK;
    unsigned voffA[2], voffB[2];
#pragma unroll
    for (int i = 0; i < 2; ++i) { int R, C; stage_rc(tid * 16 + i * 8192, R, C); const int Rb = Epi::PERM ? ((R & ~31) + perm32(R & 31)) : R;
        voffA[i] = (unsigned)(R * K + C) * 2u; voffB[i] = (unsigned)(Rb * K + C) * 2u; }
    const size_t kstep = (size_t)(BK * 2);
    const size_t hstep = (size_t)HALF * K * 2;
    const size_t tstep = 2 * hstep;
    const unsigned ldsw = (unsigned)wid * 1024u;
    const int aoff = lds_byte(wr * 64 + fr, fq * 8), boff = lds_byte(wc * 32 + fr, fq * 8);
#define PG8_SA(b, h) (((b) * 2 + (h)) * HTB)
#define PG8_SB(b, h) ((4 + (b) * 2 + (h)) * HTB)
#define PG8_STAGE(bufoff, gbase, voff) do { _Pragma("unroll") for (int _i = 0; _i < 2; ++_i) \
        __builtin_amdgcn_global_load_lds((const unsigned*)((const char*)(gbase) + (voff)[_i]), (PG8_LAS unsigned*)(lds + (bufoff) + ldsw + _i * 8192), 16, 0, 0); } while (0)
#define PG8_LDA(dst, b, h) do { _Pragma("unroll") for (int m = 0; m < 4; ++m) _Pragma("unroll") for (int k = 0; k < 2; ++k) dst[m][k] = *(const PG8_LAS bf16x8*)(lds + PG8_SA(b, h) + aoff + m * 2048 + k * 1024); } while (0)
#define PG8_LDB(dst, b, h) do { _Pragma("unroll") for (int n = 0; n < 2; ++n) _Pragma("unroll") for (int k = 0; k < 2; ++k) dst[n][k] = *(const PG8_LAS bf16x8*)(lds + PG8_SB(b, h) + boff + n * 2048 + k * 1024); } while (0)
#define PG8_MMA(ai, bj, At, Bt) do { __builtin_amdgcn_s_setprio(1); _Pragma("unroll") for (int m = 0; m < 4; ++m) _Pragma("unroll") for (int n = 0; n < 2; ++n) _Pragma("unroll") for (int k = 0; k < 2; ++k) \
        acc[ai][bj][m][n] = __builtin_amdgcn_mfma_f32_16x16x32_bf16(Bt[n][k], At[m][k], acc[ai][bj][m][n], 0, 0, 0); __builtin_amdgcn_s_setprio(0); } while (0)
#define PG8_WAIT_V(n) asm volatile("s_waitcnt vmcnt(" #n ")" ::: "memory")
#define PG8_WAIT_L(n) asm volatile("s_waitcnt lgkmcnt(" #n ")" ::: "memory")
#define PG8_BAR __builtin_amdgcn_s_barrier()
#define PG8_SCHED __builtin_amdgcn_sched_barrier(0)
    Unit cur, nxt; int ui = 0;
    if (!S.next(0, cur)) return;
    f32x4 acc[2][2][4][2];
#pragma unroll
    for (int a = 0; a < 2; ++a)
#pragma unroll
        for (int b = 0; b < 2; ++b)
#pragma unroll
            for (int m = 0; m < 4; ++m)
#pragma unroll
                for (int n = 0; n < 2; ++n) acc[a][b][m][n] = (f32x4){0.f, 0.f, 0.f, 0.f};
    bf16x8 At[4][2], B0[2][2], B1[2][2];
    const char* cA = (const char*)gA_ + (size_t)cur.pm * tstep; const char* cB = (const char*)gB_ + (size_t)cur.pn * tstep;
    S.a_ready(cur);
    if constexpr (SP2) {
        PG8_STAGE(PG8_SB(0, 0), cB, voffB); PG8_STAGE(PG8_SB(0, 1), cB + hstep, voffB); PG8_STAGE(PG8_SA(0, 0), cA, voffA); PG8_STAGE(PG8_SA(0, 1), cA + hstep, voffA);
        if (wr == 1) PG8_BAR;
        PG8_WAIT_V(2); PG8_BAR;
        PG8_STAGE(PG8_SB(1, 0), cB + kstep, voffB); PG8_STAGE(PG8_SA(1, 0), cA + kstep, voffA); PG8_STAGE(PG8_SB(1, 1), cB + hstep + kstep, voffB);
        PG8_WAIT_V(6); PG8_BAR;
    } else {
        PG8_STAGE(PG8_SB(0, 0), cB, voffB); PG8_STAGE(PG8_SA(0, 0), cA, voffA); PG8_STAGE(PG8_SB(0, 1), cB + hstep, voffB); PG8_STAGE(PG8_SA(0, 1), cA + hstep, voffA);
        if (wr == 1) PG8_BAR;
        PG8_WAIT_V(4); PG8_BAR;
        PG8_STAGE(PG8_SB(1, 0), cB + kstep, voffB); PG8_STAGE(PG8_SA(1, 0), cA + kstep, voffA); PG8_STAGE(PG8_SB(1, 1), cB + hstep + kstep, voffB);
        PG8_WAIT_V(6); PG8_BAR;
    }
    for (;;) {
        const bool has_next = S.next(ui + 1, nxt);
        const char* nA = has_next ? (const char*)gA_ + (size_t)nxt.pm * tstep : cA; const char* nB = has_next ? (const char*)gB_ + (size_t)nxt.pn * tstep : cB;
        for (int t = 0; t < nt; t += 2) {
            const bool last = (t == nt - 2);
            const char* a1 = cA + (size_t)(t + 1) * kstep;
            const char* a2 = last ? nA : cA + (size_t)(t + 2) * kstep; const char* b2 = last ? nB : cB + (size_t)(t + 2) * kstep;
            const char* a3 = a2 + kstep; const char* b3 = b2 + kstep;
            if (last && has_next) S.a_ready(nxt);
            if constexpr (SP2) {
            PG8_LDB(B0, 0, 0); PG8_LDB(B1, 0, 1); PG8_SCHED; PG8_LDA(At, 0, 0); PG8_STAGE(PG8_SA(1, 1), a1 + hstep, voffA);
            PG8_WAIT_V(8); PG8_WAIT_L(0); PG8_BAR; PG8_MMA(0, 0, At, B0); PG8_MMA(0, 1, At, B1); PG8_BAR; PG8_SCHED;
            PG8_LDA(At, 0, 1); PG8_STAGE(PG8_SB(0, 0), b2, voffB); PG8_STAGE(PG8_SB(0, 1), b2 + hstep, voffB); PG8_STAGE(PG8_SA(0, 0), a2, voffA);
            PG8_WAIT_V(8); PG8_WAIT_L(0); PG8_BAR; PG8_MMA(1, 0, At, B0); PG8_MMA(1, 1, At, B1); PG8_BAR; PG8_SCHED;
            PG8_LDB(B0, 1, 0); PG8_LDB(B1, 1, 1); PG8_SCHED; PG8_LDA(At, 1, 0); PG8_STAGE(PG8_SA(0, 1), a2 + hstep, voffA);
            PG8_WAIT_V(8); PG8_WAIT_L(0); PG8_BAR; PG8_MMA(0, 0, At, B0); PG8_MMA(0, 1, At, B1); PG8_BAR; PG8_SCHED;
            PG8_LDA(At, 1, 1); PG8_STAGE(PG8_SB(1, 0), b3, voffB); PG8_STAGE(PG8_SB(1, 1), b3 + hstep, voffB); PG8_STAGE(PG8_SA(1, 0), a3, voffA);
            PG8_WAIT_V(8); PG8_WAIT_L(0); PG8_BAR; PG8_MMA(1, 0, At, B0); PG8_MMA(1, 1, At, B1); PG8_BAR; PG8_SCHED;
            } else {
            PG8_LDB(B0, 0, 0); PG8_SCHED; PG8_LDA(At, 0, 0); PG8_STAGE(PG8_SA(1, 1), a1 + hstep, voffA);
            PG8_WAIT_L(8); PG8_BAR; PG8_WAIT_L(0); PG8_MMA(0, 0, At, B0); PG8_BAR; PG8_SCHED;
            PG8_LDB(B1, 0, 1); PG8_STAGE(PG8_SB(0, 0), b2, voffB);
            PG8_BAR; PG8_WAIT_L(0); PG8_MMA(0, 1, At, B1); PG8_BAR;
            PG8_LDA(At, 0, 1); PG8_STAGE(PG8_SA(0, 0), a2, voffA);
            PG8_BAR; PG8_WAIT_L(0); PG8_MMA(1, 0, At, B0); PG8_BAR; PG8_SCHED;
            PG8_STAGE(PG8_SB(0, 1), b2 + hstep, voffB);
            PG8_WAIT_V(6); PG8_BAR; PG8_MMA(1, 1, At, B1); PG8_BAR;
            PG8_LDB(B0, 1, 0); PG8_SCHED; PG8_LDA(At, 1, 0); PG8_STAGE(PG8_SA(0, 1), a2 + hstep, voffA);
            PG8_WAIT_L(8); PG8_BAR; PG8_WAIT_L(0); PG8_MMA(0, 0, At, B0); PG8_BAR; PG8_SCHED;
            PG8_LDB(B1, 1, 1); PG8_STAGE(PG8_SB(1, 0), b3, voffB);
            PG8_BAR; PG8_WAIT_L(0); PG8_MMA(0, 1, At, B1); PG8_BAR;
            PG8_LDA(At, 1, 1); PG8_STAGE(PG8_SA(1, 0), a3, voffA);
            PG8_BAR; PG8_WAIT_L(0); PG8_MMA(1, 0, At, B0); PG8_BAR; PG8_SCHED;
            PG8_STAGE(PG8_SB(1, 1), b3 + hstep, voffB);
            PG8_WAIT_V(6); PG8_BAR; PG8_MMA(1, 1, At, B1); PG8_BAR;
            }
        }
        if constexpr (ALIGN_EPI) { if (wr == 0) PG8_BAR; }
        if constexpr (!Epi::AFTER_DRAIN) { E(acc, cur, wr, wc, fr, fq); S.done(cur); }
        if (!has_next) break;
#pragma unroll
        for (int a = 0; a < 2; ++a)
#pragma unroll
            for (int b = 0; b < 2; ++b)
#pragma unroll
                for (int m = 0; m < 4; ++m)
#pragma unroll
                    for (int n = 0; n < 2; ++n) acc[a][b][m][n] = (f32x4){0.f, 0.f, 0.f, 0.f};
        cur = nxt; cA = nA; cB = nB; ++ui;
        if constexpr (ALIGN_EPI) { if (wr == 1) PG8_BAR; }
    }
    PG8_WAIT_V(0);
    if constexpr (!ALIGN_EPI) { if (wr == 0) PG8_BAR; }
    PG8_BAR;
    if constexpr (Epi::AFTER_DRAIN) { E.fused(acc, cur, wr, wc, fr, fq, lds, wid, lane); S.done(cur); }
#undef PG8_SA
#undef PG8_SB
#undef PG8_STAGE
#undef PG8_LDA
#undef PG8_LDB
#undef PG8_MMA
#undef PG8_WAIT_V
#undef PG8_WAIT_L
#undef PG8_BAR
#undef PG8_SCHED
}
}
#define GAS __attribute__((address_space(1)))
#define LAS __attribute__((address_space(3)))
typedef unsigned short bf16;
typedef unsigned v4u __attribute__((ext_vector_type(4)));
typedef float f32x4 __attribute__((ext_vector_type(4)));
typedef short bf16x8 __attribute__((ext_vector_type(8)));
typedef GAS unsigned gu32;
typedef GAS unsigned long long gu64;
#define RLX_AGENT __ATOMIC_RELAXED, __HIP_MEMORY_SCOPE_AGENT
#define LDS_WAIT() asm volatile("s_waitcnt lgkmcnt(0)" ::: "memory")
#define VM_WAIT() asm volatile("s_waitcnt vmcnt(0)" ::: "memory")
__device__ __forceinline__ unsigned long long rt() { return __builtin_amdgcn_s_memrealtime(); }
typedef __bf16 bfx2_t __attribute__((ext_vector_type(2)));
typedef float f32x2_t __attribute__((ext_vector_type(2)));
__device__ __forceinline__ unsigned pk2(float lo, float hi) { return __builtin_bit_cast(unsigned, __builtin_convertvector((f32x2_t){lo, hi}, bfx2_t)); }
__device__ __forceinline__ unsigned f2bf(float f) { return pk2(f, 0.f) & 0xffffu; }

#define XB_TMO      128
#define XB_XCNT(j)  (256  + 64 * (j))
#define XB_XSUB(j)  (1280 + 64 * (j))
#define XB_XGEN(j)  (2304 + 64 * (j))
#define XB_TOP      3328
#define XB_TOPGEN   3392
#define XCD_BAR_WORDS 3456
#define XB_SPIN_CAP (1u << 18)

__device__ __forceinline__ unsigned xb_ld(unsigned* p)              { return __hip_atomic_load(p, __ATOMIC_RELAXED, __HIP_MEMORY_SCOPE_AGENT); }
__device__ __forceinline__ unsigned xb_add(unsigned* p, unsigned v) { return __hip_atomic_fetch_add(p, v, __ATOMIC_RELAXED, __HIP_MEMORY_SCOPE_AGENT); }
__device__ __forceinline__ unsigned xb_xcc_id() { return (unsigned)__builtin_amdgcn_s_getreg((3 << 11) | 20) & 0xFu; }
#define XB_SPIN(cond, bar) do { unsigned _sp = 0; while (cond) { __builtin_amdgcn_s_sleep(1); \
    if ((++_sp & 255u) == 0u) { if (xb_ld(&(bar)[XB_TMO])) break; if (_sp > XB_SPIN_CAP) { atomicAdd(&(bar)[XB_TMO], 1u); break; } } } } while (0)

struct XcdBarrier {
    unsigned* bar; unsigned x;
    volatile LAS unsigned* st;
};

__device__ __forceinline__ XcdBarrier xcd_barrier_post(unsigned* bar, volatile LAS unsigned* st) {
    XcdBarrier b; b.bar = bar; b.x = xb_xcc_id(); b.st = st;
    if (threadIdx.x == 0) (void)xb_add(&bar[XB_XCNT(b.x)], 1u);
    return b;
}
__device__ __forceinline__ void xcd_barrier_complete(unsigned* bar, unsigned x, unsigned& nloc, unsigned& nx) {
    const unsigned G = gridDim.x * gridDim.y * gridDim.z;
    unsigned sum, cnt, mine, sp = 0u;
    for (;;) {
        sum = 0u; cnt = 0u; mine = 0u;
#pragma unroll
        for (unsigned j = 0; j < 16; ++j) { const unsigned c = xb_ld(&bar[XB_XCNT(j)]); sum += c; cnt += (c > 0u) ? 1u : 0u; mine = (j == x) ? c : mine; }
        if (sum == G) break;
        __builtin_amdgcn_s_sleep(1);
        if ((++sp & 255u) == 0u) { if (xb_ld(&bar[XB_TMO])) break; if (sp > XB_SPIN_CAP) { atomicAdd(&bar[XB_TMO], 1u); break; } }
    }
    nloc = mine > 0u ? mine : 1u; nx = cnt > 0u ? cnt : 1u;
}

__device__ __forceinline__ void xcd_barrier(const XcdBarrier& b) {
    asm volatile("s_waitcnt vmcnt(0)" ::: "memory");
    __syncthreads();
    if (threadIdx.x == 0) {
        unsigned* bar = b.bar;
        __builtin_amdgcn_s_waitcnt(0);
        unsigned nloc = b.st[0], nx = b.st[1];
        if (nloc == 0u) { xcd_barrier_complete(bar, b.x, nloc, nx); b.st[0] = nloc; b.st[1] = nx; }
        const unsigned old = xb_add(&bar[XB_XSUB(b.x)], 1u);
        const unsigned gen = old / nloc;
        if (old + 1u == (gen + 1u) * nloc) {
            __builtin_amdgcn_fence(__ATOMIC_RELEASE, "agent");
            asm volatile("s_waitcnt vmcnt(0)" ::: "memory");
            const unsigned og = xb_add(&bar[XB_TOP], 1u);
            const unsigned tg = og / nx;
            if (og + 1u == (tg + 1u) * nx) xb_add(&bar[XB_TOPGEN], 1u);
            else XB_SPIN(xb_ld(&bar[XB_TOPGEN]) == tg, bar);
            __builtin_amdgcn_fence(__ATOMIC_ACQUIRE, "agent");
            xb_add(&bar[XB_XGEN(b.x)], 1u);
            asm volatile("s_waitcnt vmcnt(0)" ::: "memory");
        } else {
            XB_SPIN(xb_ld(&bar[XB_XGEN(b.x)]) == gen, bar);
            __builtin_amdgcn_fence(__ATOMIC_ACQUIRE, "agent");
            asm volatile("s_waitcnt vmcnt(0)" ::: "memory");
        }
    }
    __syncthreads();
}
template <int CTRL> __device__ __forceinline__ float dpp_mov(float x) { return __int_as_float(__builtin_amdgcn_update_dpp(0, __float_as_int(x), CTRL, 0xF, 0xF, true)); }
__device__ __forceinline__ float sum_xor16(float x) { auto r = __builtin_amdgcn_permlane16_swap(__float_as_uint(x), __float_as_uint(x), false, false); return __uint_as_float(r[0]) + __uint_as_float(r[1]); }
__device__ __forceinline__ float sum_xor32(float x) { auto r = __builtin_amdgcn_permlane32_swap(__float_as_uint(x), __float_as_uint(x), false, false); return __uint_as_float(r[0]) + __uint_as_float(r[1]); }
__device__ __forceinline__ float wave_sum(float v) {
    v += dpp_mov<0xB1>(v); v += dpp_mov<0x4E>(v); v += dpp_mov<0x141>(v); v += dpp_mov<0x140>(v);
    return sum_xor32(sum_xor16(v));
}
__device__ __forceinline__ void transpose64_item(const float* W, int K, int N, bf16* WT, LAS unsigned char* img, int item, int lane, const float* gk) {
    const int nblk = (N + 63) >> 6, kb = item / nblk, nb = item - kb * nblk, k0 = 64 * kb, n0 = 64 * nb;
    const int kl = lane >> 4, n4 = (lane & 15) * 4; const bool live = n0 + n4 < N;
    f32x4 v[16];
#pragma unroll
    for (int j = 0; j < 16; ++j) v[j] = live ? *(const GAS f32x4*)(W + (size_t)(k0 + 4 * j + kl) * N + n0 + n4) : (f32x4){0.f, 0.f, 0.f, 0.f};
#pragma unroll
    for (int j = 0; j < 16; ++j) { const int kk = 4 * j + kl; const float g = gk ? gk[k0 + kk] : 1.0f; const f32x4 x = v[j] * g;
        LAS unsigned char* p = img + n4 * 132 + kk * 2;
        *(LAS unsigned short*)(p) = (unsigned short)f2bf(x.x); *(LAS unsigned short*)(p + 132) = (unsigned short)f2bf(x.y); *(LAS unsigned short*)(p + 264) = (unsigned short)f2bf(x.z); *(LAS unsigned short*)(p + 396) = (unsigned short)f2bf(x.w); }
    LDS_WAIT(); asm volatile("" ::: "memory");
    const int c = lane & 7;
#pragma unroll
    for (int jj = 0; jj < 8; ++jj) { const int n = (lane >> 3) + 8 * jj;
        const LAS unsigned* q = (const LAS unsigned*)(img + n * 132 + c * 16); v4u o; o.x = q[0]; o.y = q[1]; o.z = q[2]; o.w = q[3];
        if (n0 + n < N) *(GAS v4u*)(WT + (size_t)(n0 + n) * K + k0 + 8 * c) = o; }
    LDS_WAIT(); asm volatile("" ::: "memory");
}
constexpr int NWAVES = 8;
constexpr int BATCH = 16, T = 2048, D = 2048, M = BATCH * T, DEPTH = 4, FF = 8192;
constexpr int EVEN_N = 6432, ZP = 6656;
constexpr int ZC_Q = 0, ZC_K = 1024, ZC_V = 2048, ZC_R = 3072, ZC_RK = 4096, ZC_RV = 5120, ZC_XW = 6144, ZC_XA = 6208, ZC_XG = 6272;
constexpr int RWS = 3360;
constexpr int NPH = 33;

constexpr size_t MiB = 1u << 20;
constexpr size_t WS_CTL = 0, CTL_ZERO_BYTES = 1 * MiB;
constexpr size_t WS_WA = 2 * MiB;
constexpr size_t WS_WB = 28 * MiB;
constexpr size_t WS_W1 = 36 * MiB;
constexpr size_t WS_W2 = 68 * MiB;
constexpr size_t WS_H = 104 * MiB;
constexpr size_t WS_BIG = 232 * MiB;
constexpr size_t WS_SSQ = 101 * MiB;
constexpr size_t WS_XB = 744 * MiB;
constexpr size_t WS_END = 872 * MiB;
constexpr int CW_BAR = 4096;

constexpr int RING_BYTES = 131072, LDSCTL_OFF = RING_BYTES, MISC_OFF = LDSCTL_OFF + 320, LDS_BYTES = 147456;

struct Args { const float* in[25]; float* out; unsigned char* ws; int ph_lo, ph_hi; };

__device__ __forceinline__ v4u zero4() { unsigned z; asm volatile("v_mov_b32 %0, 0" : "=v"(z)); return (v4u){z, z, z, z}; }
__device__ __forceinline__ float bf2f(bf16 h) { return __uint_as_float((unsigned)h << 16); }
__device__ __forceinline__ float bflo(unsigned w) { return __uint_as_float(w << 16); }
__device__ __forceinline__ float bfhi(unsigned w) { return __uint_as_float(w & 0xffff0000u); }

__device__ __forceinline__ void rms_row_out(const bf16* xrow, const float* g, float* orow, int lane) {
    const GAS v4u* xr = (const GAS v4u*)xrow + lane; const GAS f32x4* gr = (const GAS f32x4*)g + 2 * lane; GAS f32x4* o = (GAS f32x4*)orow + 2 * lane;
    f32x4 v[8]; float s = 0.f;
#pragma unroll
    for (int j = 0; j < 4; ++j) { const v4u w = xr[64 * j]; v[2 * j] = (f32x4){bflo(w.x), bfhi(w.x), bflo(w.y), bfhi(w.y)}; v[2 * j + 1] = (f32x4){bflo(w.z), bfhi(w.z), bflo(w.w), bfhi(w.w)};
        s += ((v[2 * j].x * v[2 * j].x + v[2 * j].y * v[2 * j].y) + (v[2 * j].z * v[2 * j].z + v[2 * j].w * v[2 * j].w)) + ((v[2 * j + 1].x * v[2 * j + 1].x + v[2 * j + 1].y * v[2 * j + 1].y) + (v[2 * j + 1].z * v[2 * j + 1].z + v[2 * j + 1].w * v[2 * j + 1].w)); }
    const float r = 1.0f / sqrtf(wave_sum(s) * (1.f / D) + 1e-6f);
#pragma unroll
    for (int j = 0; j < 4; ++j) { o[128 * j] = v[2 * j] * r * gr[128 * j]; o[128 * j + 1] = v[2 * j + 1] * r * gr[128 * j + 1]; }
}
__device__ __forceinline__ void prep_phase(const float* Win, int Nin, const float* Wout, const float* w1, const float* w2, const float* x0, const float* gmix, const float* gffn, unsigned char* ws, bool even, LAS unsigned char* lds, int wave, int lane, int tid, int G) {
    const int gw = blockIdx.x * NWAVES + wave, NGW = G * NWAVES;
    bf16* WA = (bf16*)(ws + WS_WA); bf16* WB = (bf16*)(ws + WS_WB); bf16* W1 = (bf16*)(ws + WS_W1); bf16* W2 = (bf16*)(ws + WS_W2);
    const int I_in = (D / 64) * ((Nin + 63) / 64), I_out = (D / 64) * (D / 64), I_1 = (D / 64) * (FF / 64), I_2 = (FF / 64) * (D / 64);
    LAS unsigned char* const img = lds + wave * 16384;
    const int total = I_in + I_out + I_1 + I_2;
    for (int it = gw; it < total; it += NGW) {
        int r = it;
        if (r < I_in) { transpose64_item(Win, D, Nin, WA, img, r, lane, gmix); continue; } r -= I_in;
        if (r < I_out) { transpose64_item(Wout, D, D, WB, img, r, lane, nullptr); continue; } r -= I_out;
        if (r < I_1) { transpose64_item(w1, D, FF, W1, img, r, lane, gffn); continue; } r -= I_1;
        transpose64_item(w2, FF, D, W2, img, r, lane, nullptr);
    }
    if (even) {
        GAS v4u* p = (GAS v4u*)(WA + (size_t)EVEN_N * D); const int n16 = (ZP - EVEN_N) * D * 2 / 16;
        for (int k = blockIdx.x * (NWAVES * 64) + tid; k < n16; k += G * NWAVES * 64) p[k] = zero4();
    }
    if (x0) {
        bf16* XB = (bf16*)(ws + WS_XB); float* SSQ = (float*)(ws + WS_SSQ);
        for (int m = gw; m < M; m += NGW) {
            const GAS f32x4* xr = (const GAS f32x4*)(x0 + (size_t)m * D) + lane; GAS unsigned long long* o8 = (GAS unsigned long long*)(XB + (size_t)m * D) + lane;
            float s = 0.f;
#pragma unroll
            for (int j = 0; j < 8; ++j) { const f32x4 v = xr[64 * j]; s += (v.x * v.x + v.y * v.y) + (v.z * v.z + v.w * v.w);
                o8[64 * j] = (unsigned long long)pk2(v.x, v.y) | ((unsigned long long)pk2(v.z, v.w) << 32); }
            s = wave_sum(s);
            if (lane < 8) SSQ[(size_t)m * 8 + lane] = lane == 0 ? s : 0.f;
        }
    }
}

__device__ __forceinline__ float rl(float x, int j) { return __int_as_float(__builtin_amdgcn_readlane(__float_as_int(x), j)); }

namespace rw {
constexpr int CH = 32;
constexpr int L_X = 0, L_RKV = 32768, L_DAG = 57344, L_ACT = 81920, L_SC = 101888, L_PREV = 102400, L_MU = 104320, L_CST = 106240;
constexpr int ACT_WS = 144, ACT_GS = 336;
constexpr int L_ACTW = L_ACT, L_ACTA = L_ACT + 32 * ACT_WS, L_ACTG = L_ACT + 64 * ACT_WS, L_Y = L_ACT;
constexpr float LOG2E = 1.4426950408889634f, LN2 = 0.6931471805599453f;
typedef float f32x2 __attribute__((ext_vector_type(2)));
__device__ __forceinline__ float ex2(float x) { return __builtin_amdgcn_exp2f(x); }
__device__ __forceinline__ float lg2(float x) { return __builtin_amdgcn_logf(x); }
__device__ __forceinline__ float rcp(float x) { return __builtin_amdgcn_rcpf(x); }
__device__ __forceinline__ float sigmoid_f(float x) { return rcp(1.0f + ex2(-x * LOG2E)); }
template <int CTRL> __device__ __forceinline__ float dppf(float x) { return __int_as_float(__builtin_amdgcn_update_dpp(0, __float_as_int(x), CTRL, 0xF, 0xF, true)); }
__device__ __forceinline__ float row16_sum(float x) { x += dppf<0xB1>(x); x += dppf<0x4E>(x); x += dppf<0x141>(x); x += dppf<0x140>(x); return x; }
#define FMUL(a, b) ({ float d_; asm("v_mul_f32 %0, %1, %2" : "=v"(d_) : "v"(a), "v"(b)); d_; })
#define FFMA(a, b, c) ({ float d_; asm("v_fma_f32 %0, %1, %2, %3" : "=v"(d_) : "v"(a), "v"(b), "v"(c)); d_; })
#define RW_BAR() asm volatile("s_waitcnt lgkmcnt(0)\n\ts_barrier" ::: "memory")
struct Params { const float *mu, *w_up, *w0, *a_up, *a0, *g_up, *k_k, *k_a, *r_k, *lnx_w, *lnx_b; };

__device__ __forceinline__ bf16x8 load_bfrag(const float* W, int k0, int col) {
    float w[8];
#pragma unroll
    for (int j = 0; j < 8; ++j) w[j] = W[(size_t)(k0 + j) * 1024 + col];
    v4u p; p.x = pk2(w[0], w[1]); p.y = pk2(w[2], w[3]); p.z = pk2(w[4], w[5]); p.w = pk2(w[6], w[7]);
    return __builtin_bit_cast(bf16x8, p);
}
__device__ __forceinline__ int colbase(int chunk, int hc) { return chunk < 24 ? ZC_R + (chunk >> 3) * 1024 + hc + 8 * (chunk & 7) : ZC_XW + 8 * (chunk - 24); }
}
namespace rw2 {
constexpr int CH = 16;
constexpr int L_X = 0, L_RKV = 15360, L_E1 = 27648, L_ACT = 44032, L_OPS = 54016, L_BKT = 63232, L_SVT = 68352, L_LB = 73472, L_LKA = 74496, L_LRA = 75776, L_S0 = 77056,
              L_RHS = 86272, L_Y = 90368, L_SC = 94464, L_PREV = 94720, L_MU = 96640, L_CST = 98560;
constexpr int ACT_WS = 144, ACT_GS = 336, OPS = 144, T32S = 80;
constexpr int L_ACTW = L_ACT, L_ACTA = L_ACT + 16 * ACT_WS, L_ACTG = L_ACT + 32 * ACT_WS;
constexpr int L_KT = L_OPS, L_BT = L_OPS + 2304, L_KK = L_OPS + 4608, L_RT = L_OPS + 6912;
using rw::LOG2E; using rw::LN2; using rw::ex2; using rw::lg2; using rw::rcp; using rw::sigmoid_f; using rw::row16_sum; using rw::load_bfrag; using rw::colbase; using rw::Params;
#define RW2_BAR() asm volatile("s_waitcnt lgkmcnt(0)\n\ts_barrier" ::: "memory")
__device__ __forceinline__ bf16x8 ldfrag(const LAS unsigned char* p) { return *(const LAS bf16x8*)p; }
__device__ __forceinline__ void st16(LAS unsigned char* p, float x) { *(LAS unsigned short*)p = (unsigned short)f2bf(x); }
}
namespace rw12 {
typedef short s16x4 __attribute__((ext_vector_type(4)));
typedef __bf16 bfx4 __attribute__((ext_vector_type(4)));
__device__ __forceinline__ s16x4 pk4(const f32x4 x) { return __builtin_bit_cast(s16x4, __builtin_convertvector(x, bfx4)); }
constexpr int CH = 16, NCH = T / CH;
constexpr int A_RK = 0  , A_E1 = 12288  , A_ACT = 28672, A_MU = 38656, A_CST = 40576, A_END = 41856;
constexpr int H_OPS = 0, H_BKT = 9216, H_SVT = 14336, H_VF = 19456, H_GV = 23552, H_DC = 27648, H_SC = 27904, H_SIZE = 28160;
constexpr int H_BASE = A_END;
constexpr int B_S0 = H_BASE + 2 * H_SIZE, B_RHS = B_S0 + 9216  , B_Y = B_RHS + 4096, B_RK2 = B_Y + 4096  , B_END = B_RK2 + 12288;
static_assert(B_END <= 131072, "RWKV LDS map");
constexpr int ACT_WS = 144, ACT_GS = 336, OPS = 144, T32S = 80;
constexpr int A_ACTW = A_ACT, A_ACTA = A_ACT + 16 * ACT_WS, A_ACTG = A_ACT + 32 * ACT_WS;
using rw::LOG2E; using rw::LN2; using rw::ex2; using rw::lg2; using rw::rcp; using rw::sigmoid_f; using rw::row16_sum; using rw::load_bfrag; using rw::colbase; using rw::Params;
using rw2::ldfrag; using rw2::st16;
#define RW12_BAR() asm volatile("s_waitcnt lgkmcnt(0)\n\ts_barrier" ::: "memory")

__device__ __forceinline__ void rwkv_phase(const Params p, const bf16* Z, bf16* O, LAS unsigned char* lds, int tid_in, int u0, int ustep) {
    const int wave = __builtin_amdgcn_readfirstlane(tid_in >> 6);
    LAS float* E1 = (LAS float*)(lds + A_E1); LAS float* CUM = E1 + 1024; LAS float* AV = E1 + 2048; LAS float* GVa = E1 + 3072;
    LAS float* MU = (LAS float*)(lds + A_MU); LAS float* CST = (LAS float*)(lds + A_CST);
    LAS float* Yf = (LAS float*)(lds + B_Y); LAS float* Yf1 = (LAS float*)(lds + B_RHS);
    for (int u = u0; u < BATCH * 16; u += ustep) {
        const int b = u >> 4, h = u & 15, hc = h * 64;
        int tid = tid_in; asm volatile("" : "+v"(tid)); int lane = tid & 63;
        const int ct = wave & 3;
        bf16x8 Bw[2], Ba[2], Bg[5];
        { const int fn = lane & 15, fq = lane >> 4;
          if (wave < 4) {
#pragma unroll
              for (int ks = 0; ks < 2; ++ks) { Bw[ks] = load_bfrag(p.w_up, 32 * ks + 8 * fq, hc + 16 * ct + fn); Ba[ks] = load_bfrag(p.a_up, 32 * ks + 8 * fq, hc + 16 * ct + fn); }
          } else {
#pragma unroll
              for (int ks = 0; ks < 5; ++ks) Bg[ks] = load_bfrag(p.g_up, 32 * ks + 8 * fq, hc + 16 * ct + fn);
          } }
        const float w0c = p.w0[hc + 16 * ct + (lane & 15)], a0c = p.a0[hc + 16 * ct + (lane & 15)];
        if (tid < 480) { const int chunk = tid >> 3, j = tid & 7; const int mi = chunk < 24 ? (chunk >> 3) * 1024 + hc + 8 * (chunk & 7) + j : 3072 + 8 * (chunk - 24) + j; MU[tid] = p.mu[mi]; }
        if (tid < 320) { const int a = tid >> 6, j = tid & 63; const float* src = a == 0 ? p.k_k : a == 1 ? p.k_a : a == 2 ? p.r_k : a == 3 ? p.lnx_w : p.lnx_b; CST[tid] = src[hc + j]; }
        for (int q = tid; q < 576 + 640; q += NWAVES * 64) {
            const int off = q < 576 ? B_S0 + q * 16 : (q < 896 ? H_BASE + H_SVT + (q - 576) * 16 : H_BASE + H_SIZE + H_SVT + (q - 896) * 16); *(LAS v4u*)(lds + off) = zero4(); }
        f32x4 sacc0 = {0.f, 0.f, 0.f, 0.f}, sacc1 = {0.f, 0.f, 0.f, 0.f};
        v4u own[2], prv[2];
        const bf16* zb = Z + (size_t)(b * T) * ZP;
#define RW12_ITEMS() int it_t[2], it_c[2]; bool it_ok[2]; \
        if (tid < 384) { it_t[0] = tid / 24; it_c[0] = tid - 24 * it_t[0]; } else { it_t[0] = (tid - 384) >> 3; it_c[0] = 24 + (tid & 7); } it_ok[0] = true; \
        if (tid < 128) { it_t[1] = tid >> 3; it_c[1] = 32 + (tid & 7); it_ok[1] = true; } else { const int q_ = tid - 128; it_t[1] = q_ / 20; it_c[1] = 40 + q_ - 20 * it_t[1]; it_ok[1] = tid < 448; if (!it_ok[1]) { it_t[1] = 0; it_c[1] = 40; } }
#define RW12_FETCH(cc) _Pragma("unroll") for (int i = 0; i < 2; ++i) { const int ta = (cc) * CH + it_t[i]; const int cb = colbase(it_c[i], hc); \
            own[i] = it_ok[i] ? *(const GAS v4u*)(zb + (size_t)ta * ZP + cb) : zero4(); prv[i] = (it_ok[i] && ta > 0) ? *(const GAS v4u*)(zb + (size_t)(ta - 1) * ZP + cb) : zero4(); }
        { RW12_ITEMS(); RW12_FETCH(0); }
        f32x4 yacc = {0.f, 0.f, 0.f, 0.f}, racc = {0.f, 0.f, 0.f, 0.f};
        RW12_BAR();
        for (int it = -1; it <= NCH + 1; ++it) {
            lane = tid & 63;
            const int fn = lane & 15, fq = lane >> 4, c4 = (tid & 15) * 4, tq = tid >> 4;
            const bool doA = it >= 0 && it < NCH, doB = it >= 1 && it <= NCH, doP2 = it + 1 < NCH, doPost = it >= 2;
            LAS unsigned char* const HA = lds + H_BASE + (it & 1) * H_SIZE;
            LAS unsigned char* const HB = lds + H_BASE + ((it & 1) ^ 1) * H_SIZE;
            if (doA) {
                if (wave < 4) {
                    f32x4 aw = {0.f, 0.f, 0.f, 0.f}, aa = aw;
#pragma unroll
                    for (int ks = 0; ks < 2; ++ks) {
                        aw = __builtin_amdgcn_mfma_f32_16x16x32_bf16(ldfrag(lds + A_ACTW + fn * ACT_WS + (32 * ks + 8 * fq) * 2), Bw[ks], aw, 0, 0, 0);
                        aa = __builtin_amdgcn_mfma_f32_16x16x32_bf16(ldfrag(lds + A_ACTA + fn * ACT_WS + (32 * ks + 8 * fq) * 2), Ba[ks], aa, 0, 0, 0); }
                    float e[4], cs[4];
#pragma unroll
                    for (int r = 0; r < 4; ++r) e[r] = 0.6065306597126334f * rcp(1.0f + ex2(-(aw[r] + w0c) * LOG2E));
                    cs[0] = e[0]; cs[1] = cs[0] + e[1]; cs[2] = cs[1] + e[2]; cs[3] = cs[2] + e[3];
                    const float run = cs[3];
                    float offs;
                    { auto r16 = __builtin_amdgcn_permlane16_swap(__float_as_uint(run), __float_as_uint(run), false, false);
                      const float ev = __uint_as_float(r16[0]), od = __uint_as_float(r16[1]);
                      const float ps = ev + od; auto r32 = __builtin_amdgcn_permlane32_swap(__float_as_uint(ps), __float_as_uint(ps), false, false);
                      offs = ((fq & 1) ? ev : 0.f) + ((fq & 2) ? __uint_as_float(r32[0]) : 0.f); }
#pragma unroll
                    for (int r = 0; r < 4; ++r) { const int idx = (4 * fq + r) * 64 + 16 * ct + fn; E1[idx] = e[r]; CUM[idx] = cs[r] + offs; AV[idx] = sigmoid_f(aa[r] + a0c); }
                } else {
                    f32x4 ag = {0.f, 0.f, 0.f, 0.f};
#pragma unroll
                    for (int ks = 0; ks < 5; ++ks) ag = __builtin_amdgcn_mfma_f32_16x16x32_bf16(ldfrag(lds + A_ACTG + fn * ACT_GS + (32 * ks + 8 * fq) * 2), Bg[ks], ag, 0, 0, 0);
                    #pragma unroll
                    for (int r = 0; r < 4; ++r) GVa[(4 * fq + r) * 64 + 16 * ct + fn] = ag[r];
                }
            }
            if (doB) {
                if (wave >= 4) {
                    const int vt = wave - 4;
                    f32x4 gkt = {0.f, 0.f, 0.f, 0.f}, grbt = gkt, grkt = gkt, gb = gkt, gbt = gkt; yacc = gkt; racc = gkt;
#pragma unroll
                    for (int ks = 0; ks < 2; ++ks) {
                        const bf16x8 fkt = ldfrag(HB + H_OPS + fn * OPS + (32 * ks + 8 * fq) * 2), fbt = ldfrag(HB + H_OPS + 2304 + fn * OPS + (32 * ks + 8 * fq) * 2);
                        const bf16x8 fkk = ldfrag(HB + H_OPS + 4608 + fn * OPS + (32 * ks + 8 * fq) * 2), frt = ldfrag(HB + H_OPS + 6912 + fn * OPS + (32 * ks + 8 * fq) * 2);
                        const bf16x8 sb_ = ldfrag(lds + B_S0 + (16 * vt + fn) * OPS + (32 * ks + 8 * fq) * 2);
                        gkt = __builtin_amdgcn_mfma_f32_16x16x32_bf16(fkk, fkt, gkt, 0, 0, 0);
                        grbt = __builtin_amdgcn_mfma_f32_16x16x32_bf16(fbt, frt, grbt, 0, 0, 0);
                        grkt = __builtin_amdgcn_mfma_f32_16x16x32_bf16(fkk, frt, grkt, 0, 0, 0);
                        yacc = __builtin_amdgcn_mfma_f32_16x16x32_bf16(frt, sb_, yacc, 0, 0, 0);
                        racc = __builtin_amdgcn_mfma_f32_16x16x32_bf16(fkt, sb_, racc, 0, 0, 0);
                        gb = __builtin_amdgcn_mfma_f32_16x16x32_bf16(fkt, fbt, gb, 0, 0, 0);
                        gbt = __builtin_amdgcn_mfma_f32_16x16x32_bf16(fbt, fkt, gbt, 0, 0, 0); }
                    racc = -racc;
                    f32x4 lkA, lrbA, lrkA;
#pragma unroll
                    for (int r = 0; r < 4; ++r) { const int i_ = 4 * fq + r; lkA[r] = (i_ < fn) ? -gkt[r] : 0.f; lrbA[r] = (i_ <= fn) ? grbt[r] : 0.f; lrkA[r] = (i_ <= fn) ? grkt[r] : 0.f; }
                    const s16x4 vB = *(const LAS s16x4*)(HB + H_SVT + (16 * vt + fn) * T32S + 32 + 8 * fq);
                    racc = __builtin_amdgcn_mfma_f32_16x16x16bf16_1k(pk4(lkA), vB, racc, 0, 0, 0);
                    { f32x4 Lm, Lt, Im;
#pragma unroll
                      for (int r = 0; r < 4; ++r) { const int t = 4 * fq + r; Lm[r] = (fn < t) ? gb[r] : 0.f; Lt[r] = (t < fn) ? gbt[r] : 0.f; Im[r] = (t == fn) ? 1.f : 0.f; }
                      const f32x4 z4 = {0.f, 0.f, 0.f, 0.f};
#define RW12_MM(MT, N) __builtin_amdgcn_mfma_f32_16x16x16bf16_1k(pk4(MT), pk4(N), z4, 0, 0, 0)
                      const f32x4 L2 = RW12_MM(Lt, Lm), L2t = RW12_MM(Lm, Lt);
                      const f32x4 L4 = RW12_MM(L2t, L2), L4t = RW12_MM(L2, L2t);
                      const f32x4 L8 = RW12_MM(L4t, L4);
                      const f32x4 F = RW12_MM(Im + L4t, Im + L8);
                      const f32x4 E = RW12_MM(Im + L2t, F) - Im;
                      const f32x4 ImLt = Im - Lt;
                      const f32x4 TT = ImLt + RW12_MM(E, ImLt);
#undef RW12_MM
                      f32x4 sa = z4;
#pragma unroll
                      for (int r = 0; r < 4; ++r) sa = __builtin_amdgcn_mfma_f32_16x16x4f32(TT[r], racc[r], sa, 0, 0, 0);
                      const s16x4 saB = pk4(sa);
                      yacc = __builtin_amdgcn_mfma_f32_16x16x16bf16_1k(pk4(lrbA), saB, yacc, 0, 0, 0);
                      yacc = __builtin_amdgcn_mfma_f32_16x16x16bf16_1k(pk4(lrkA), vB, yacc, 0, 0, 0);
                      LAS float* Yw = (it & 1) ? Yf1 : Yf;
#pragma unroll
                      for (int r = 0; r < 4; ++r) Yw[(4 * fq + r) * 64 + 16 * vt + fn] = yacc[r];
                      *(LAS s16x4*)(HB + H_SVT + (16 * vt + fn) * T32S + 8 * fq) = saB; }
                }
            }
            if (doPost && wave < 4) {
                const f32x4 lw = *(const LAS f32x4*)(CST + 192 + c4), lb = *(const LAS f32x4*)(CST + 256 + c4);
                const f32x4 y4 = *(const LAS f32x4*)(((it & 1) ? Yf : Yf1) + tq * 64 + c4), v4 = *(const LAS f32x4*)((LAS float*)(HA + H_VF) + tq * 64 + c4), g4 = *(const LAS f32x4*)((LAS float*)(HA + H_GV) + tq * 64 + c4);
                const float bo = ((const LAS float*)(HA + H_SC))[tq];
                const float mean = row16_sum((y4.x + y4.y) + (y4.z + y4.w)) * (1.f / 64.f);
                const f32x4 d = y4 - mean;
                const float var = row16_sum((d.x * d.x + d.y * d.y) + (d.z * d.z + d.w * d.w)) * (1.f / 64.f);
                const float rstd = __builtin_amdgcn_rsqf(var + 64e-5f);
                const f32x4 o = (d * rstd * lw + lb + v4 * bo) * g4;
                GAS unsigned long long* dst = (GAS unsigned long long*)(O + (size_t)(b * T + (it - 2) * CH + tq) * D + 1024 + hc + c4);
                *dst = (unsigned long long)pk2(o.x, o.y) | ((unsigned long long)pk2(o.z, o.w) << 32);
            }
            RW12_BAR();
            if (doA && wave < 4) {
                const LAS float* Rf = (const LAS float*)(lds + ((it & 1) ? B_RK2 : A_RK)); const LAS float* Kf = Rf + 1024; const LAS float* Vfa = Rf + 2048;
                const f32x4 kkc = *(const LAS f32x4*)(CST + c4), kac = *(const LAS f32x4*)(CST + 64 + c4), rkc = *(const LAS f32x4*)(CST + 128 + c4);
                const f32x4 k4 = *(const LAS f32x4*)(Kf + tq * 64 + c4), r4 = *(const LAS f32x4*)(Rf + tq * 64 + c4), v4 = *(const LAS f32x4*)(Vfa + tq * 64 + c4);
                *(LAS f32x4*)((LAS float*)(HA + H_VF) + tq * 64 + c4) = v4; *(LAS f32x4*)((LAS float*)(HA + H_GV) + tq * 64 + c4) = *(const LAS f32x4*)(GVa + tq * 64 + c4);
                const f32x4 e4 = *(const LAS f32x4*)(E1 + tq * 64 + c4), cm = *(const LAS f32x4*)(CUM + tq * 64 + c4), a4 = *(const LAS f32x4*)(AV + tq * 64 + c4);
                f32x4 kk = k4 * kkc;
                const float ss = row16_sum((kk.x * kk.x + kk.y * kk.y) + (kk.z * kk.z + kk.w * kk.w));
                const float inv = ss > 1e-24f ? __builtin_amdgcn_rsqf(ss) : 1e12f;
                kk = kk * inv;
                const f32x4 kmod = k4 * (1.0f + (a4 - 1.0f) * kac);
                const f32x4 bv = kk * a4;
                const f32x4 bo4 = kmod * r4 * rkc;
                const float bo = row16_sum((bo4.x + bo4.y) + (bo4.z + bo4.w));
                if ((tid & 15) == 0) ((LAS float*)(HA + H_SC))[tq] = bo;
                f32x4 em, ep, emx;
#pragma unroll
                for (int j = 0; j < 4; ++j) { em[j] = ex2(-cm[j] * LOG2E); ep[j] = rcp(em[j]); emx[j] = ex2((e4[j] - cm[j]) * LOG2E); }
                if (tq == CH - 1) *(LAS f32x4*)((LAS float*)(HA + H_DC) + c4) = em;
                const f32x4 okt = kk * emx, obt = bv * ep, okk = kmod * ep, ort = r4 * em;
                typedef unsigned u32x2 __attribute__((ext_vector_type(2)));
                *(LAS u32x2*)(HA + H_OPS + tq * OPS + c4 * 2) = (u32x2){pk2(okt.x, okt.y), pk2(okt.z, okt.w)};
                *(LAS u32x2*)(HA + H_OPS + 2304 + tq * OPS + c4 * 2) = (u32x2){pk2(obt.x, obt.y), pk2(obt.z, obt.w)};
                *(LAS u32x2*)(HA + H_OPS + 4608 + tq * OPS + c4 * 2) = (u32x2){pk2(okk.x, okk.y), pk2(okk.z, okk.w)};
                *(LAS u32x2*)(HA + H_OPS + 6912 + tq * OPS + c4 * 2) = (u32x2){pk2(ort.x, ort.y), pk2(ort.z, ort.w)};
#pragma unroll
                for (int j = 0; j < 4; ++j) { st16(HA + H_BKT + (c4 + j) * T32S + tq * 2, obt[j]); st16(HA + H_BKT + (c4 + j) * T32S + 32 + tq * 2, okk[j]); st16(HA + H_SVT + (c4 + j) * T32S + 32 + tq * 2, v4[j]); }
            }
            if (doB) {
                const int id0 = 2 * wave, vt = id0 >> 2, kt0 = id0 & 3;
                const bf16x8 af = ldfrag(HB + H_SVT + (16 * vt + fn) * T32S + fq * 16);
                const LAS float* DC = (const LAS float*)(HB + H_DC);
                sacc0 = __builtin_amdgcn_mfma_f32_16x16x32_bf16(af, ldfrag(HB + H_BKT + (16 * kt0 + fn) * T32S + fq * 16), sacc0, 0, 0, 0);
                sacc1 = __builtin_amdgcn_mfma_f32_16x16x32_bf16(af, ldfrag(HB + H_BKT + (16 * kt0 + 16 + fn) * T32S + fq * 16), sacc1, 0, 0, 0);
                sacc0 = sacc0 * DC[16 * kt0 + fn]; sacc1 = sacc1 * DC[16 * kt0 + 16 + fn];
#pragma unroll
                for (int r = 0; r < 4; ++r) { st16(lds + B_S0 + (16 * vt + 4 * fq + r) * OPS + (16 * kt0 + fn) * 2, sacc0[r]); st16(lds + B_S0 + (16 * vt + 4 * fq + r) * OPS + (16 * kt0 + 16 + fn) * 2, sacc1[r]); }
            }
            if (doP2) {
                LAS float* Rf = (LAS float*)(lds + ((it & 1) ? A_RK : B_RK2)); LAS float* Vfa = Rf + 2048;
                RW12_ITEMS();
#pragma unroll
                for (int i = 0; i < 2; ++i) if (it_ok[i]) {
                    const int t = it_t[i], chunk = it_c[i];
                    const f32x4 m0 = *(const LAS f32x4*)(MU + chunk * 8), m1 = *(const LAS f32x4*)(MU + chunk * 8 + 4);
                    float x[8];
                    { const unsigned cw[4] = {own[i].x, own[i].y, own[i].z, own[i].w}; const unsigned pw[4] = {prv[i].x, prv[i].y, prv[i].z, prv[i].w}; const float mm[8] = {m0.x, m0.y, m0.z, m0.w, m1.x, m1.y, m1.z, m1.w};
#pragma unroll
                      for (int j = 0; j < 4; ++j) { const float a0 = bflo(cw[j]), a1 = bfhi(cw[j]), q0 = bflo(pw[j]), q1 = bfhi(pw[j]);
                          x[2 * j] = a0 + (q0 - a0) * mm[2 * j]; x[2 * j + 1] = a1 + (q1 - a1) * mm[2 * j + 1]; } }
                    if (chunk < 24) { LAS float* dst = (chunk < 16 ? Rf + (chunk >> 3) * 1024 : Vfa) + t * 64 + 8 * (chunk & 7);
                        *(LAS f32x4*)dst = (f32x4){x[0], x[1], x[2], x[3]}; *(LAS f32x4*)(dst + 4) = (f32x4){x[4], x[5], x[6], x[7]}; }
                    else {
                        float y[8];
                        if (chunk < 32) {
#pragma unroll
                            for (int j = 0; j < 8; ++j) y[j] = 1.0f - 2.0f * rcp(ex2(x[j] * (2.0f * LOG2E)) + 1.0f);
                        } else if (chunk < 40) {
#pragma unroll
                            for (int j = 0; j < 8; ++j) y[j] = x[j];
                        } else {
#pragma unroll
                            for (int j = 0; j < 8; ++j) y[j] = sigmoid_f(x[j]);
                        }
                        v4u o; o.x = pk2(y[0], y[1]); o.y = pk2(y[2], y[3]); o.z = pk2(y[4], y[5]); o.w = pk2(y[6], y[7]);
                        const int off = chunk < 32 ? A_ACTW + t * ACT_WS + (chunk - 24) * 16 : chunk < 40 ? A_ACTA + t * ACT_WS + (chunk - 32) * 16 : A_ACTG + t * ACT_GS + (chunk - 40) * 16;
                        *(LAS v4u*)(lds + off) = o;
                    }
                }
                if (it + 2 < NCH) { RW12_FETCH(it + 2); }
            }
            RW12_BAR();
        }
    }
}
}
namespace sb {
using f32x16 = __attribute__((ext_vector_type(16))) float;
using s16x4 = __attribute__((ext_vector_type(4))) short;
constexpr int NSLOT = 3, SLOTB = 16384;
constexpr int LDS_K = 0, LDS_V = NSLOT * SLOTB, LDS_OST = 2 * NSLOT * SLOTB, LDS_CNT = LDS_OST + 8 * 4096;
constexpr float QSCALE = 0.125f * 1.4426950408889634f;
__device__ __forceinline__ int crow(int r, int hi) { return (r & 3) + 8 * (r >> 2) + 4 * hi; }
__device__ __forceinline__ void glds16(const void* gsrc, unsigned lds_dst) { unsigned keep;
    asm volatile("s_mov_b32 %0, m0\n\ts_mov_b32 m0, %2\n\ts_nop 0\n\tglobal_load_lds_dwordx4 %1, off\n\ts_mov_b32 m0, %0" : "=&s"(keep) : "v"(gsrc), "s"(lds_dst) : "memory"); }
#define SB_WAIT_BAR(N) asm volatile("s_waitcnt vmcnt(" #N ") lgkmcnt(0)\n\ts_barrier" ::: "memory")

__device__ __forceinline__ void qkt(f32x16& p0, f32x16& p1, const LAS unsigned char* Kslot, const bf16x8* qr, int r32, int hi) {
    const LAS unsigned char* kb = Kslot + hi * 1024 + r32 * 16;
    p0 = f32x16{}; p1 = f32x16{};
#pragma unroll
    for (int d0 = 0; d0 < 4; ++d0) {
        const bf16x8 b0 = *(const LAS bf16x8*)(kb + d0 * 2048);
        const bf16x8 b1 = *(const LAS bf16x8*)(kb + d0 * 2048 + 512);
        p0 = __builtin_amdgcn_mfma_f32_32x32x16_bf16(b0, qr[d0], p0, 0, 0, 0);
        p1 = __builtin_amdgcn_mfma_f32_32x32x16_bf16(b1, qr[d0], p1, 0, 0, 0);
    }
}
__device__ __forceinline__ void pv(f32x16* o, unsigned vb, bf16x8 pa0, bf16x8 pa1, bf16x8 pa2, bf16x8 pa3) {
#pragma unroll
    for (int d0 = 0; d0 < 2; ++d0) { s16x4 lo[4], hi[4];
#pragma unroll
        for (int ks = 0; ks < 4; ++ks) {
            asm volatile("ds_read_b64_tr_b16 %0,%1 offset:%c2" : "=&v"(lo[ks]) : "v"(vb), "i"(d0 * 4096 + ks * 1024) : "memory");
            asm volatile("ds_read_b64_tr_b16 %0,%1 offset:%c2" : "=&v"(hi[ks]) : "v"(vb), "i"(d0 * 4096 + ks * 1024 + 512) : "memory"); }
        asm volatile("s_waitcnt lgkmcnt(0)" ::: "memory"); __builtin_amdgcn_sched_barrier(0);
#define SB_PK(k) (bf16x8){lo[k][0], lo[k][1], lo[k][2], lo[k][3], hi[k][0], hi[k][1], hi[k][2], hi[k][3]}
        o[d0] = __builtin_amdgcn_mfma_f32_32x32x16_bf16(pa0, SB_PK(0), o[d0], 0, 0, 0);
        o[d0] = __builtin_amdgcn_mfma_f32_32x32x16_bf16(pa1, SB_PK(1), o[d0], 0, 0, 0);
        o[d0] = __builtin_amdgcn_mfma_f32_32x32x16_bf16(pa2, SB_PK(2), o[d0], 0, 0, 0);
        o[d0] = __builtin_amdgcn_mfma_f32_32x32x16_bf16(pa3, SB_PK(3), o[d0], 0, 0, 0);
#undef SB_PK
    }
}
__device__ __forceinline__ unsigned cvtpk(float lo, float hi) { unsigned r; asm("v_cvt_pk_bf16_f32 %0, %1, %2" : "=v"(r) : "v"(lo), "v"(hi)); return r; }

template <bool MASK> __device__ __forceinline__ void sb_weights(f32x16& P0, f32x16& P1, float& Pr, int kvrel0, int hi) {
#pragma unroll
    for (int r = 0; r < 32; ++r) {
        const float z = r < 16 ? P0[r] : P1[r - 16];
        float kp = __builtin_amdgcn_rcpf(1.0f + __builtin_amdgcn_exp2f(z));
        if (MASK) { if (kvrel0 >= -((r & 3) + 8 * ((r & 15) >> 2) + 32 * (r >> 4))) kp = 1.0f; }
        if (r < 16) P0[r] = kp; else P1[r - 16] = kp;
    }
#define SB_KP(r) ((r) < 16 ? P0[(r)] : P1[(r) - 16])
    float gt[8];
#pragma unroll
    for (int g = 0; g < 8; ++g) gt[g] = (SB_KP(4 * g + 3) * SB_KP(4 * g + 2)) * (SB_KP(4 * g + 1) * SB_KP(4 * g));
    float sg[8]; float run = Pr;
#pragma unroll
    for (int g = 7; g >= 0; --g) {
        auto rr = __builtin_amdgcn_permlane32_swap(__float_as_uint(gt[g]), __float_as_uint(gt[g]), false, false);
        const float lo_t = __uint_as_float(rr[0]), up_t = __uint_as_float(rr[1]);
        const float s_up = run;
        const float s_lo = run * up_t;
        run = s_lo * lo_t;
        sg[g] = hi ? s_up : s_lo;
    }
    Pr = run;
#pragma unroll
    for (int g = 0; g < 8; ++g) {
        const float t4 = sg[g], t3 = t4 * SB_KP(4 * g + 3), t2 = t3 * SB_KP(4 * g + 2), t1 = t2 * SB_KP(4 * g + 1), t0 = t1 * SB_KP(4 * g);
        const float w3 = t4 - t3, w2 = t3 - t2, w1 = t2 - t1, w0 = t1 - t0;
        if (g < 4) { P0[4 * g] = w0; P0[4 * g + 1] = w1; P0[4 * g + 2] = w2; P0[4 * g + 3] = w3; } else { P1[4 * g - 16] = w0; P1[4 * g - 15] = w1; P1[4 * g - 14] = w2; P1[4 * g - 13] = w3; }
    }
#undef SB_KP
}

__device__ __forceinline__ void attn_unit(int b, int h, int qb, const bf16* Z, bf16* O, LAS unsigned char* lds, int tid_in) {
    int tid = tid_in; asm volatile("" : "+v"(tid));
    const int lane = tid & 63, r32 = lane & 31, hi = lane >> 5; const int wid = __builtin_amdgcn_readfirstlane(tid >> 6);
    const size_t rowbase = (size_t)b * T; const int q0 = qb * 256;
    const bf16* Qw = Z + (rowbase + q0 + wid * 32) * ZP + ZC_Q + h * 64;
    const bf16* Kh = Z + rowbase * ZP + ZC_K + h * 64; const bf16* Vh = Z + rowbase * ZP + ZC_V + h * 64;
    const unsigned lds0 = (unsigned)(size_t)lds;
    LAS unsigned* CNT = (LAS unsigned*)(lds + LDS_CNT);
    if (tid < 3) CNT[tid] = 0u;
    const bf16* ksrc = Kh + (size_t)lane * ZP + wid * 8;
    const bf16* vsrc = Vh + (size_t)(16 * (wid & 3) + (lane >> 2)) * ZP + (wid >> 2) * 32 + (lane & 3) * 8;
    const unsigned kdst = lds0 + LDS_K + wid * 1024, vdst = lds0 + LDS_V + wid * 1024;
#define SB_DMA_K(j, so) glds16(ksrc + (size_t)(j) * 64 * ZP, (unsigned)__builtin_amdgcn_readfirstlane(kdst + (so)))
#define SB_DMA_V(j, so) glds16(vsrc + (size_t)(j) * 64 * ZP, (unsigned)__builtin_amdgcn_readfirstlane(vdst + (so)))
    const int NT = (q0 + 256) / 128;
#define SB_DMA2(J, so) do { SB_DMA_K(2 * (J) + 1, (so)); SB_DMA_V(2 * (J) + 1, (so)); SB_DMA_K(2 * (J), (so) + 8192); SB_DMA_V(2 * (J), (so) + 8192); } while (0)
    SB_DMA2(NT - 1, 0); if (NT > 1) SB_DMA2(NT - 2, SLOTB);
    bf16x8 qr[4];
#pragma unroll
    for (int d0 = 0; d0 < 4; ++d0) qr[d0] = *(const GAS bf16x8*)(Qw + (size_t)r32 * ZP + d0 * 16 + hi * 8);
    asm volatile("" : "+v"(qr[0]), "+v"(qr[1]), "+v"(qr[2]), "+v"(qr[3]));
    f32x16 o[2]; o[0] = f32x16{}; o[1] = f32x16{};
    float Pr = 1.0f; bool wdone = false;
    const int tq = q0 + wid * 32 + r32, tmin = q0 + wid * 32, tmax = tmin + 31;
    const unsigned vb0 = lds0 + LDS_V + ((lane >> 4) & 1) * 32 + (lane & 3) * 8 + (4 * hi + ((lane & 15) >> 2)) * 64;
    int so_cur = 0, so_n2 = 2 * SLOTB;
    for (int i = 0; i < NT; ++i) {
        const int j = NT - 1 - i;
        if (i + 1 < NT) { SB_WAIT_BAR(4); } else { SB_WAIT_BAR(0); }
        if (i > 0) { const unsigned votes = CNT[(i - 1) % 3]; if (votes == 8u) break; }
        if (tid == 0) CNT[(i + 1) % 3] = 0u;
        if (i + 2 < NT) SB_DMA2(j - 2, so_n2);
#pragma unroll
        for (int sub = 0; sub < 2; ++sub) {
            const int kv0 = 128 * j + 64 * (1 - sub), so_t = so_cur + sub * 8192;
            if (kv0 < tmax && !wdone) {
                f32x16 P0, P1;
                qkt(P0, P1, lds + LDS_K + so_t, qr, r32, hi);
                if (kv0 + 63 >= tmin) sb_weights<true>(P0, P1, Pr, kv0 - tq + 4 * hi, hi); else sb_weights<false>(P0, P1, Pr, 0, hi);
                v4u pw0, pw1, pw2, pw3;
                pw0.x = cvtpk(P0[0], P0[1]); pw0.y = cvtpk(P0[2], P0[3]); pw0.z = cvtpk(P0[4], P0[5]); pw0.w = cvtpk(P0[6], P0[7]);
                pw1.x = cvtpk(P0[8], P0[9]); pw1.y = cvtpk(P0[10], P0[11]); pw1.z = cvtpk(P0[12], P0[13]); pw1.w = cvtpk(P0[14], P0[15]);
                pw2.x = cvtpk(P1[0], P1[1]); pw2.y = cvtpk(P1[2], P1[3]); pw2.z = cvtpk(P1[4], P1[5]); pw2.w = cvtpk(P1[6], P1[7]);
                pw3.x = cvtpk(P1[8], P1[9]); pw3.y = cvtpk(P1[10], P1[11]); pw3.z = cvtpk(P1[12], P1[13]); pw3.w = cvtpk(P1[14], P1[15]);
                pv(o, vb0 + so_t, __builtin_bit_cast(bf16x8, pw0), __builtin_bit_cast(bf16x8, pw1), __builtin_bit_cast(bf16x8, pw2), __builtin_bit_cast(bf16x8, pw3));
                wdone = __all(Pr == 0.0f);
            }
        }
        if (wdone && lane == 0) __hip_atomic_fetch_add(CNT + (i % 3), 1u, __ATOMIC_RELAXED, __HIP_MEMORY_SCOPE_WORKGROUP);
        so_cur = (so_cur == 2 * SLOTB) ? 0 : so_cur + SLOTB; so_n2 = (so_n2 == 2 * SLOTB) ? 0 : so_n2 + SLOTB;
    }
    { LAS bf16* stg = (LAS bf16*)(lds + LDS_OST) + wid * 2048;
#pragma unroll
      for (int r = 0; r < 16; ++r) { const int orow = crow(r, hi);
#pragma unroll
          for (int d0 = 0; d0 < 2; ++d0) stg[orow * 64 + d0 * 32 + r32] = (bf16)f2bf(o[d0][r]); }
      asm volatile("s_waitcnt lgkmcnt(0)" ::: "memory");
      bf16* Ow = O + (rowbase + q0 + wid * 32) * D + h * 64;
#pragma unroll
      for (int i = 0; i < 4; ++i) { const int row = i * 8 + (lane >> 3), ch = lane & 7; const v4u v = *(const LAS v4u*)(stg + row * 64 + ch * 8); *(GAS v4u*)(Ow + (size_t)row * D + ch * 8) = v; } }
    asm volatile("s_waitcnt vmcnt(0) lgkmcnt(0)\n\ts_barrier" ::: "memory");
#undef SB_DMA2
#undef SB_DMA_K
#undef SB_DMA_V
}
__device__ __forceinline__ void attn_phase(const bf16* Z, bf16* O, LAS unsigned char* lds, int tid, int G) {
    for (int bh = blockIdx.x; bh < BATCH * 16; bh += G)
        for (int qb = 7; qb >= 0; --qb) attn_unit(bh >> 4, bh & 15, qb, Z, O, lds, tid);
}
}
namespace sg {
using f32x16 = __attribute__((ext_vector_type(16))) float;
using s16x4 = __attribute__((ext_vector_type(4))) short;
typedef unsigned u32x2 __attribute__((ext_vector_type(2)));
constexpr int XS_STRIDE = 576, WS_STRIDE = 272, PT_STRIDE = 36  ;
static_assert(8 * 64 * PT_STRIDE * 4 <= 128 * XS_STRIDE, "patches fit the X image");
constexpr int L_XS = 0, L_WS = 128 * XS_STRIDE, L_STAT = L_WS + 128 * WS_STRIDE, L_BS = L_STAT + 1024;
#define SG_BAR() asm volatile("s_waitcnt lgkmcnt(0)\n\ts_barrier" ::: "memory")
__device__ __forceinline__ int crow(int r, int hi) { return (r & 3) + 8 * (r >> 2) + 4 * hi; }

__device__ __forceinline__ void sgu_phase(const float* ln_g, const float* ln_b, const float* w_s, const float* b_s, const bf16* ZC, bf16* O, LAS unsigned char* lds, int tid_in, int G) {
    LAS float* STAT = (LAS float*)(lds + L_STAT); LAS float* BS = (LAS float*)(lds + L_BS);
    for (int bn = blockIdx.x; bn < BATCH * 16; bn += G) {
        int tid = tid_in; asm volatile("" : "+v"(tid));
        const int lane = tid & 63, wave = __builtin_amdgcn_readfirstlane(tid >> 6), r32 = lane & 31, hi = lane >> 5;
        const size_t rowbase = (size_t)bn * 128;
#pragma unroll 2
        for (int rr = 0; rr < 16; ++rr) {
            const int row = 16 * wave + rr;
            const GAS v4u* vr = (const GAS v4u*)(ZC + (rowbase + row) * 4096 + 2048) + lane;
            float x[32]; float s = 0.f;
#pragma unroll
            for (int j = 0; j < 4; ++j) { const v4u w = vr[64 * j];
                x[8 * j + 0] = bflo(w.x); x[8 * j + 1] = bfhi(w.x); x[8 * j + 2] = bflo(w.y); x[8 * j + 3] = bfhi(w.y); x[8 * j + 4] = bflo(w.z); x[8 * j + 5] = bfhi(w.z); x[8 * j + 6] = bflo(w.w); x[8 * j + 7] = bfhi(w.w); }
#pragma unroll
            for (int j = 0; j < 32; ++j) s += x[j];
            const float mean = wave_sum(s) * (1.f / 2048.f); float q = 0.f;
#pragma unroll
            for (int j = 0; j < 32; ++j) { const float d = x[j] - mean; q += d * d; }
            const float rstd = 1.0f / sqrtf(wave_sum(q) * (1.f / 2048.f) + 1e-5f);
            if (lane == 0) { STAT[2 * row] = mean; STAT[2 * row + 1] = rstd; }
        }
        SG_BAR();
        const int cc = tid & 31;
        v4u xv[8];
#define SG_FETCH(gg) do { unsigned vo_ = (unsigned)(((tid >> 5) * 4096 + 8 * cc) * 2); asm volatile("" : "+v"(vo_));     \
            const GAS unsigned char* zb_ = (const GAS unsigned char*)(ZC + rowbase * 4096 + 2048 + 256 * (gg)); \
            _Pragma("unroll") for (int i = 0; i < 8; ++i) xv[i] = *(const GAS v4u*)(zb_ + (size_t)i * (16 * 4096 * 2) + vo_); } while (0)
        SG_FETCH(0);
#pragma unroll 1
        for (int g = 0; g < 8; ++g) {
            f32x4 wv[8];
#pragma unroll
            for (int i = 0; i < 8; ++i) { const int id = tid + 512 * i, s = id >> 5; wv[i] = *(const GAS f32x4*)(w_s + ((size_t)g * 128 + s) * 128 + 4 * cc); }
            const f32x4 lg0 = *(const GAS f32x4*)(ln_g + 256 * g + 8 * cc), lg1 = *(const GAS f32x4*)(ln_g + 256 * g + 8 * cc + 4);
            const f32x4 lb0 = *(const GAS f32x4*)(ln_b + 256 * g + 8 * cc), lb1 = *(const GAS f32x4*)(ln_b + 256 * g + 8 * cc + 4);
            if (tid < 128) BS[tid] = b_s[g * 128 + tid];
#pragma unroll
            for (int i = 0; i < 8; ++i) { const int id = tid + 512 * i, s = id >> 5;
                const float mean = STAT[2 * s], rstd = STAT[2 * s + 1];
                const v4u w = xv[i];
                const f32x4 a0 = ((f32x4){bflo(w.x), bfhi(w.x), bflo(w.y), bfhi(w.y)} - mean) * rstd * lg0 + lb0;
                const f32x4 a1 = ((f32x4){bflo(w.z), bfhi(w.z), bflo(w.w), bfhi(w.w)} - mean) * rstd * lg1 + lb1;
                v4u o; o.x = pk2(a0.x, a0.y); o.y = pk2(a0.z, a0.w); o.z = pk2(a1.x, a1.y); o.w = pk2(a1.z, a1.w);
                *(LAS v4u*)(lds + L_XS + s * XS_STRIDE + cc * 16) = o;
                u32x2 p; p.x = pk2(wv[i].x, wv[i].y); p.y = pk2(wv[i].z, wv[i].w);
                *(LAS u32x2*)(lds + L_WS + s * WS_STRIDE + cc * 8) = p; }
            SG_BAR();
            if (g < 7) SG_FETCH(g + 1);
            f32x16 acc[4];
#pragma unroll
            for (int tt = 0; tt < 4; ++tt) acc[tt] = f32x16{};
            const unsigned xb = (unsigned)(size_t)(lds + L_XS) + (8 * hi + ((lane & 15) >> 2)) * XS_STRIDE + (32 * wave + 16 * ((lane >> 4) & 1) + 4 * (lane & 3)) * 2;
            const unsigned xb4 = xb + 4 * XS_STRIDE;
            const LAS unsigned char* wb = lds + L_WS + r32 * WS_STRIDE + 16 * hi;
#pragma unroll
            for (int ks = 0; ks < 8; ++ks) {
                s16x4 lo, up;
                asm volatile("ds_read_b64_tr_b16 %0,%1 offset:%c2" : "=&v"(lo) : "v"(xb), "i"(ks * 16 * XS_STRIDE) : "memory");
                asm volatile("ds_read_b64_tr_b16 %0,%1 offset:%c2" : "=&v"(up) : "v"(xb4), "i"(ks * 16 * XS_STRIDE) : "memory");
                bf16x8 af[4];
#pragma unroll
                for (int tt = 0; tt < 4; ++tt) if (tt >= 2 || ks < 4) af[tt] = *(const LAS bf16x8*)(wb + tt * 32 * WS_STRIDE + ks * 32);
                asm volatile("s_waitcnt lgkmcnt(0)" ::: "memory"); __builtin_amdgcn_sched_barrier(0);
                const bf16x8 bfr = (bf16x8){lo[0], lo[1], lo[2], lo[3], up[0], up[1], up[2], up[3]};
#pragma unroll
                for (int tt = 0; tt < 4; ++tt) if (tt >= 2 || ks < 4) acc[tt] = __builtin_amdgcn_mfma_f32_32x32x16_bf16(af[tt], bfr, acc[tt], 0, 0, 0);
            }
            const size_t ccol = (size_t)(256 * g + 32 * wave + 8 * (lane & 3));
            v4u uq[4];
#pragma unroll
            for (int j = 0; j < 4; ++j) uq[j] = *(const GAS v4u*)(ZC + (rowbase + 16 * j + (lane >> 2)) * 4096 + ccol);
            SG_BAR();
            LAS float* PT = (LAS float*)(lds + L_XS + wave * (64 * PT_STRIDE * 4));
#pragma unroll
            for (int half = 0; half < 2; ++half) {
#pragma unroll
                for (int t2 = 0; t2 < 2; ++t2)
#pragma unroll
                    for (int r = 0; r < 16; ++r) { const int tl = 32 * t2 + crow(r, hi); PT[tl * PT_STRIDE + r32] = acc[2 * half + t2][r] + BS[64 * half + tl]; }
                asm volatile("s_waitcnt lgkmcnt(0)" ::: "memory");
                v4u un[4];
                if (half == 0) {
#pragma unroll
                    for (int j = 0; j < 4; ++j) un[j] = *(const GAS v4u*)(ZC + (rowbase + 64 + 16 * j + (lane >> 2)) * 4096 + ccol); }
#pragma unroll
                for (int j = 0; j < 4; ++j) { const int tl = 16 * j + (lane >> 2);
                    const f32x4 m0 = *(const LAS f32x4*)(PT + tl * PT_STRIDE + 8 * (lane & 3)), m1 = *(const LAS f32x4*)(PT + tl * PT_STRIDE + 8 * (lane & 3) + 4);
                    const v4u w = uq[j];
                    v4u o; o.x = pk2(m0.x * bflo(w.x), m0.y * bfhi(w.x)); o.y = pk2(m0.z * bflo(w.y), m0.w * bfhi(w.y)); o.z = pk2(m1.x * bflo(w.z), m1.y * bfhi(w.z)); o.w = pk2(m1.z * bflo(w.w), m1.w * bfhi(w.w));
                    *(GAS v4u*)(O + (rowbase + 64 * half + tl) * D + ccol) = o; }
                if (half == 0) {
#pragma unroll
                    for (int j = 0; j < 4; ++j) uq[j] = un[j]; }
                asm volatile("s_waitcnt lgkmcnt(0)" ::: "memory");
            }
            SG_BAR();
        }
    }
}
}
#define AS4 __attribute__((address_space(4)))
__device__ __forceinline__ const AS4 unsigned char* kargs() { const AS4 unsigned char* kp = (const AS4 unsigned char*)__builtin_amdgcn_kernarg_segment_ptr(); asm volatile("" : "+s"(kp)); return kp; }
__device__ __forceinline__ const float* arg_in(int k) { return *(const float* const AS4*)(kargs() + 8 * k); }
__device__ __forceinline__ float* arg_out() { return *(float* const AS4*)(kargs() + 200); }
__device__ __forceinline__ unsigned char* arg_ws() { return *(unsigned char* const AS4*)(kargs() + 208); }
static_assert(sizeof(Args) == 224, "Args layout: in[25] | out | ws | ph_lo | ph_hi");
#ifndef MK_ONE_LAUNCH
#define MK_ONE_LAUNCH 1
#endif
#ifndef MK_PROBE_DUP
#define MK_PROBE_DUP 0
#endif
#define DUP(k) for (int rep_ = 0; rep_ < 1 + ((MK_PROBE_DUP >> (k)) & 1); ++rep_)
__global__ void __launch_bounds__(NWAVES * 64, 2) fwd(Args a) {
    extern __shared__ __attribute__((aligned(16))) unsigned char lds_raw[];
    LAS unsigned char* lds = (LAS unsigned char*)lds_raw;
    const int wave = __builtin_amdgcn_readfirstlane((int)threadIdx.x >> 6), G = gridDim.x;
    for (int u = threadIdx.x; u < (LDS_BYTES - LDSCTL_OFF) / 4; u += NWAVES * 64) ((LAS unsigned*)(lds + LDSCTL_OFF))[u] = 0u;
    __syncthreads();
    XcdBarrier bar; bar.bar = (unsigned*)(arg_ws() + WS_CTL) + CW_BAR; bar.x = 0; bar.st = nullptr;
    if (MK_ONE_LAUNCH) bar = xcd_barrier_post((unsigned*)(arg_ws() + WS_CTL) + CW_BAR, (volatile LAS unsigned*)(lds + MISC_OFF) + 8);
    const int lo = a.ph_lo, hi = a.ph_hi;
#define IN(k) (lo <= (k) && (k) < hi)
#define SEAM(k) do { if (MK_ONE_LAUNCH && IN(k) && IN((k) + 1)) xcd_barrier(bar); } while (0)
#pragma unroll 1
    for (int L = 0; L < DEPTH; ++L) {
        const int pb = 8 * L, i = L >> 1; const bool even = !(L & 1);
#define FRESH_TID() int lane; asm volatile("v_mbcnt_lo_u32_b32 %0, -1, 0\n\tv_mbcnt_hi_u32_b32 %0, -1, %0" : "=v"(lane)); const int tid = wave * 64 + lane; (void)tid
        unsigned char* const ws = arg_ws();
        bf16* const H = (bf16*)(ws + WS_H); bf16* const BIG = (bf16*)(ws + WS_BIG);
        if (IN(pb + 0)) { FRESH_TID();
            const float* Win; const float* Wout; int Nin;
            if (even) { Win = arg_in(4) + (size_t)i * D * EVEN_N; Wout = arg_in(16) + (size_t)i * D * D; Nin = EVEN_N; } else { Win = arg_in(17) + (size_t)i * D * 4096; Wout = arg_in(22) + (size_t)i * D * D; Nin = 4096; }
            const float* x0 = nullptr; if (L == 0) x0 = arg_in(0);
            DUP(0) prep_phase(Win, Nin, Wout, arg_in(23) + (size_t)L * D * FF, arg_in(24) + (size_t)L * FF * D, x0, arg_in(1) + (size_t)L * D, arg_in(2) + (size_t)L * D, ws, even, lds, wave, lane, tid, G); SEAM(pb + 0); }
        if (IN(pb + 1)) { FRESH_TID();
            bf16* const WA = (bf16*)(ws + WS_WA);
            bf16* const XB = (bf16*)(ws + WS_XB); const float* const SSQ = (const float*)(ws + WS_SSQ);
            if (even) { pg8::Gemm g{XB, WA, M, ZP, D}; pg8::StaticOrder S; S.init(M, ZP, G, (int)blockIdx.x, 8); const int pm0 = pg8::rs_table(SSQ, S, lds, tid); pg8::EpiActS<0> E{BIG, ZP, 4, sb::QSCALE, (const LAS float*)(lds + pg8::LX_RS), pm0};
                DUP(5) pg8::gemm_phase<pg8::EpiActS<0>, pg8::StaticOrder, true, true>(lds, g, S, E, tid); }
            else { pg8::Gemm g{XB, WA, M, 4096, D}; pg8::StaticOrder S; S.init(M, 4096, G, (int)blockIdx.x, 8); const int pm0 = pg8::rs_table(SSQ, S, lds, tid); pg8::EpiActS<1> E{BIG, 4096, 0, 1.f, (const LAS float*)(lds + pg8::LX_RS), pm0};
                DUP(5) pg8::gemm_phase<pg8::EpiActS<1>, pg8::StaticOrder, true, true>(lds, g, S, E, tid); }
            SEAM(pb + 1);
        }
        if (IN(pb + 2)) { FRESH_TID();
            if (even) { DUP(1) sb::attn_phase(BIG, H, lds, tid, G); }
            else DUP(3) sg::sgu_phase(arg_in(18) + (size_t)i * 2048, arg_in(19) + (size_t)i * 2048, arg_in(20) + (size_t)i * 131072, arg_in(21) + (size_t)i * 1024, BIG, H, lds, tid, G);
        }
        if (IN(pb + 3)) { FRESH_TID();
            if (even) { const rw::Params q{arg_in(5) + (size_t)i * RWS, arg_in(6) + (size_t)i * 65536, arg_in(7) + (size_t)i * 1024, arg_in(8) + (size_t)i * 65536, arg_in(9) + (size_t)i * 1024, arg_in(10) + (size_t)i * 163840,
                    arg_in(11) + (size_t)i * 1024, arg_in(12) + (size_t)i * 1024, arg_in(13) + (size_t)i * 1024, arg_in(14) + (size_t)i * 1024, arg_in(15) + (size_t)i * 1024};
                DUP(2) rw12::rwkv_phase(q, BIG, H, lds, tid, (int)blockIdx.x, G); }
            SEAM(pb + 3); }
        if (IN(pb + 4)) { FRESH_TID(); pg8::Gemm g{H, (bf16*)(ws + WS_WB), M, D, D}; pg8::StaticOrder S; S.init(M, D, G, (int)blockIdx.x); pg8::EpiResidB E{(bf16*)(ws + WS_XB), (float*)(ws + WS_SSQ), D, lds};
            pg8::gemm_phase<pg8::EpiResidB, pg8::StaticOrder, true, true>(lds, g, S, E, tid); SEAM(pb + 4); }
        if (IN(pb + 6)) { FRESH_TID(); pg8::Gemm g{(bf16*)(ws + WS_XB), (bf16*)(ws + WS_W1), M, FF, D}; pg8::StaticOrder S; S.init(M, FF, G, (int)blockIdx.x, 8); const int pm0 = pg8::rs_table((const float*)(ws + WS_SSQ), S, lds, tid); pg8::EpiActS<2> E{BIG, FF, 0, 1.f, (const LAS float*)(lds + pg8::LX_RS), pm0};
            DUP(6) pg8::gemm_phase<pg8::EpiActS<2>, pg8::StaticOrder, true, true>(lds, g, S, E, tid); SEAM(pb + 6); }
        if (IN(pb + 7)) { FRESH_TID(); pg8::Gemm g{BIG, (bf16*)(ws + WS_W2), M, D, FF}; pg8::StaticOrder S; S.init(M, D, G, (int)blockIdx.x); pg8::EpiResidB E{(bf16*)(ws + WS_XB), (float*)(ws + WS_SSQ), D, lds};
            pg8::gemm_phase<pg8::EpiResidB, pg8::StaticOrder, true, true>(lds, g, S, E, tid); SEAM(pb + 7); }
    }
    if (IN(32)) { const int gw = blockIdx.x * NWAVES + wave, NGW = G * NWAVES; int lane; asm volatile("v_mbcnt_lo_u32_b32 %0, -1, 0\n\tv_mbcnt_hi_u32_b32 %0, -1, %0" : "=v"(lane)); float* const xo = arg_out(); const float* gf = arg_in(3); const bf16* const XB = (const bf16*)(arg_ws() + WS_XB);
        for (int m = gw; m < M; m += NGW) rms_row_out(XB + (size_t)m * D, gf, xo + (size_t)m * D, lane); }
#undef IN
#undef SEAM
}

extern "C" void kernel_launch(void* const* d_in, const int* in_sizes, int n_in, void* d_out, int out_size, void* d_ws, size_t ws_size, hipStream_t stream) {
    static int grid = 0;
    if (grid == 0) {
        if (n_in != 25 || out_size != M * D || ws_size < WS_END) { fprintf(stderr, "kernel_launch: unexpected shapes (n_in %d, out %d, ws %zu)\n", n_in, out_size, ws_size); grid = -1; return; }
        int dev = 0, cus = 0, per_cu = 0;
        if (hipGetDevice(&dev) != hipSuccess || hipDeviceGetAttribute(&cus, hipDeviceAttributeMultiprocessorCount, dev) != hipSuccess) { grid = -1; return; }
        if (hipFuncSetAttribute((const void*)fwd, hipFuncAttributeMaxDynamicSharedMemorySize, LDS_BYTES) != hipSuccess) { fprintf(stderr, "kernel_launch: hipFuncSetAttribute failed\n"); grid = -1; return; }
        if (hipOccupancyMaxActiveBlocksPerMultiprocessor(&per_cu, (const void*)fwd, NWAVES * 64, LDS_BYTES) != hipSuccess || per_cu < 1) fprintf(stderr, "kernel_launch: occupancy query reports %d\n", per_cu);
        (void)hipGetLastError();
        grid = cus;
    }
    if (grid < 0) return;
    (void)hipMemsetAsync((char*)d_ws + WS_CTL, 0, CTL_ZERO_BYTES, stream);
    Args a{};
    for (int i = 0; i < 25; ++i) a.in[i] = (const float*)d_in[i];
    a.out = (float*)d_out; a.ws = (unsigned char*)d_ws;
#if MK_ONE_LAUNCH
    a.ph_lo = 0; a.ph_hi = NPH;
    hipLaunchKernelGGL(fwd, dim3(grid), dim3(NWAVES * 64), LDS_BYTES, stream, a);
#else
    for (int p = 0; p < NPH; ++p) { a.ph_lo = p; a.ph_hi = p + 1;
        hipLaunchKernelGGL(fwd, dim3(grid), dim3(NWAVES * 64), LDS_BYTES, stream, a); }
#endif
}
```

```cpp
#include <hip/hip_runtime.h>
#include <cstdio>
#include <cstdint>
namespace pg8 {
#define PG8_LAS __attribute__((address_space(3)))
typedef unsigned short bf16_t;
typedef short bf16x8 __attribute__((ext_vector_type(8)));
typedef float f32x4 __attribute__((ext_vector_type(4)));
typedef unsigned u32x4 __attribute__((ext_vector_type(4)));
constexpr int BM = 256, BK = 64, HALF = 128, HTB = HALF * BK * 2  , STAGE_BYTES = 8 * HTB, NXCD = 8, WGM = 8;

__host__ __device__ __forceinline__ int lds_byte(int r, int c) { const int st = (r >> 4) * 2 + (c >> 5), rr = r & 15, cc = c & 31, ob = rr * 64 + cc * 2; return st * 1024 + (ob ^ (((ob >> 9) & 1) << 5)); }
__host__ __device__ __forceinline__ void stage_rc(int b, int& R, int& C) { const int st = b / 1024, sb = b % 1024, swz = sb ^ (((sb >> 9) & 1) << 5); R = (st >> 1) * 16 + swz / 64; C = (st & 1) * 32 + (swz % 64) / 2; }
__host__ __device__ __forceinline__ int perm32(int rho) { const int n = rho >> 4, i = rho & 15; return 8 * (i >> 2) + 4 * n + (i & 3); }

struct Unit { int pm, pn; };
struct Gemm { const bf16_t* A; const bf16_t* Bt; int M, N, K; };

struct StaticOrder {
    int nM, nN, nwg, G, c;
    int wgm = 4;
    __host__ __device__ void init(int M, int N, int G_, int c_, int wgm_ = 4) { nM = M / BM; nN = N / BM; nwg = nM * nN; G = G_; c = c_; wgm = wgm_; }
    __host__ __device__ bool next(int i, Unit& u) const {
        const long L = (long)i * G + c; if (L >= nwg) return false;
        int wgid = (int)L; { const int q = nwg / NXCD, r = nwg % NXCD, xcd = wgid % NXCD, off = wgid / NXCD; wgid = (xcd < r ? xcd * (q + 1) : r * (q + 1) + (xcd - r) * q) + off; }
        const int nig = wgm * nN, gid = wgid / nig, fm = gid * wgm, gsz = (nM - fm) < wgm ? (nM - fm) : wgm;
        u.pm = fm + ((wgid % nig) % gsz); u.pn = (wgid % nig) / gsz; return true;
    }
    __device__ __forceinline__ void a_ready(const Unit&) const {}
    __device__ __forceinline__ void done(const Unit&) const {}
};

__device__ __forceinline__ unsigned cvt_pk_bf16(float lo, float hi) { unsigned r; asm volatile("v_cvt_pk_bf16_f32 %0, %1, %2" : "=v"(r) : "v"(lo), "v"(hi)); return r; }
typedef float f32x2 __attribute__((ext_vector_type(2)));
__device__ __forceinline__ f32x2 gelu_pk(f32x2 v) {
    const f32x2 av = __builtin_elementwise_abs(v), d = av * 0.2316418882f + 1.0f;
    f32x2 t; t.x = __builtin_amdgcn_rcpf(d.x); t.y = __builtin_amdgcn_rcpf(d.y);
    f32x2 q = t * 0.5307027145f + (-0.7265760135f); q = q * t + 0.7107068705f; q = q * t + (-0.142248368f); q = q * t + 0.127414796f; q = q * t;
    const f32x2 s = (v * v) * (-0.72134752044f);
    f32x2 e; e.x = __builtin_amdgcn_exp2f(s.x); e.y = __builtin_amdgcn_exp2f(s.y);
    const f32x2 m = v * (q * e), r = v - m;
    f32x2 o; o.x = v.x < 0.f ? m.x : r.x; o.y = v.y < 0.f ? m.y : r.y; return o;
}
constexpr int LX_RED = 135168;
constexpr int LX_RS = 139264;
template <class Sched> __device__ __forceinline__ int rs_table(const float* ssq, const Sched& S, PG8_LAS unsigned char* lds0, int tid) {
    Unit ua, ub; if (!S.next(0, ua)) return 0;
    ub = ua; S.next((S.nwg - 1 - S.c) / S.G, ub);
    const int row = ((tid < BM) ? ua.pm : ub.pm) * BM + (tid & (BM - 1));
    const f32x4* p = (const f32x4*)(ssq + (size_t)row * 8); const f32x4 a = p[0], b = p[1];
    ((PG8_LAS float*)(lds0 + LX_RS))[tid] = __builtin_amdgcn_rsqf((((a[0] + a[1]) + (a[2] + a[3])) + ((b[0] + b[1]) + (b[2] + b[3]))) * (1.0f / 2048.0f) + 1e-6f);
    return ua.pm;
}
template <int ACT> struct EpiActS {
    static constexpr bool PERM = true, AFTER_DRAIN = false;
    bf16_t* O; int ldc; int nscale; float scale0; const PG8_LAS float* rs_tab; int pm0;
    __device__ __forceinline__ void operator()(const f32x4 (&acc)[2][2][4][2], const Unit& u, int wr, int wc, int fr, int fq) const {
        const int row0 = u.pm * BM + wr * 64 + fr; const int col0 = u.pn * BM + wc * 32 + 8 * fq;
        const float sc = (u.pn < nscale) ? scale0 : 1.f;
        float rs[2][4];
        const PG8_LAS float* rt = rs_tab + ((u.pm == pm0) ? 0 : BM) + wr * 64 + fr;
#pragma unroll
        for (int ai = 0; ai < 2; ++ai)
#pragma unroll
            for (int m = 0; m < 4; ++m) rs[ai][m] = rt[ai * HALF + m * 16];
#pragma unroll
        for (int ai = 0; ai < 2; ++ai)
#pragma unroll
            for (int m = 0; m < 4; ++m) { bf16_t* rowp = O + (size_t)(row0 + ai * HALF + m * 16) * ldc + col0; const float rsv = rs[ai][m];
#pragma unroll
                for (int bj = 0; bj < 2; ++bj) { f32x4 v0 = acc[ai][bj][m][0] * rsv, v1 = acc[ai][bj][m][1] * rsv;
                    if (ACT == 1) { f32x2 a = gelu_pk((f32x2){v0[0], v0[1]}), b = gelu_pk((f32x2){v0[2], v0[3]}), c = gelu_pk((f32x2){v1[0], v1[1]}), d = gelu_pk((f32x2){v1[2], v1[3]});
                        v0 = (f32x4){a.x, a.y, b.x, b.y}; v1 = (f32x4){c.x, c.y, d.x, d.y}; }
                    if (ACT == 2) { const f32x4 z = {0.f, 0.f, 0.f, 0.f}; v0 = __builtin_elementwise_max(v0, z); v1 = __builtin_elementwise_max(v1, z); v0 = v0 * v0; v1 = v1 * v1; }
                    if (ACT == 0) { v0 = v0 * sc; v1 = v1 * sc; }
                    u32x4 w; w.x = cvt_pk_bf16(v0[0], v0[1]); w.y = cvt_pk_bf16(v0[2], v0[3]); w.z = cvt_pk_bf16(v1[0], v1[1]); w.w = cvt_pk_bf16(v1[2], v1[3]);
                    *(u32x4*)(rowp + bj * HALF) = w; } }
    }
};
struct EpiResidB {
    static constexpr bool PERM = true, AFTER_DRAIN = false;
    bf16_t* xb; float* ssq; int ldc; PG8_LAS unsigned char* lds0;
    __device__ __forceinline__ void operator()(const f32x4 (&acc)[2][2][4][2], const Unit& u, int wr, int wc, int fr, int fq) const {
        const int col0 = u.pn * BM + wc * 32 + 8 * fq;
        PG8_LAS float* RED = (PG8_LAS float*)(lds0 + LX_RED);
#pragma unroll
        for (int ai = 0; ai < 2; ++ai)
#pragma unroll
            for (int m = 0; m < 4; ++m) { const int rl = ai * HALF + wr * 64 + m * 16 + fr; const size_t off = (size_t)(u.pm * BM + rl) * ldc + col0;
                u32x4 b[2];
#pragma unroll
                for (int bj = 0; bj < 2; ++bj) b[bj] = *(const u32x4*)(xb + off + bj * HALF);
                float q = 0.f;
#pragma unroll
                for (int bj = 0; bj < 2; ++bj) {
                    f32x4 o0 = {__uint_as_float(b[bj].x << 16), __uint_as_float(b[bj].x & 0xffff0000u), __uint_as_float(b[bj].y << 16), __uint_as_float(b[bj].y & 0xffff0000u)};
                    f32x4 o1 = {__uint_as_float(b[bj].z << 16), __uint_as_float(b[bj].z & 0xffff0000u), __uint_as_float(b[bj].w << 16), __uint_as_float(b[bj].w & 0xffff0000u)};
                    o0 = o0 + acc[ai][bj][m][0]; o1 = o1 + acc[ai][bj][m][1];
                    q += ((o0[0] * o0[0] + o0[1] * o0[1]) + (o0[2] * o0[2] + o0[3] * o0[3])) + ((o1[0] * o1[0] + o1[1] * o1[1]) + (o1[2] * o1[2] + o1[3] * o1[3]));
                    u32x4 w; w.x = cvt_pk_bf16(o0[0], o0[1]); w.y = cvt_pk_bf16(o0[2], o0[3]); w.z = cvt_pk_bf16(o1[0], o1[1]); w.w = cvt_pk_bf16(o1[2], o1[3]);
                    *(u32x4*)(xb + off + bj * HALF) = w; }
                { auto r16 = __builtin_amdgcn_permlane16_swap(__float_as_uint(q), __float_as_uint(q), false, false); q = __uint_as_float(r16[0]) + __uint_as_float(r16[1]);
                  auto r32 = __builtin_amdgcn_permlane32_swap(__float_as_uint(q), __float_as_uint(q), false, false); q = __uint_as_float(r32[0]) + __uint_as_float(r32[1]); }
                if (fq == 0) RED[rl * 4 + wc] = q;
                if (m & 1) asm volatile("" ::: "memory"); }
        asm volatile("s_waitcnt lgkmcnt(0)\n\ts_barrier" ::: "memory");
        const int t = (wr * 4 + wc) * 64 + fq * 16 + fr;
        if (t < BM) { const f32x4 r4 = *(const PG8_LAS f32x4*)(RED + t * 4); ssq[(size_t)(u.pm * BM + t) * 8 + u.pn] = (r4[0] + r4[1]) + (r4[2] + r4[3]); }
    }
};
template <class Epi, class Sched, bool ALIGN_EPI = false, bool SP2 = false>
__device__ __forceinline__ void gemm_phase(PG8_LAS unsigned char* lds, const Gemm g, const Sched& S, const Epi& E, int tid_in) {
    int tid_ = tid_in; const bf16_t* gA_ = g.A; const bf16_t* gB_ = g.Bt; asm volatile("" : "+v"(tid_), "+s"(gA_), "+s"(gB_));
    const int tid = tid_, wid = __builtin_amdgcn_readfirstlane(tid >> 6), lane = tid & 63, wr = wid >> 2, wc = wid & 3, fr = lane & 15, fq = lane >> 4;
    const int K = g.K, nt = K / BK;
    unsigned voffA[2], voffB[2];
#pragma unroll
    for (int i = 0; i < 2; ++i) { int R, C; stage_rc(tid * 16 + i * 8192, R, C); const int Rb = Epi::PERM ? ((R & ~31) + perm32(R & 31)) : R;
        voffA[i] = (unsigned)(R * K + C) * 2u; voffB[i] = (unsigned)(Rb * K + C) * 2u; }
    const size_t kstep = (size_t)(BK * 2);
    const size_t hstep = (size_t)HALF * K * 2;
    const size_t tstep = 2 * hstep;
    const unsigned ldsw = (unsigned)wid * 1024u;
    const int aoff = lds_byte(wr * 64 + fr, fq * 8), boff = lds_byte(wc * 32 + fr, fq * 8);
#define PG8_SA(b, h) (((b) * 2 + (h)) * HTB)
#define PG8_SB(b, h) ((4 + (b) * 2 + (h)) * HTB)
#define PG8_STAGE(bufoff, gbase, voff) do { _Pragma("unroll") for (int _i = 0; _i < 2; ++_i) \
        __builtin_amdgcn_global_load_lds((const unsigned*)((const char*)(gbase) + (voff)[_i]), (PG8_LAS unsigned*)(lds + (bufoff) + ldsw + _i * 8192), 16, 0, 0); } while (0)
#define PG8_LDA(dst, b, h) do { _Pragma("unroll") for (int m = 0; m < 4; ++m) _Pragma("unroll") for (int k = 0; k < 2; ++k) dst[m][k] = *(const PG8_LAS bf16x8*)(lds + PG8_SA(b, h) + aoff + m * 2048 + k * 1024); } while (0)
#define PG8_LDB(dst, b, h) do { _Pragma("unroll") for (int n = 0; n < 2; ++n) _Pragma("unroll") for (int k = 0; k < 2; ++k) dst[n][k] = *(const PG8_LAS bf16x8*)(lds + PG8_SB(b, h) + boff + n * 2048 + k * 1024); } while (0)
#define PG8_MMA(ai, bj, At, Bt) do { __builtin_amdgcn_s_setprio(1); _Pragma("unroll") for (int m = 0; m < 4; ++m) _Pragma("unroll") for (int n = 0; n < 2; ++n) _Pragma("unroll") for (int k = 0; k < 2; ++k) \
        acc[ai][bj][m][n] = __builtin_amdgcn_mfma_f32_16x16x32_bf16(Bt[n][k], At[m][k], acc[ai][bj][m][n], 0, 0, 0); __builtin_amdgcn_s_setprio(0); } while (0)
#define PG8_WAIT_V(n) asm volatile("s_waitcnt vmcnt(" #n ")" ::: "memory")
#define PG8_WAIT_L(n) asm volatile("s_waitcnt lgkmcnt(" #n ")" ::: "memory")
#define PG8_BAR __builtin_amdgcn_s_barrier()
#define PG8_SCHED __builtin_amdgcn_sched_barrier(0)
    Unit cur, nxt; int ui = 0;
    if (!S.next(0, cur)) return;
    f32x4 acc[2][2][4][2];
#pragma unroll
    for (int a = 0; a < 2; ++a)
#pragma unroll
        for (int b = 0; b < 2; ++b)
#pragma unroll
            for (int m = 0; m < 4; ++m)
#pragma unroll
                for (int n = 0; n < 2; ++n) acc[a][b][m][n] = (f32x4){0.f, 0.f, 0.f, 0.f};
    bf16x8 At[4][2], B0[2][2], B1[2][2];
    const char* cA = (const char*)gA_ + (size_t)cur.pm * tstep; const char* cB = (const char*)gB_ + (size_t)cur.pn * tstep;
    S.a_ready(cur);
    if constexpr (SP2) {
        PG8_STAGE(PG8_SB(0, 0), cB, voffB); PG8_STAGE(PG8_SB(0, 1), cB + hstep, voffB); PG8_STAGE(PG8_SA(0, 0), cA, voffA); PG8_STAGE(PG8_SA(0, 1), cA + hstep, voffA);
        if (wr == 1) PG8_BAR;
        PG8_WAIT_V(2); PG8_BAR;
        PG8_STAGE(PG8_SB(1, 0), cB + kstep, voffB); PG8_STAGE(PG8_SA(1, 0), cA + kstep, voffA); PG8_STAGE(PG8_SB(1, 1), cB + hstep + kstep, voffB);
        PG8_WAIT_V(6); PG8_BAR;
    } else {
        PG8_STAGE(PG8_SB(0, 0), cB, voffB); PG8_STAGE(PG8_SA(0, 0), cA, voffA); PG8_STAGE(PG8_SB(0, 1), cB + hstep, voffB); PG8_STAGE(PG8_SA(0, 1), cA + hstep, voffA);
        if (wr == 1) PG8_BAR;
        PG8_WAIT_V(4); PG8_BAR;
        PG8_STAGE(PG8_SB(1, 0), cB + kstep, voffB); PG8_STAGE(PG8_SA(1, 0), cA + kstep, voffA); PG8_STAGE(PG8_SB(1, 1), cB + hstep + kstep, voffB);
        PG8_WAIT_V(6); PG8_BAR;
    }
    for (;;) {
        const bool has_next = S.next(ui + 1, nxt);
        const char* nA = has_next ? (const char*)gA_ + (size_t)nxt.pm * tstep : cA; const char* nB = has_next ? (const char*)gB_ + (size_t)nxt.pn * tstep : cB;
        for (int t = 0; t < nt; t += 2) {
            const bool last = (t == nt - 2);
            const char* a1 = cA + (size_t)(t + 1) * kstep;
            const char* a2 = last ? nA : cA + (size_t)(t + 2) * kstep; const char* b2 = last ? nB : cB + (size_t)(t + 2) * kstep;
            const char* a3 = a2 + kstep; const char* b3 = b2 + kstep;
            if (last && has_next) S.a_ready(nxt);
            if constexpr (SP2) {
            PG8_LDB(B0, 0, 0); PG8_LDB(B1, 0, 1); PG8_SCHED; PG8_LDA(At, 0, 0); PG8_STAGE(PG8_SA(1, 1), a1 + hstep, voffA);
            PG8_WAIT_V(8); PG8_WAIT_L(0); PG8_BAR; PG8_MMA(0, 0, At, B0); PG8_MMA(0, 1, At, B1); PG8_BAR; PG8_SCHED;
            PG8_LDA(At, 0, 1); PG8_STAGE(PG8_SB(0, 0), b2, voffB); PG8_STAGE(PG8_SB(0, 1), b2 + hstep, voffB); PG8_STAGE(PG8_SA(0, 0), a2, voffA);
            PG8_WAIT_V(8); PG8_WAIT_L(0); PG8_BAR; PG8_MMA(1, 0, At, B0); PG8_MMA(1, 1, At, B1); PG8_BAR; PG8_SCHED;
            PG8_LDB(B0, 1, 0); PG8_LDB(B1, 1, 1); PG8_SCHED; PG8_LDA(At, 1, 0); PG8_STAGE(PG8_SA(0, 1), a2 + hstep, voffA);
            PG8_WAIT_V(8); PG8_WAIT_L(0); PG8_BAR; PG8_MMA(0, 0, At, B0); PG8_MMA(0, 1, At, B1); PG8_BAR; PG8_SCHED;
            PG8_LDA(At, 1, 1); PG8_STAGE(PG8_SB(1, 0), b3, voffB); PG8_STAGE(PG8_SB(1, 1), b3 + hstep, voffB); PG8_STAGE(PG8_SA(1, 0), a3, voffA);
            PG8_WAIT_V(8); PG8_WAIT_L(0); PG8_BAR; PG8_MMA(1, 0, At, B0); PG8_MMA(1, 1, At, B1); PG8_BAR; PG8_SCHED;
            } else {
            PG8_LDB(B0, 0, 0); PG8_SCHED; PG8_LDA(At, 0, 0); PG8_STAGE(PG8_SA(1, 1), a1 + hstep, voffA);
            PG8_WAIT_L(8); PG8_BAR; PG8_WAIT_L(0); PG8_MMA(0, 0, At, B0); PG8_BAR; PG8_SCHED;
            PG8_LDB(B1, 0, 1); PG8_STAGE(PG8_SB(0, 0), b2, voffB);
            PG8_BAR; PG8_WAIT_L(0); PG8_MMA(0, 1, At, B1); PG8_BAR;
            PG8_LDA(At, 0, 1); PG8_STAGE(PG8_SA(0, 0), a2, voffA);
            PG8_BAR; PG8_WAIT_L(0); PG8_MMA(1, 0, At, B0); PG8_BAR; PG8_SCHED;
            PG8_STAGE(PG8_SB(0, 1), b2 + hstep, voffB);
            PG8_WAIT_V(6); PG8_BAR; PG8_MMA(1, 1, At, B1); PG8_BAR;
            PG8_LDB(B0, 1, 0); PG8_SCHED; PG8_LDA(At, 1, 0); PG8_STAGE(PG8_SA(0, 1), a2 + hstep, voffA);
            PG8_WAIT_L(8); PG8_BAR; PG8_WAIT_L(0); PG8_MMA(0, 0, At, B0); PG8_BAR; PG8_SCHED;
            PG8_LDB(B1, 1, 1); PG8_STAGE(PG8_SB(1, 0), b3, voffB);
            PG8_BAR; PG8_WAIT_L(0); PG8_MMA(0, 1, At, B1); PG8_BAR;
            PG8_LDA(At, 1, 1); PG8_STAGE(PG8_SA(1, 0), a3, voffA);
            PG8_BAR; PG8_WAIT_L(0); PG8_MMA(1, 0, At, B0); PG8_BAR; PG8_SCHED;
            PG8_STAGE(PG8_SB(1, 1), b3 + hstep, voffB);
            PG8_WAIT_V(6); PG8_BAR; PG8_MMA(1, 1, At, B1); PG8_BAR;
            }
        }
        if constexpr (ALIGN_EPI) { if (wr == 0) PG8_BAR; }
        if constexpr (!Epi::AFTER_DRAIN) { E(acc, cur, wr, wc, fr, fq); S.done(cur); }
        if (!has_next) break;
#pragma unroll
        for (int a = 0; a < 2; ++a)
#pragma unroll
            for (int b = 0; b < 2; ++b)
#pragma unroll
                for (int m = 0; m < 4; ++m)
#pragma unroll
                    for (int n = 0; n < 2; ++n) acc[a][b][m][n] = (f32x4){0.f, 0.f, 0.f, 0.f};
        cur = nxt; cA = nA; cB = nB; ++ui;
        if constexpr (ALIGN_EPI) { if (wr == 1) PG8_BAR; }
    }
    PG8_WAIT_V(0);
    if constexpr (!ALIGN_EPI) { if (wr == 0) PG8_BAR; }
    PG8_BAR;
    if constexpr (Epi::AFTER_DRAIN) { E.fused(acc, cur, wr, wc, fr, fq, lds, wid, lane); S.done(cur); }
#undef PG8_SA
#undef PG8_SB
#undef PG8_STAGE
#undef PG8_LDA
#undef PG8_LDB
#undef PG8_MMA
#undef PG8_WAIT_V
#undef PG8_WAIT_L
#undef PG8_BAR
#undef PG8_SCHED
}
}
#define GAS __attribute__((address_space(1)))
#define LAS __attribute__((address_space(3)))
typedef unsigned short bf16;
typedef unsigned v4u __attribute__((ext_vector_type(4)));
typedef float f32x4 __attribute__((ext_vector_type(4)));
typedef short bf16x8 __attribute__((ext_vector_type(8)));
typedef GAS unsigned gu32;
typedef GAS unsigned long long gu64;
#define RLX_AGENT __ATOMIC_RELAXED, __HIP_MEMORY_SCOPE_AGENT
#define LDS_WAIT() asm volatile("s_waitcnt lgkmcnt(0)" ::: "memory")
#define VM_WAIT() asm volatile("s_waitcnt vmcnt(0)" ::: "memory")
__device__ __forceinline__ unsigned long long rt() { return __builtin_amdgcn_s_memrealtime(); }
typedef __bf16 bfx2_t __attribute__((ext_vector_type(2)));
typedef float f32x2_t __attribute__((ext_vector_type(2)));
__device__ __forceinline__ unsigned pk2(float lo, float hi) { return __builtin_bit_cast(unsigned, __builtin_convertvector((f32x2_t){lo, hi}, bfx2_t)); }
__device__ __forceinline__ unsigned f2bf(float f) { return pk2(f, 0.f) & 0xffffu; }

#define XB_TMO      128
#define XB_XCNT(j)  (256  + 64 * (j))
#define XB_XSUB(j)  (1280 + 64 * (j))
#define XB_XGEN(j)  (2304 + 64 * (j))
#define XB_TOP      3328
#define XB_TOPGEN   3392
#define XCD_BAR_WORDS 3456
#define XB_SPIN_CAP (1u << 18)

__device__ __forceinline__ unsigned xb_ld(unsigned* p)              { return __hip_atomic_load(p, __ATOMIC_RELAXED, __HIP_MEMORY_SCOPE_AGENT); }
__device__ __forceinline__ unsigned xb_add(unsigned* p, unsigned v) { return __hip_atomic_fetch_add(p, v, __ATOMIC_RELAXED, __HIP_MEMORY_SCOPE_AGENT); }
__device__ __forceinline__ unsigned xb_xcc_id() { return (unsigned)__builtin_amdgcn_s_getreg((3 << 11) | 20) & 0xFu; }
#define XB_SPIN(cond, bar) do { unsigned _sp = 0; while (cond) { __builtin_amdgcn_s_sleep(1); \
    if ((++_sp & 255u) == 0u) { if (xb_ld(&(bar)[XB_TMO])) break; if (_sp > XB_SPIN_CAP) { atomicAdd(&(bar)[XB_TMO], 1u); break; } } } } while (0)

struct XcdBarrier {
    unsigned* bar; unsigned x;
    volatile LAS unsigned* st;
};

__device__ __forceinline__ XcdBarrier xcd_barrier_post(unsigned* bar, volatile LAS unsigned* st) {
    XcdBarrier b; b.bar = bar; b.x = xb_xcc_id(); b.st = st;
    if (threadIdx.x == 0) (void)xb_add(&bar[XB_XCNT(b.x)], 1u);
    return b;
}
__device__ __forceinline__ void xcd_barrier_complete(unsigned* bar, unsigned x, unsigned& nloc, unsigned& nx) {
    const unsigned G = gridDim.x * gridDim.y * gridDim.z;
    unsigned sum, cnt, mine, sp = 0u;
    for (;;) {
        sum = 0u; cnt = 0u; mine = 0u;
#pragma unroll
        for (unsigned j = 0; j < 16; ++j) { const unsigned c = xb_ld(&bar[XB_XCNT(j)]); sum += c; cnt += (c > 0u) ? 1u : 0u; mine = (j == x) ? c : mine; }
        if (sum == G) break;
        __builtin_amdgcn_s_sleep(1);
        if ((++sp & 255u) == 0u) { if (xb_ld(&bar[XB_TMO])) break; if (sp > XB_SPIN_CAP) { atomicAdd(&bar[XB_TMO], 1u); break; } }
    }
    nloc = mine > 0u ? mine : 1u; nx = cnt > 0u ? cnt : 1u;
}

__device__ __forceinline__ void xcd_barrier(const XcdBarrier& b) {
    asm volatile("s_waitcnt vmcnt(0)" ::: "memory");
    __syncthreads();
    if (threadIdx.x == 0) {
        unsigned* bar = b.bar;
        __builtin_amdgcn_s_waitcnt(0);
        unsigned nloc = b.st[0], nx = b.st[1];
        if (nloc == 0u) { xcd_barrier_complete(bar, b.x, nloc, nx); b.st[0] = nloc; b.st[1] = nx; }
        const unsigned old = xb_add(&bar[XB_XSUB(b.x)], 1u);
        const unsigned gen = old / nloc;
        if (old + 1u == (gen + 1u) * nloc) {
            __builtin_amdgcn_fence(__ATOMIC_RELEASE, "agent");
            asm volatile("s_waitcnt vmcnt(0)" ::: "memory");
            const unsigned og = xb_add(&bar[XB_TOP], 1u);
            const unsigned tg = og / nx;
            if (og + 1u == (tg + 1u) * nx) xb_add(&bar[XB_TOPGEN], 1u);
            else XB_SPIN(xb_ld(&bar[XB_TOPGEN]) == tg, bar);
            __builtin_amdgcn_fence(__ATOMIC_ACQUIRE, "agent");
            xb_add(&bar[XB_XGEN(b.x)], 1u);
            asm volatile("s_waitcnt vmcnt(0)" ::: "memory");
        } else {
            XB_SPIN(xb_ld(&bar[XB_XGEN(b.x)]) == gen, bar);
            __builtin_amdgcn_fence(__ATOMIC_ACQUIRE, "agent");
            asm volatile("s_waitcnt vmcnt(0)" ::: "memory");
        }
    }
    __syncthreads();
}
template <int CTRL> __device__ __forceinline__ float dpp_mov(float x) { return __int_as_float(__builtin_amdgcn_update_dpp(0, __float_as_int(x), CTRL, 0xF, 0xF, true)); }
__device__ __forceinline__ float sum_xor16(float x) { auto r = __builtin_amdgcn_permlane16_swap(__float_as_uint(x), __float_as_uint(x), false, false); return __uint_as_float(r[0]) + __uint_as_float(r[1]); }
__device__ __forceinline__ float sum_xor32(float x) { auto r = __builtin_amdgcn_permlane32_swap(__float_as_uint(x), __float_as_uint(x), false, false); return __uint_as_float(r[0]) + __uint_as_float(r[1]); }
__device__ __forceinline__ float wave_sum(float v) {
    v += dpp_mov<0xB1>(v); v += dpp_mov<0x4E>(v); v += dpp_mov<0x141>(v); v += dpp_mov<0x140>(v);
    return sum_xor32(sum_xor16(v));
}
__device__ __forceinline__ void transpose64_item(const float* W, int K, int N, bf16* WT, LAS unsigned char* img, int item, int lane, const float* gk) {
    const int nblk = (N + 63) >> 6, kb = item / nblk, nb = item - kb * nblk, k0 = 64 * kb, n0 = 64 * nb;
    const int kl = lane >> 4, n4 = (lane & 15) * 4; const bool live = n0 + n4 < N;
    f32x4 v[16];
#pragma unroll
    for (int j = 0; j < 16; ++j) v[j] = live ? *(const GAS f32x4*)(W + (size_t)(k0 + 4 * j + kl) * N + n0 + n4) : (f32x4){0.f, 0.f, 0.f, 0.f};
#pragma unroll
    for (int j = 0; j < 16; ++j) { const int kk = 4 * j + kl; const float g = gk ? gk[k0 + kk] : 1.0f; const f32x4 x = v[j] * g;
        LAS unsigned char* p = img + n4 * 132 + kk * 2;
        *(LAS unsigned short*)(p) = (unsigned short)f2bf(x.x); *(LAS unsigned short*)(p + 132) = (unsigned short)f2bf(x.y); *(LAS unsigned short*)(p + 264) = (unsigned short)f2bf(x.z); *(LAS unsigned short*)(p + 396) = (unsigned short)f2bf(x.w); }
    LDS_WAIT(); asm volatile("" ::: "memory");
    const int c = lane & 7;
#pragma unroll
    for (int jj = 0; jj < 8; ++jj) { const int n = (lane >> 3) + 8 * jj;
        const LAS unsigned* q = (const LAS unsigned*)(img + n * 132 + c * 16); v4u o; o.x = q[0]; o.y = q[1]; o.z = q[2]; o.w = q[3];
        if (n0 + n < N) *(GAS v4u*)(WT + (size_t)(n0 + n) * K + k0 + 8 * c) = o; }
    LDS_WAIT(); asm volatile("" ::: "memory");
}
constexpr int NWAVES = 8;
constexpr int BATCH = 16, T = 2048, D = 2048, M = BATCH * T, DEPTH = 4, FF = 8192;
constexpr int EVEN_N = 6432, ZP = 6656;
constexpr int ZC_Q = 0, ZC_K = 1024, ZC_V = 2048, ZC_R = 3072, ZC_RK = 4096, ZC_RV = 5120, ZC_XW = 6144, ZC_XA = 6208, ZC_XG = 6272;
constexpr int RWS = 3360;
constexpr int NPH = 33;

constexpr size_t MiB = 1u << 20;
constexpr size_t WS_CTL = 0, CTL_ZERO_BYTES = 1 * MiB;
constexpr size_t WS_WA = 2 * MiB;
constexpr size_t WS_WB = 28 * MiB;
constexpr size_t WS_W1 = 36 * MiB;
constexpr size_t WS_W2 = 68 * MiB;
constexpr size_t WS_H = 104 * MiB;
constexpr size_t WS_BIG = 232 * MiB;
constexpr size_t WS_SSQ = 101 * MiB;
constexpr size_t WS_XB = 744 * MiB;
constexpr size_t WS_END = 872 * MiB;
constexpr int CW_BAR = 4096;

constexpr int RING_BYTES = 131072, LDSCTL_OFF = RING_BYTES, MISC_OFF = LDSCTL_OFF + 320, LDS_BYTES = 147456;

struct Args { const float* in[25]; float* out; unsigned char* ws; int ph_lo, ph_hi; };

__device__ __forceinline__ v4u zero4() { unsigned z; asm volatile("v_mov_b32 %0, 0" : "=v"(z)); return (v4u){z, z, z, z}; }
__device__ __forceinline__ float bf2f(bf16 h) { return __uint_as_float((unsigned)h << 16); }
__device__ __forceinline__ float bflo(unsigned w) { return __uint_as_float(w << 16); }
__device__ __forceinline__ float bfhi(unsigned w) { return __uint_as_float(w & 0xffff0000u); }

__device__ __forceinline__ void rms_row_out(const bf16* xrow, const float* g, float* orow, int lane) {
    const GAS v4u* xr = (const GAS v4u*)xrow + lane; const GAS f32x4* gr = (const GAS f32x4*)g + 2 * lane; GAS f32x4* o = (GAS f32x4*)orow + 2 * lane;
    f32x4 v[8]; float s = 0.f;
#pragma unroll
    for (int j = 0; j < 4; ++j) { const v4u w = xr[64 * j]; v[2 * j] = (f32x4){bflo(w.x), bfhi(w.x), bflo(w.y), bfhi(w.y)}; v[2 * j + 1] = (f32x4){bflo(w.z), bfhi(w.z), bflo(w.w), bfhi(w.w)};
        s += ((v[2 * j].x * v[2 * j].x + v[2 * j].y * v[2 * j].y) + (v[2 * j].z * v[2 * j].z + v[2 * j].w * v[2 * j].w)) + ((v[2 * j + 1].x * v[2 * j + 1].x + v[2 * j + 1].y * v[2 * j + 1].y) + (v[2 * j + 1].z * v[2 * j + 1].z + v[2 * j + 1].w * v[2 * j + 1].w)); }
    const float r = 1.0f / sqrtf(wave_sum(s) * (1.f / D) + 1e-6f);
#pragma unroll
    for (int j = 0; j < 4; ++j) { o[128 * j] = v[2 * j] * r * gr[128 * j]; o[128 * j + 1] = v[2 * j + 1] * r * gr[128 * j + 1]; }
}
__device__ __forceinline__ void prep_phase(const float* Win, int Nin, const float* Wout, const float* w1, const float* w2, const float* x0, const float* gmix, const float* gffn, unsigned char* ws, bool even, LAS unsigned char* lds, int wave, int lane, int tid, int G) {
    const int gw = blockIdx.x * NWAVES + wave, NGW = G * NWAVES;
    bf16* WA = (bf16*)(ws + WS_WA); bf16* WB = (bf16*)(ws + WS_WB); bf16* W1 = (bf16*)(ws + WS_W1); bf16* W2 = (bf16*)(ws + WS_W2);
    const int I_in = (D / 64) * ((Nin + 63) / 64), I_out = (D / 64) * (D / 64), I_1 = (D / 64) * (FF / 64), I_2 = (FF / 64) * (D / 64);
    LAS unsigned char* const img = lds + wave * 16384;
    const int total = I_in + I_out + I_1 + I_2;
    for (int it = gw; it < total; it += NGW) {
        int r = it;
        if (r < I_in) { transpose64_item(Win, D, Nin, WA, img, r, lane, gmix); continue; } r -= I_in;
        if (r < I_out) { transpose64_item(Wout, D, D, WB, img, r, lane, nullptr); continue; } r -= I_out;
        if (r < I_1) { transpose64_item(w1, D, FF, W1, img, r, lane, gffn); continue; } r -= I_1;
        transpose64_item(w2, FF, D, W2, img, r, lane, nullptr);
    }
    if (even) {
        GAS v4u* p = (GAS v4u*)(WA + (size_t)EVEN_N * D); const int n16 = (ZP - EVEN_N) * D * 2 / 16;
        for (int k = blockIdx.x * (NWAVES * 64) + tid; k < n16; k += G * NWAVES * 64) p[k] = zero4();
    }
    if (x0) {
        bf16* XB = (bf16*)(ws + WS_XB); float* SSQ = (float*)(ws + WS_SSQ);
        for (int m = gw; m < M; m += NGW) {
            const GAS f32x4* xr = (const GAS f32x4*)(x0 + (size_t)m * D) + lane; GAS unsigned long long* o8 = (GAS unsigned long long*)(XB + (size_t)m * D) + lane;
            float s = 0.f;
#pragma unroll
            for (int j = 0; j < 8; ++j) { const f32x4 v = xr[64 * j]; s += (v.x * v.x + v.y * v.y) + (v.z * v.z + v.w * v.w);
                o8[64 * j] = (unsigned long long)pk2(v.x, v.y) | ((unsigned long long)pk2(v.z, v.w) << 32); }
            s = wave_sum(s);
            if (lane < 8) SSQ[(size_t)m * 8 + lane] = lane == 0 ? s : 0.f;
        }
    }
}

__device__ __forceinline__ float rl(float x, int j) { return __int_as_float(__builtin_amdgcn_readlane(__float_as_int(x), j)); }

namespace rw {
constexpr int CH = 32;
constexpr int L_X = 0, L_RKV = 32768, L_DAG = 57344, L_ACT = 81920, L_SC = 101888, L_PREV = 102400, L_MU = 104320, L_CST = 106240;
constexpr int ACT_WS = 144, ACT_GS = 336;
constexpr int L_ACTW = L_ACT, L_ACTA = L_ACT + 32 * ACT_WS, L_ACTG = L_ACT + 64 * ACT_WS, L_Y = L_ACT;
constexpr float LOG2E = 1.4426950408889634f, LN2 = 0.6931471805599453f;
typedef float f32x2 __attribute__((ext_vector_type(2)));
__device__ __forceinline__ float ex2(float x) { return __builtin_amdgcn_exp2f(x); }
__device__ __forceinline__ float lg2(float x) { return __builtin_amdgcn_logf(x); }
__device__ __forceinline__ float rcp(float x) { return __builtin_amdgcn_rcpf(x); }
__device__ __forceinline__ float sigmoid_f(float x) { return rcp(1.0f + ex2(-x * LOG2E)); }
template <int CTRL> __device__ __forceinline__ float dppf(float x) { return __int_as_float(__builtin_amdgcn_update_dpp(0, __float_as_int(x), CTRL, 0xF, 0xF, true)); }
__device__ __forceinline__ float row16_sum(float x) { x += dppf<0xB1>(x); x += dppf<0x4E>(x); x += dppf<0x141>(x); x += dppf<0x140>(x); return x; }
#define FMUL(a, b) ({ float d_; asm("v_mul_f32 %0, %1, %2" : "=v"(d_) : "v"(a), "v"(b)); d_; })
#define FFMA(a, b, c) ({ float d_; asm("v_fma_f32 %0, %1, %2, %3" : "=v"(d_) : "v"(a), "v"(b), "v"(c)); d_; })
#define RW_BAR() asm volatile("s_waitcnt lgkmcnt(0)\n\ts_barrier" ::: "memory")
struct Params { const float *mu, *w_up, *w0, *a_up, *a0, *g_up, *k_k, *k_a, *r_k, *lnx_w, *lnx_b; };

__device__ __forceinline__ bf16x8 load_bfrag(const float* W, int k0, int col) {
    float w[8];
#pragma unroll
    for (int j = 0; j < 8; ++j) w[j] = W[(size_t)(k0 + j) * 1024 + col];
    v4u p; p.x = pk2(w[0], w[1]); p.y = pk2(w[2], w[3]); p.z = pk2(w[4], w[5]); p.w = pk2(w[6], w[7]);
    return __builtin_bit_cast(bf16x8, p);
}
__device__ __forceinline__ int colbase(int chunk, int hc) { return chunk < 24 ? ZC_R + (chunk >> 3) * 1024 + hc + 8 * (chunk & 7) : ZC_XW + 8 * (chunk - 24); }
}
namespace rw2 {
constexpr int CH = 16;
constexpr int L_X = 0, L_RKV = 15360, L_E1 = 27648, L_ACT = 44032, L_OPS = 54016, L_BKT = 63232, L_SVT = 68352, L_LB = 73472, L_LKA = 74496, L_LRA = 75776, L_S0 = 77056,
              L_RHS = 86272, L_Y = 90368, L_SC = 94464, L_PREV = 94720, L_MU = 96640, L_CST = 98560;
constexpr int ACT_WS = 144, ACT_GS = 336, OPS = 144, T32S = 80;
constexpr int L_ACTW = L_ACT, L_ACTA = L_ACT + 16 * ACT_WS, L_ACTG = L_ACT + 32 * ACT_WS;
constexpr int L_KT = L_OPS, L_BT = L_OPS + 2304, L_KK = L_OPS + 4608, L_RT = L_OPS + 6912;
using rw::LOG2E; using rw::LN2; using rw::ex2; using rw::lg2; using rw::rcp; using rw::sigmoid_f; using rw::row16_sum; using rw::load_bfrag; using rw::colbase; using rw::Params;
#define RW2_BAR() asm volatile("s_waitcnt lgkmcnt(0)\n\ts_barrier" ::: "memory")
__device__ __forceinline__ bf16x8 ldfrag(const LAS unsigned char* p) { return *(const LAS bf16x8*)p; }
__device__ __forceinline__ void st16(LAS unsigned char* p, float x) { *(LAS unsigned short*)p = (unsigned short)f2bf(x); }
}
namespace rw12 {
typedef short s16x4 __attribute__((ext_vector_type(4)));
typedef __bf16 bfx4 __attribute__((ext_vector_type(4)));
__device__ __forceinline__ s16x4 pk4(const f32x4 x) { return __builtin_bit_cast(s16x4, __builtin_convertvector(x, bfx4)); }
constexpr int CH = 16, NCH = T / CH;
constexpr int A_RK = 0  , A_E1 = 12288  , A_ACT = 28672, A_MU = 38656, A_CST = 40576, A_END = 41856;
constexpr int H_OPS = 0, H_BKT = 9216, H_SVT = 14336, H_VF = 19456, H_GV = 23552, H_DC = 27648, H_SC = 27904, H_SIZE = 28160;
constexpr int H_BASE = A_END;
constexpr int B_S0 = H_BASE + 2 * H_SIZE, B_RHS = B_S0 + 9216  , B_Y = B_RHS + 4096, B_RK2 = B_Y + 4096  , B_END = B_RK2 + 12288;
static_assert(B_END <= 131072, "RWKV LDS map");
constexpr int ACT_WS = 144, ACT_GS = 336, OPS = 144, T32S = 80;
constexpr int A_ACTW = A_ACT, A_ACTA = A_ACT + 16 * ACT_WS, A_ACTG = A_ACT + 32 * ACT_WS;
using rw::LOG2E; using rw::LN2; using rw::ex2; using rw::lg2; using rw::rcp; using rw::sigmoid_f; using rw::row16_sum; using rw::load_bfrag; using rw::colbase; using rw::Params;
using rw2::ldfrag; using rw2::st16;
#define RW12_BAR() asm volatile("s_waitcnt lgkmcnt(0)\n\ts_barrier" ::: "memory")

__device__ __forceinline__ void rwkv_phase(const Params p, const bf16* Z, bf16* O, LAS unsigned char* lds, int tid_in, int u0, int ustep) {
    const int wave = __builtin_amdgcn_readfirstlane(tid_in >> 6);
    LAS float* E1 = (LAS float*)(lds + A_E1); LAS float* CUM = E1 + 1024; LAS float* AV = E1 + 2048; LAS float* GVa = E1 + 3072;
    LAS float* MU = (LAS float*)(lds + A_MU); LAS float* CST = (LAS float*)(lds + A_CST);
    LAS float* Yf = (LAS float*)(lds + B_Y); LAS float* Yf1 = (LAS float*)(lds + B_RHS);
    for (int u = u0; u < BATCH * 16; u += ustep) {
        const int b = u >> 4, h = u & 15, hc = h * 64;
        int tid = tid_in; asm volatile("" : "+v"(tid)); int lane = tid & 63;
        const int ct = wave & 3;
        bf16x8 Bw[2], Ba[2], Bg[5];
        { const int fn = lane & 15, fq = lane >> 4;
          if (wave < 4) {
#pragma unroll
              for (int ks = 0; ks < 2; ++ks) { Bw[ks] = load_bfrag(p.w_up, 32 * ks + 8 * fq, hc + 16 * ct + fn); Ba[ks] = load_bfrag(p.a_up, 32 * ks + 8 * fq, hc + 16 * ct + fn); }
          } else {
#pragma unroll
              for (int ks = 0; ks < 5; ++ks) Bg[ks] = load_bfrag(p.g_up, 32 * ks + 8 * fq, hc + 16 * ct + fn);
          } }
        const float w0c = p.w0[hc + 16 * ct + (lane & 15)], a0c = p.a0[hc + 16 * ct + (lane & 15)];
        if (tid < 480) { const int chunk = tid >> 3, j = tid & 7; const int mi = chunk < 24 ? (chunk >> 3) * 1024 + hc + 8 * (chunk & 7) + j : 3072 + 8 * (chunk - 24) + j; MU[tid] = p.mu[mi]; }
        if (tid < 320) { const int a = tid >> 6, j = tid & 63; const float* src = a == 0 ? p.k_k : a == 1 ? p.k_a : a == 2 ? p.r_k : a == 3 ? p.lnx_w : p.lnx_b; CST[tid] = src[hc + j]; }
        for (int q = tid; q < 576 + 640; q += NWAVES * 64) {
            const int off = q < 576 ? B_S0 + q * 16 : (q < 896 ? H_BASE + H_SVT + (q - 576) * 16 : H_BASE + H_SIZE + H_SVT + (q - 896) * 16); *(LAS v4u*)(lds + off) = zero4(); }
        f32x4 sacc0 = {0.f, 0.f, 0.f, 0.f}, sacc1 = {0.f, 0.f, 0.f, 0.f};
        v4u own[2], prv[2];
        const bf16* zb = Z + (size_t)(b * T) * ZP;
#define RW12_ITEMS() int it_t[2], it_c[2]; bool it_ok[2]; \
        if (tid < 384) { it_t[0] = tid / 24; it_c[0] = tid - 24 * it_t[0]; } else { it_t[0] = (tid - 384) >> 3; it_c[0] = 24 + (tid & 7); } it_ok[0] = true; \
        if (tid < 128) { it_t[1] = tid >> 3; it_c[1] = 32 + (tid & 7); it_ok[1] = true; } else { const int q_ = tid - 128; it_t[1] = q_ / 20; it_c[1] = 40 + q_ - 20 * it_t[1]; it_ok[1] = tid < 448; if (!it_ok[1]) { it_t[1] = 0; it_c[1] = 40; } }
#define RW12_FETCH(cc) _Pragma("unroll") for (int i = 0; i < 2; ++i) { const int ta = (cc) * CH + it_t[i]; const int cb = colbase(it_c[i], hc); \
            own[i] = it_ok[i] ? *(const GAS v4u*)(zb + (size_t)ta * ZP + cb) : zero4(); prv[i] = (it_ok[i] && ta > 0) ? *(const GAS v4u*)(zb + (size_t)(ta - 1) * ZP + cb) : zero4(); }
        { RW12_ITEMS(); RW12_FETCH(0); }
        f32x4 yacc = {0.f, 0.f, 0.f, 0.f}, racc = {0.f, 0.f, 0.f, 0.f};
        RW12_BAR();
        for (int it = -1; it <= NCH + 1; ++it) {
            lane = tid & 63;
            const int fn = lane & 15, fq = lane >> 4, c4 = (tid & 15) * 4, tq = tid >> 4;
            const bool doA = it >= 0 && it < NCH, doB = it >= 1 && it <= NCH, doP2 = it + 1 < NCH, doPost = it >= 2;
            LAS unsigned char* const HA = lds + H_BASE + (it & 1) * H_SIZE;
            LAS unsigned char* const HB = lds + H_BASE + ((it & 1) ^ 1) * H_SIZE;
            if (doA) {
                if (wave < 4) {
                    f32x4 aw = {0.f, 0.f, 0.f, 0.f}, aa = aw;
#pragma unroll
                    for (int ks = 0; ks < 2; ++ks) {
                        aw = __builtin_amdgcn_mfma_f32_16x16x32_bf16(ldfrag(lds + A_ACTW + fn * ACT_WS + (32 * ks + 8 * fq) * 2), Bw[ks], aw, 0, 0, 0);
                        aa = __builtin_amdgcn_mfma_f32_16x16x32_bf16(ldfrag(lds + A_ACTA + fn * ACT_WS + (32 * ks + 8 * fq) * 2), Ba[ks], aa, 0, 0, 0); }
                    float e[4], cs[4];
#pragma unroll
                    for (int r = 0; r < 4; ++r) e[r] = 0.6065306597126334f * rcp(1.0f + ex2(-(aw[r] + w0c) * LOG2E));
                    cs[0] = e[0]; cs[1] = cs[0] + e[1]; cs[2] = cs[1] + e[2]; cs[3] = cs[2] + e[3];
                    const float run = cs[3];
                    float offs;
                    { auto r16 = __builtin_amdgcn_permlane16_swap(__float_as_uint(run), __float_as_uint(run), false, false);
                      const float ev = __uint_as_float(r16[0]), od = __uint_as_float(r16[1]);
                      const float ps = ev + od; auto r32 = __builtin_amdgcn_permlane32_swap(__float_as_uint(ps), __float_as_uint(ps), false, false);
                      offs = ((fq & 1) ? ev : 0.f) + ((fq & 2) ? __uint_as_float(r32[0]) : 0.f); }
#pragma unroll
                    for (int r = 0; r < 4; ++r) { const int idx = (4 * fq + r) * 64 + 16 * ct + fn; E1[idx] = e[r]; CUM[idx] = cs[r] + offs; AV[idx] = sigmoid_f(aa[r] + a0c); }
                } else {
                    f32x4 ag = {0.f, 0.f, 0.f, 0.f};
#pragma unroll
                    for (int ks = 0; ks < 5; ++ks) ag = __builtin_amdgcn_mfma_f32_16x16x32_bf16(ldfrag(lds + A_ACTG + fn * ACT_GS + (32 * ks + 8 * fq) * 2), Bg[ks], ag, 0, 0, 0);
                    #pragma unroll
                    for (int r = 0; r < 4; ++r) GVa[(4 * fq + r) * 64 + 16 * ct + fn] = ag[r];
                }
            }
            if (doB) {
                if (wave >= 4) {
                    const int vt = wave - 4;
                    f32x4 gkt = {0.f, 0.f, 0.f, 0.f}, grbt = gkt, grkt = gkt, gb = gkt, gbt = gkt; yacc = gkt; racc = gkt;
#pragma unroll
                    for (int ks = 0; ks < 2; ++ks) {
                        const bf16x8 fkt = ldfrag(HB + H_OPS + fn * OPS + (32 * ks + 8 * fq) * 2), fbt = ldfrag(HB + H_OPS + 2304 + fn * OPS + (32 * ks + 8 * fq) * 2);
                        const bf16x8 fkk = ldfrag(HB + H_OPS + 4608 + fn * OPS + (32 * ks + 8 * fq) * 2), frt = ldfrag(HB + H_OPS + 6912 + fn * OPS + (32 * ks + 8 * fq) * 2);
                        const bf16x8 sb_ = ldfrag(lds + B_S0 + (16 * vt + fn) * OPS + (32 * ks + 8 * fq) * 2);
                        gkt = __builtin_amdgcn_mfma_f32_16x16x32_bf16(fkk, fkt, gkt, 0, 0, 0);
                        grbt = __builtin_amdgcn_mfma_f32_16x16x32_bf16(fbt, frt, grbt, 0, 0, 0);
                        grkt = __builtin_amdgcn_mfma_f32_16x16x32_bf16(fkk, frt, grkt, 0, 0, 0);
                        yacc = __builtin_amdgcn_mfma_f32_16x16x32_bf16(frt, sb_, yacc, 0, 0, 0);
                        racc = __builtin_amdgcn_mfma_f32_16x16x32_bf16(fkt, sb_, racc, 0, 0, 0);
                        gb = __builtin_amdgcn_mfma_f32_16x16x32_bf16(fkt, fbt, gb, 0, 0, 0);
                        gbt = __builtin_amdgcn_mfma_f32_16x16x32_bf16(fbt, fkt, gbt, 0, 0, 0); }
                    racc = -racc;
                    f32x4 lkA, lrbA, lrkA;
#pragma unroll
                    for (int r = 0; r < 4; ++r) { const int i_ = 4 * fq + r; lkA[r] = (i_ < fn) ? -gkt[r] : 0.f; lrbA[r] = (i_ <= fn) ? grbt[r] : 0.f; lrkA[r] = (i_ <= fn) ? grkt[r] : 0.f; }
                    const s16x4 vB = *(const LAS s16x4*)(HB + H_SVT + (16 * vt + fn) * T32S + 32 + 8 * fq);
                    racc = __builtin_amdgcn_mfma_f32_16x16x16bf16_1k(pk4(lkA), vB, racc, 0, 0, 0);
                    { f32x4 Lm, Lt, Im;
#pragma unroll
                      for (int r = 0; r < 4; ++r) { const int t = 4 * fq + r; Lm[r] = (fn < t) ? gb[r] : 0.f; Lt[r] = (t < fn) ? gbt[r] : 0.f; Im[r] = (t == fn) ? 1.f : 0.f; }
                      const f32x4 z4 = {0.f, 0.f, 0.f, 0.f};
#define RW12_MM(MT, N) __builtin_amdgcn_mfma_f32_16x16x16bf16_1k(pk4(MT), pk4(N), z4, 0, 0, 0)
                      const f32x4 L2 = RW12_MM(Lt, Lm), L2t = RW12_MM(Lm, Lt);
                      const f32x4 L4 = RW12_MM(L2t, L2), L4t = RW12_MM(L2, L2t);
                      const f32x4 L8 = RW12_MM(L4t, L4);
                      const f32x4 F = RW12_MM(Im + L4t, Im + L8);
                      const f32x4 E = RW12_MM(Im + L2t, F) - Im;
                      const f32x4 ImLt = Im - Lt;
                      const f32x4 TT = ImLt + RW12_MM(E, ImLt);
#undef RW12_MM
                      f32x4 sa = z4;
#pragma unroll
                      for (int r = 0; r < 4; ++r) sa = __builtin_amdgcn_mfma_f32_16x16x4f32(TT[r], racc[r], sa, 0, 0, 0);
                      const s16x4 saB = pk4(sa);
                      yacc = __builtin_amdgcn_mfma_f32_16x16x16bf16_1k(pk4(lrbA), saB, yacc, 0, 0, 0);
                      yacc = __builtin_amdgcn_mfma_f32_16x16x16bf16_1k(pk4(lrkA), vB, yacc, 0, 0, 0);
                      LAS float* Yw = (it & 1) ? Yf1 : Yf;
#pragma unroll
                      for (int r = 0; r < 4; ++r) Yw[(4 * fq + r) * 64 + 16 * vt + fn] = yacc[r];
                      *(LAS s16x4*)(HB + H_SVT + (16 * vt + fn) * T32S + 8 * fq) = saB; }
                }
            }
            if (doPost && wave < 4) {
                const f32x4 lw = *(const LAS f32x4*)(CST + 192 + c4), lb = *(const LAS f32x4*)(CST + 256 + c4);
                const f32x4 y4 = *(const LAS f32x4*)(((it & 1) ? Yf : Yf1) + tq * 64 + c4), v4 = *(const LAS f32x4*)((LAS float*)(HA + H_VF) + tq * 64 + c4), g4 = *(const LAS f32x4*)((LAS float*)(HA + H_GV) + tq * 64 + c4);
                const float bo = ((const LAS float*)(HA + H_SC))[tq];
                const float mean = row16_sum((y4.x + y4.y) + (y4.z + y4.w)) * (1.f / 64.f);
                const f32x4 d = y4 - mean;
                const float var = row16_sum((d.x * d.x + d.y * d.y) + (d.z * d.z + d.w * d.w)) * (1.f / 64.f);
                const float rstd = __builtin_amdgcn_rsqf(var + 64e-5f);
                const f32x4 o = (d * rstd * lw + lb + v4 * bo) * g4;
                GAS unsigned long long* dst = (GAS unsigned long long*)(O + (size_t)(b * T + (it - 2) * CH + tq) * D + 1024 + hc + c4);
                *dst = (unsigned long long)pk2(o.x, o.y) | ((unsigned long long)pk2(o.z, o.w) << 32);
            }
            RW12_BAR();
            if (doA && wave < 4) {
                const LAS float* Rf = (const LAS float*)(lds + ((it & 1) ? B_RK2 : A_RK)); const LAS float* Kf = Rf + 1024; const LAS float* Vfa = Rf + 2048;
                const f32x4 kkc = *(const LAS f32x4*)(CST + c4), kac = *(const LAS f32x4*)(CST + 64 + c4), rkc = *(const LAS f32x4*)(CST + 128 + c4);
                const f32x4 k4 = *(const LAS f32x4*)(Kf + tq * 64 + c4), r4 = *(const LAS f32x4*)(Rf + tq * 64 + c4), v4 = *(const LAS f32x4*)(Vfa + tq * 64 + c4);
                *(LAS f32x4*)((LAS float*)(HA + H_VF) + tq * 64 + c4) = v4; *(LAS f32x4*)((LAS float*)(HA + H_GV) + tq * 64 + c4) = *(const LAS f32x4*)(GVa + tq * 64 + c4);
                const f32x4 e4 = *(const LAS f32x4*)(E1 + tq * 64 + c4), cm = *(const LAS f32x4*)(CUM + tq * 64 + c4), a4 = *(const LAS f32x4*)(AV + tq * 64 + c4);
                f32x4 kk = k4 * kkc;
                const float ss = row16_sum((kk.x * kk.x + kk.y * kk.y) + (kk.z * kk.z + kk.w * kk.w));
                const float inv = ss > 1e-24f ? __builtin_amdgcn_rsqf(ss) : 1e12f;
                kk = kk * inv;
                const f32x4 kmod = k4 * (1.0f + (a4 - 1.0f) * kac);
                const f32x4 bv = kk * a4;
                const f32x4 bo4 = kmod * r4 * rkc;
                const float bo = row16_sum((bo4.x + bo4.y) + (bo4.z + bo4.w));
                if ((tid & 15) == 0) ((LAS float*)(HA + H_SC))[tq] = bo;
                f32x4 em, ep, emx;
#pragma unroll
                for (int j = 0; j < 4; ++j) { em[j] = ex2(-cm[j] * LOG2E); ep[j] = rcp(em[j]); emx[j] = ex2((e4[j] - cm[j]) * LOG2E); }
                if (tq == CH - 1) *(LAS f32x4*)((LAS float*)(HA + H_DC) + c4) = em;
                const f32x4 okt = kk * emx, obt = bv * ep, okk = kmod * ep, ort = r4 * em;
                typedef unsigned u32x2 __attribute__((ext_vector_type(2)));
                *(LAS u32x2*)(HA + H_OPS + tq * OPS + c4 * 2) = (u32x2){pk2(okt.x, okt.y), pk2(okt.z, okt.w)};
                *(LAS u32x2*)(HA + H_OPS + 2304 + tq * OPS + c4 * 2) = (u32x2){pk2(obt.x, obt.y), pk2(obt.z, obt.w)};
                *(LAS u32x2*)(HA + H_OPS + 4608 + tq * OPS + c4 * 2) = (u32x2){pk2(okk.x, okk.y), pk2(okk.z, okk.w)};
                *(LAS u32x2*)(HA + H_OPS + 6912 + tq * OPS + c4 * 2) = (u32x2){pk2(ort.x, ort.y), pk2(ort.z, ort.w)};
#pragma unroll
                for (int j = 0; j < 4; ++j) { st16(HA + H_BKT + (c4 + j) * T32S + tq * 2, obt[j]); st16(HA + H_BKT + (c4 + j) * T32S + 32 + tq * 2, okk[j]); st16(HA + H_SVT + (c4 + j) * T32S + 32 + tq * 2, v4[j]); }
            }
            if (doB) {
                const int id0 = 2 * wave, vt = id0 >> 2, kt0 = id0 & 3;
                const bf16x8 af = ldfrag(HB + H_SVT + (16 * vt + fn) * T32S + fq * 16);
                const LAS float* DC = (const LAS float*)(HB + H_DC);
                sacc0 = __builtin_amdgcn_mfma_f32_16x16x32_bf16(af, ldfrag(HB + H_BKT + (16 * kt0 + fn) * T32S + fq * 16), sacc0, 0, 0, 0);
                sacc1 = __builtin_amdgcn_mfma_f32_16x16x32_bf16(af, ldfrag(HB + H_BKT + (16 * kt0 + 16 + fn) * T32S + fq * 16), sacc1, 0, 0, 0);
                sacc0 = sacc0 * DC[16 * kt0 + fn]; sacc1 = sacc1 * DC[16 * kt0 + 16 + fn];
#pragma unroll
                for (int r = 0; r < 4; ++r) { st16(lds + B_S0 + (16 * vt + 4 * fq + r) * OPS + (16 * kt0 + fn) * 2, sacc0[r]); st16(lds + B_S0 + (16 * vt + 4 * fq + r) * OPS + (16 * kt0 + 16 + fn) * 2, sacc1[r]); }
            }
            if (doP2) {
                LAS float* Rf = (LAS float*)(lds + ((it & 1) ? A_RK : B_RK2)); LAS float* Vfa = Rf + 2048;
                RW12_ITEMS();
#pragma unroll
                for (int i = 0; i < 2; ++i) if (it_ok[i]) {
                    const int t = it_t[i], chunk = it_c[i];
                    const f32x4 m0 = *(const LAS f32x4*)(MU + chunk * 8), m1 = *(const LAS f32x4*)(MU + chunk * 8 + 4);
                    float x[8];
                    { const unsigned cw[4] = {own[i].x, own[i].y, own[i].z, own[i].w}; const unsigned pw[4] = {prv[i].x, prv[i].y, prv[i].z, prv[i].w}; const float mm[8] = {m0.x, m0.y, m0.z, m0.w, m1.x, m1.y, m1.z, m1.w};
#pragma unroll
                      for (int j = 0; j < 4; ++j) { const float a0 = bflo(cw[j]), a1 = bfhi(cw[j]), q0 = bflo(pw[j]), q1 = bfhi(pw[j]);
                          x[2 * j] = a0 + (q0 - a0) * mm[2 * j]; x[2 * j + 1] = a1 + (q1 - a1) * mm[2 * j + 1]; } }
                    if (chunk < 24) { LAS float* dst = (chunk < 16 ? Rf + (chunk >> 3) * 1024 : Vfa) + t * 64 + 8 * (chunk & 7);
                        *(LAS f32x4*)dst = (f32x4){x[0], x[1], x[2], x[3]}; *(LAS f32x4*)(dst + 4) = (f32x4){x[4], x[5], x[6], x[7]}; }
                    else {
                        float y[8];
                        if (chunk < 32) {
#pragma unroll
                            for (int j = 0; j < 8; ++j) y[j] = 1.0f - 2.0f * rcp(ex2(x[j] * (2.0f * LOG2E)) + 1.0f);
                        } else if (chunk < 40) {
#pragma unroll
                            for (int j = 0; j < 8; ++j) y[j] = x[j];
                        } else {
#pragma unroll
                            for (int j = 0; j < 8; ++j) y[j] = sigmoid_f(x[j]);
                        }
                        v4u o; o.x = pk2(y[0], y[1]); o.y = pk2(y[2], y[3]); o.z = pk2(y[4], y[5]); o.w = pk2(y[6], y[7]);
                        const int off = chunk < 32 ? A_ACTW + t * ACT_WS + (chunk - 24) * 16 : chunk < 40 ? A_ACTA + t * ACT_WS + (chunk - 32) * 16 : A_ACTG + t * ACT_GS + (chunk - 40) * 16;
                        *(LAS v4u*)(lds + off) = o;
                    }
                }
                if (it + 2 < NCH) { RW12_FETCH(it + 2); }
            }
            RW12_BAR();
        }
    }
}
}
namespace sb {
using f32x16 = __attribute__((ext_vector_type(16))) float;
using s16x4 = __attribute__((ext_vector_type(4))) short;
constexpr int NSLOT = 3, SLOTB = 16384;
constexpr int LDS_K = 0, LDS_V = NSLOT * SLOTB, LDS_OST = 2 * NSLOT * SLOTB, LDS_CNT = LDS_OST + 8 * 4096;
constexpr float QSCALE = 0.125f * 1.4426950408889634f;
__device__ __forceinline__ int crow(int r, int hi) { return (r & 3) + 8 * (r >> 2) + 4 * hi; }
__device__ __forceinline__ void glds16(const void* gsrc, unsigned lds_dst) { unsigned keep;
    asm volatile("s_mov_b32 %0, m0\n\ts_mov_b32 m0, %2\n\ts_nop 0\n\tglobal_load_lds_dwordx4 %1, off\n\ts_mov_b32 m0, %0" : "=&s"(keep) : "v"(gsrc), "s"(lds_dst) : "memory"); }
#define SB_WAIT_BAR(N) asm volatile("s_waitcnt vmcnt(" #N ") lgkmcnt(0)\n\ts_barrier" ::: "memory")

__device__ __forceinline__ void qkt(f32x16& p0, f32x16& p1, const LAS unsigned char* Kslot, const bf16x8* qr, int r32, int hi) {
    const LAS unsigned char* kb = Kslot + hi * 1024 + r32 * 16;
    p0 = f32x16{}; p1 = f32x16{};
#pragma unroll
    for (int d0 = 0; d0 < 4; ++d0) {
        const bf16x8 b0 = *(const LAS bf16x8*)(kb + d0 * 2048);
        const bf16x8 b1 = *(const LAS bf16x8*)(kb + d0 * 2048 + 512);
        p0 = __builtin_amdgcn_mfma_f32_32x32x16_bf16(b0, qr[d0], p0, 0, 0, 0);
        p1 = __builtin_amdgcn_mfma_f32_32x32x16_bf16(b1, qr[d0], p1, 0, 0, 0);
    }
}
__device__ __forceinline__ void pv(f32x16* o, unsigned vb, bf16x8 pa0, bf16x8 pa1, bf16x8 pa2, bf16x8 pa3) {
#pragma unroll
    for (int d0 = 0; d0 < 2; ++d0) { s16x4 lo[4], hi[4];
#pragma unroll
        for (int ks = 0; ks < 4; ++ks) {
            asm volatile("ds_read_b64_tr_b16 %0,%1 offset:%c2" : "=&v"(lo[ks]) : "v"(vb), "i"(d0 * 4096 + ks * 1024) : "memory");
            asm volatile("ds_read_b64_tr_b16 %0,%1 offset:%c2" : "=&v"(hi[ks]) : "v"(vb), "i"(d0 * 4096 + ks * 1024 + 512) : "memory"); }
        asm volatile("s_waitcnt lgkmcnt(0)" ::: "memory"); __builtin_amdgcn_sched_barrier(0);
#define SB_PK(k) (bf16x8){lo[k][0], lo[k][1], lo[k][2], lo[k][3], hi[k][0], hi[k][1], hi[k][2], hi[k][3]}
        o[d0] = __builtin_amdgcn_mfma_f32_32x32x16_bf16(pa0, SB_PK(0), o[d0], 0, 0, 0);
        o[d0] = __builtin_amdgcn_mfma_f32_32x32x16_bf16(pa1, SB_PK(1), o[d0], 0, 0, 0);
        o[d0] = __builtin_amdgcn_mfma_f32_32x32x16_bf16(pa2, SB_PK(2), o[d0], 0, 0, 0);
        o[d0] = __builtin_amdgcn_mfma_f32_32x32x16_bf16(pa3, SB_PK(3), o[d0], 0, 0, 0);
#undef SB_PK
    }
}
__device__ __forceinline__ unsigned cvtpk(float lo, float hi) { unsigned r; asm("v_cvt_pk_bf16_f32 %0, %1, %2" : "=v"(r) : "v"(lo), "v"(hi)); return r; }

template <bool MASK> __device__ __forceinline__ void sb_weights(f32x16& P0, f32x16& P1, float& Pr, int kvrel0, int hi) {
#pragma unroll
    for (int r = 0; r < 32; ++r) {
        const float z = r < 16 ? P0[r] : P1[r - 16];
        float kp = __builtin_amdgcn_rcpf(1.0f + __builtin_amdgcn_exp2f(z));
        if (MASK) { if (kvrel0 >= -((r & 3) + 8 * ((r & 15) >> 2) + 32 * (r >> 4))) kp = 1.0f; }
        if (r < 16) P0[r] = kp; else P1[r - 16] = kp;
    }
#define SB_KP(r) ((r) < 16 ? P0[(r)] : P1[(r) - 16])
    float gt[8];
#pragma unroll
    for (int g = 0; g < 8; ++g) gt[g] = (SB_KP(4 * g + 3) * SB_KP(4 * g + 2)) * (SB_KP(4 * g + 1) * SB_KP(4 * g));
    float sg[8]; float run = Pr;
#pragma unroll
    for (int g = 7; g >= 0; --g) {
        auto rr = __builtin_amdgcn_permlane32_swap(__float_as_uint(gt[g]), __float_as_uint(gt[g]), false, false);
        const float lo_t = __uint_as_float(rr[0]), up_t = __uint_as_float(rr[1]);
        const float s_up = run;
        const float s_lo = run * up_t;
        run = s_lo * lo_t;
        sg[g] = hi ? s_up : s_lo;
    }
    Pr = run;
#pragma unroll
    for (int g = 0; g < 8; ++g) {
        const float t4 = sg[g], t3 = t4 * SB_KP(4 * g + 3), t2 = t3 * SB_KP(4 * g + 2), t1 = t2 * SB_KP(4 * g + 1), t0 = t1 * SB_KP(4 * g);
        const float w3 = t4 - t3, w2 = t3 - t2, w1 = t2 - t1, w0 = t1 - t0;
        if (g < 4) { P0[4 * g] = w0; P0[4 * g + 1] = w1; P0[4 * g + 2] = w2; P0[4 * g + 3] = w3; } else { P1[4 * g - 16] = w0; P1[4 * g - 15] = w1; P1[4 * g - 14] = w2; P1[4 * g - 13] = w3; }
    }
#undef SB_KP
}

__device__ __forceinline__ void attn_unit(int b, int h, int qb, const bf16* Z, bf16* O, LAS unsigned char* lds, int tid_in) {
    int tid = tid_in; asm volatile("" : "+v"(tid));
    const int lane = tid & 63, r32 = lane & 31, hi = lane >> 5; const int wid = __builtin_amdgcn_readfirstlane(tid >> 6);
    const size_t rowbase = (size_t)b * T; const int q0 = qb * 256;
    const bf16* Qw = Z + (rowbase + q0 + wid * 32) * ZP + ZC_Q + h * 64;
    const bf16* Kh = Z + rowbase * ZP + ZC_K + h * 64; const bf16* Vh = Z + rowbase * ZP + ZC_V + h * 64;
    const unsigned lds0 = (unsigned)(size_t)lds;
    LAS unsigned* CNT = (LAS unsigned*)(lds + LDS_CNT);
    if (tid < 3) CNT[tid] = 0u;
    const bf16* ksrc = Kh + (size_t)lane * ZP + wid * 8;
    const bf16* vsrc = Vh + (size_t)(16 * (wid & 3) + (lane >> 2)) * ZP + (wid >> 2) * 32 + (lane & 3) * 8;
    const unsigned kdst = lds0 + LDS_K + wid * 1024, vdst = lds0 + LDS_V + wid * 1024;
#define SB_DMA_K(j, so) glds16(ksrc + (size_t)(j) * 64 * ZP, (unsigned)__builtin_amdgcn_readfirstlane(kdst + (so)))
#define SB_DMA_V(j, so) glds16(vsrc + (size_t)(j) * 64 * ZP, (unsigned)__builtin_amdgcn_readfirstlane(vdst + (so)))
    const int NT = (q0 + 256) / 128;
#define SB_DMA2(J, so) do { SB_DMA_K(2 * (J) + 1, (so)); SB_DMA_V(2 * (J) + 1, (so)); SB_DMA_K(2 * (J), (so) + 8192); SB_DMA_V(2 * (J), (so) + 8192); } while (0)
    SB_DMA2(NT - 1, 0); if (NT > 1) SB_DMA2(NT - 2, SLOTB);
    bf16x8 qr[4];
#pragma unroll
    for (int d0 = 0; d0 < 4; ++d0) qr[d0] = *(const GAS bf16x8*)(Qw + (size_t)r32 * ZP + d0 * 16 + hi * 8);
    asm volatile("" : "+v"(qr[0]), "+v"(qr[1]), "+v"(qr[2]), "+v"(qr[3]));
    f32x16 o[2]; o[0] = f32x16{}; o[1] = f32x16{};
    float Pr = 1.0f; bool wdone = false;
    const int tq = q0 + wid * 32 + r32, tmin = q0 + wid * 32, tmax = tmin + 31;
    const unsigned vb0 = lds0 + LDS_V + ((lane >> 4) & 1) * 32 + (lane & 3) * 8 + (4 * hi + ((lane & 15) >> 2)) * 64;
    int so_cur = 0, so_n2 = 2 * SLOTB;
    for (int i = 0; i < NT; ++i) {
        const int j = NT - 1 - i;
        if (i + 1 < NT) { SB_WAIT_BAR(4); } else { SB_WAIT_BAR(0); }
        if (i > 0) { const unsigned votes = CNT[(i - 1) % 3]; if (votes == 8u) break; }
        if (tid == 0) CNT[(i + 1) % 3] = 0u;
        if (i + 2 < NT) SB_DMA2(j - 2, so_n2);
#pragma unroll
        for (int sub = 0; sub < 2; ++sub) {
            const int kv0 = 128 * j + 64 * (1 - sub), so_t = so_cur + sub * 8192;
            if (kv0 < tmax && !wdone) {
                f32x16 P0, P1;
                qkt(P0, P1, lds + LDS_K + so_t, qr, r32, hi);
                if (kv0 + 63 >= tmin) sb_weights<true>(P0, P1, Pr, kv0 - tq + 4 * hi, hi); else sb_weights<false>(P0, P1, Pr, 0, hi);
                v4u pw0, pw1, pw2, pw3;
                pw0.x = cvtpk(P0[0], P0[1]); pw0.y = cvtpk(P0[2], P0[3]); pw0.z = cvtpk(P0[4], P0[5]); pw0.w = cvtpk(P0[6], P0[7]);
                pw1.x = cvtpk(P0[8], P0[9]); pw1.y = cvtpk(P0[10], P0[11]); pw1.z = cvtpk(P0[12], P0[13]); pw1.w = cvtpk(P0[14], P0[15]);
                pw2.x = cvtpk(P1[0], P1[1]); pw2.y = cvtpk(P1[2], P1[3]); pw2.z = cvtpk(P1[4], P1[5]); pw2.w = cvtpk(P1[6], P1[7]);
                pw3.x = cvtpk(P1[8], P1[9]); pw3.y = cvtpk(P1[10], P1[11]); pw3.z = cvtpk(P1[12], P1[13]); pw3.w = cvtpk(P1[14], P1[15]);
                pv(o, vb0 + so_t, __builtin_bit_cast(bf16x8, pw0), __builtin_bit_cast(bf16x8, pw1), __builtin_bit_cast(bf16x8, pw2), __builtin_bit_cast(bf16x8, pw3));
                wdone = __all(Pr == 0.0f);
            }
        }
        if (wdone && lane == 0) __hip_atomic_fetch_add(CNT + (i % 3), 1u, __ATOMIC_RELAXED, __HIP_MEMORY_SCOPE_WORKGROUP);
        so_cur = (so_cur == 2 * SLOTB) ? 0 : so_cur + SLOTB; so_n2 = (so_n2 == 2 * SLOTB) ? 0 : so_n2 + SLOTB;
    }
    { LAS bf16* stg = (LAS bf16*)(lds + LDS_OST) + wid * 2048;
#pragma unroll
      for (int r = 0; r < 16; ++r) { const int orow = crow(r, hi);
#pragma unroll
          for (int d0 = 0; d0 < 2; ++d0) stg[orow * 64 + d0 * 32 + r32] = (bf16)f2bf(o[d0][r]); }
      asm volatile("s_waitcnt lgkmcnt(0)" ::: "memory");
      bf16* Ow = O + (rowbase + q0 + wid * 32) * D + h * 64;
#pragma unroll
      for (int i = 0; i < 4; ++i) { const int row = i * 8 + (lane >> 3), ch = lane & 7; const v4u v = *(const LAS v4u*)(stg + row * 64 + ch * 8); *(GAS v4u*)(Ow + (size_t)row * D + ch * 8) = v; } }
    asm volatile("s_waitcnt vmcnt(0) lgkmcnt(0)\n\ts_barrier" ::: "memory");
#undef SB_DMA2
#undef SB_DMA_K
#undef SB_DMA_V
}
__device__ __forceinline__ void attn_phase(const bf16* Z, bf16* O, LAS unsigned char* lds, int tid, int G) {
    for (int bh = blockIdx.x; bh < BATCH * 16; bh += G)
        for (int qb = 7; qb >= 0; --qb) attn_unit(bh >> 4, bh & 15, qb, Z, O, lds, tid);
}
}
namespace sg {
using f32x16 = __attribute__((ext_vector_type(16))) float;
using s16x4 = __attribute__((ext_vector_type(4))) short;
typedef unsigned u32x2 __attribute__((ext_vector_type(2)));
constexpr int XS_STRIDE = 576, WS_STRIDE = 272, PT_STRIDE = 36  ;
static_assert(8 * 64 * PT_STRIDE * 4 <= 128 * XS_STRIDE, "patches fit the X image");
constexpr int L_XS = 0, L_WS = 128 * XS_STRIDE, L_STAT = L_WS + 128 * WS_STRIDE, L_BS = L_STAT + 1024;
#define SG_BAR() asm volatile("s_waitcnt lgkmcnt(0)\n\ts_barrier" ::: "memory")
__device__ __forceinline__ int crow(int r, int hi) { return (r & 3) + 8 * (r >> 2) + 4 * hi; }

__device__ __forceinline__ void sgu_phase(const float* ln_g, const float* ln_b, const float* w_s, const float* b_s, const bf16* ZC, bf16* O, LAS unsigned char* lds, int tid_in, int G) {
    LAS float* STAT = (LAS float*)(lds + L_STAT); LAS float* BS = (LAS float*)(lds + L_BS);
    for (int bn = blockIdx.x; bn < BATCH * 16; bn += G) {
        int tid = tid_in; asm volatile("" : "+v"(tid));
        const int lane = tid & 63, wave = __builtin_amdgcn_readfirstlane(tid >> 6), r32 = lane & 31, hi = lane >> 5;
        const size_t rowbase = (size_t)bn * 128;
#pragma unroll 4
        for (int rr = 0; rr < 16; ++rr) {
            const int row = 16 * wave + rr;
            const GAS v4u* vr = (const GAS v4u*)(ZC + (rowbase + row) * 4096 + 2048) + lane;
            float x[32]; float s = 0.f;
#pragma unroll
            for (int j = 0; j < 4; ++j) { const v4u w = vr[64 * j];
                x[8 * j + 0] = bflo(w.x); x[8 * j + 1] = bfhi(w.x); x[8 * j + 2] = bflo(w.y); x[8 * j + 3] = bfhi(w.y); x[8 * j + 4] = bflo(w.z); x[8 * j + 5] = bfhi(w.z); x[8 * j + 6] = bflo(w.w); x[8 * j + 7] = bfhi(w.w); }
#pragma unroll
            for (int j = 0; j < 32; ++j) s += x[j];
            const float mean = wave_sum(s) * (1.f / 2048.f); float q = 0.f;
#pragma unroll
            for (int j = 0; j < 32; ++j) { const float d = x[j] - mean; q += d * d; }
            const float rstd = 1.0f / sqrtf(wave_sum(q) * (1.f / 2048.f) + 1e-5f);
            if (lane == 0) { STAT[2 * row] = mean; STAT[2 * row + 1] = rstd; }
        }
        SG_BAR();
        const int cc = tid & 31;
        v4u xv[8];
#define SG_FETCH(gg) do { unsigned vo_ = (unsigned)(((tid >> 5) * 4096 + 8 * cc) * 2); asm volatile("" : "+v"(vo_));     \
            const GAS unsigned char* zb_ = (const GAS unsigned char*)(ZC + rowbase * 4096 + 2048 + 256 * (gg)); \
            _Pragma("unroll") for (int i = 0; i < 8; ++i) xv[i] = *(const GAS v4u*)(zb_ + (size_t)i * (16 * 4096 * 2) + vo_); } while (0)
        SG_FETCH(0);
#pragma unroll 1
        for (int g = 0; g < 8; ++g) {
            f32x4 wv[8];
#pragma unroll
            for (int i = 0; i < 8; ++i) { const int id = tid + 512 * i, s = id >> 5; wv[i] = *(const GAS f32x4*)(w_s + ((size_t)g * 128 + s) * 128 + 4 * cc); }
            const f32x4 lg0 = *(const GAS f32x4*)(ln_g + 256 * g + 8 * cc), lg1 = *(const GAS f32x4*)(ln_g + 256 * g + 8 * cc + 4);
            const f32x4 lb0 = *(const GAS f32x4*)(ln_b + 256 * g + 8 * cc), lb1 = *(const GAS f32x4*)(ln_b + 256 * g + 8 * cc + 4);
            if (tid < 128) BS[tid] = b_s[g * 128 + tid];
#pragma unroll
            for (int i = 0; i < 8; ++i) { const int id = tid + 512 * i, s = id >> 5;
                const float mean = STAT[2 * s], rstd = STAT[2 * s + 1];
                const v4u w = xv[i];
                const f32x4 a0 = ((f32x4){bflo(w.x), bfhi(w.x), bflo(w.y), bfhi(w.y)} - mean) * rstd * lg0 + lb0;
                const f32x4 a1 = ((f32x4){bflo(w.z), bfhi(w.z), bflo(w.w), bfhi(w.w)} - mean) * rstd * lg1 + lb1;
                v4u o; o.x = pk2(a0.x, a0.y); o.y = pk2(a0.z, a0.w); o.z = pk2(a1.x, a1.y); o.w = pk2(a1.z, a1.w);
                *(LAS v4u*)(lds + L_XS + s * XS_STRIDE + cc * 16) = o;
                u32x2 p; p.x = pk2(wv[i].x, wv[i].y); p.y = pk2(wv[i].z, wv[i].w);
                *(LAS u32x2*)(lds + L_WS + s * WS_STRIDE + cc * 8) = p; }
            SG_BAR();
            if (g < 7) SG_FETCH(g + 1);
            f32x16 acc[4];
#pragma unroll
            for (int tt = 0; tt < 4; ++tt) acc[tt] = f32x16{};
            const unsigned xb = (unsigned)(size_t)(lds + L_XS) + (8 * hi + ((lane & 15) >> 2)) * XS_STRIDE + (32 * wave + 16 * ((lane >> 4) & 1) + 4 * (lane & 3)) * 2;
            const unsigned xb4 = xb + 4 * XS_STRIDE;
            const LAS unsigned char* wb = lds + L_WS + r32 * WS_STRIDE + 16 * hi;
#pragma unroll
            for (int ks = 0; ks < 8; ++ks) {
                s16x4 lo, up;
                asm volatile("ds_read_b64_tr_b16 %0,%1 offset:%c2" : "=&v"(lo) : "v"(xb), "i"(ks * 16 * XS_STRIDE) : "memory");
                asm volatile("ds_read_b64_tr_b16 %0,%1 offset:%c2" : "=&v"(up) : "v"(xb4), "i"(ks * 16 * XS_STRIDE) : "memory");
                bf16x8 af[4];
#pragma unroll
                for (int tt = 0; tt < 4; ++tt) if (tt >= 2 || ks < 4) af[tt] = *(const LAS bf16x8*)(wb + tt * 32 * WS_STRIDE + ks * 32);
                asm volatile("s_waitcnt lgkmcnt(0)" ::: "memory"); __builtin_amdgcn_sched_barrier(0);
                const bf16x8 bfr = (bf16x8){lo[0], lo[1], lo[2], lo[3], up[0], up[1], up[2], up[3]};
#pragma unroll
                for (int tt = 0; tt < 4; ++tt) if (tt >= 2 || ks < 4) acc[tt] = __builtin_amdgcn_mfma_f32_32x32x16_bf16(af[tt], bfr, acc[tt], 0, 0, 0);
            }
            const size_t ccol = (size_t)(256 * g + 32 * wave + 8 * (lane & 3));
            v4u uq[4];
#pragma unroll
            for (int j = 0; j < 4; ++j) uq[j] = *(const GAS v4u*)(ZC + (rowbase + 16 * j + (lane >> 2)) * 4096 + ccol);
            SG_BAR();
            LAS float* PT = (LAS float*)(lds + L_XS + wave * (64 * PT_STRIDE * 4));
#pragma unroll
            for (int half = 0; half < 2; ++half) {
#pragma unroll
                for (int t2 = 0; t2 < 2; ++t2)
#pragma unroll
                    for (int r = 0; r < 16; ++r) { const int tl = 32 * t2 + crow(r, hi); PT[tl * PT_STRIDE + r32] = acc[2 * half + t2][r] + BS[64 * half + tl]; }
                asm volatile("s_waitcnt lgkmcnt(0)" ::: "memory");
                v4u un[4];
                if (half == 0) {
#pragma unroll
                    for (int j = 0; j < 4; ++j) un[j] = *(const GAS v4u*)(ZC + (rowbase + 64 + 16 * j + (lane >> 2)) * 4096 + ccol); }
#pragma unroll
                for (int j = 0; j < 4; ++j) { const int tl = 16 * j + (lane >> 2);
                    const f32x4 m0 = *(const LAS f32x4*)(PT + tl * PT_STRIDE + 8 * (lane & 3)), m1 = *(const LAS f32x4*)(PT + tl * PT_STRIDE + 8 * (lane & 3) + 4);
                    const v4u w = uq[j];
                    v4u o; o.x = pk2(m0.x * bflo(w.x), m0.y * bfhi(w.x)); o.y = pk2(m0.z * bflo(w.y), m0.w * bfhi(w.y)); o.z = pk2(m1.x * bflo(w.z), m1.y * bfhi(w.z)); o.w = pk2(m1.z * bflo(w.w), m1.w * bfhi(w.w));
                    *(GAS v4u*)(O + (rowbase + 64 * half + tl) * D + ccol) = o; }
                if (half == 0) {
#pragma unroll
                    for (int j = 0; j < 4; ++j) uq[j] = un[j]; }
                asm volatile("s_waitcnt lgkmcnt(0)" ::: "memory");
            }
            SG_BAR();
        }
    }
}
}
#define AS4 __attribute__((address_space(4)))
__device__ __forceinline__ const AS4 unsigned char* kargs() { const AS4 unsigned char* kp = (const AS4 unsigned char*)__builtin_amdgcn_kernarg_segment_ptr(); asm volatile("" : "+s"(kp)); return kp; }
__device__ __forceinline__ const float* arg_in(int k) { return *(const float* const AS4*)(kargs() + 8 * k); }
__device__ __forceinline__ float* arg_out() { return *(float* const AS4*)(kargs() + 200); }
__device__ __forceinline__ unsigned char* arg_ws() { return *(unsigned char* const AS4*)(kargs() + 208); }
static_assert(sizeof(Args) == 224, "Args layout: in[25] | out | ws | ph_lo | ph_hi");
#ifndef MK_ONE_LAUNCH
#define MK_ONE_LAUNCH 1
#endif
#ifndef MK_PROBE_DUP
#define MK_PROBE_DUP 0
#endif
#define DUP(k) for (int rep_ = 0; rep_ < 1 + ((MK_PROBE_DUP >> (k)) & 1); ++rep_)
__global__ void __launch_bounds__(NWAVES * 64, 2) fwd(Args a) {
    extern __shared__ __attribute__((aligned(16))) unsigned char lds_raw[];
    LAS unsigned char* lds = (LAS unsigned char*)lds_raw;
    const int wave = __builtin_amdgcn_readfirstlane((int)threadIdx.x >> 6), G = gridDim.x;
    for (int u = threadIdx.x; u < (LDS_BYTES - LDSCTL_OFF) / 4; u += NWAVES * 64) ((LAS unsigned*)(lds + LDSCTL_OFF))[u] = 0u;
    __syncthreads();
    XcdBarrier bar; bar.bar = (unsigned*)(arg_ws() + WS_CTL) + CW_BAR; bar.x = 0; bar.st = nullptr;
    if (MK_ONE_LAUNCH) bar = xcd_barrier_post((unsigned*)(arg_ws() + WS_CTL) + CW_BAR, (volatile LAS unsigned*)(lds + MISC_OFF) + 8);
    const int lo = a.ph_lo, hi = a.ph_hi;
#define IN(k) (lo <= (k) && (k) < hi)
#define SEAM(k) do { if (MK_ONE_LAUNCH && IN(k) && IN((k) + 1)) xcd_barrier(bar); } while (0)
#pragma unroll 1
    for (int L = 0; L < DEPTH; ++L) {
        const int pb = 8 * L, i = L >> 1; const bool even = !(L & 1);
#define FRESH_TID() int lane; asm volatile("v_mbcnt_lo_u32_b32 %0, -1, 0\n\tv_mbcnt_hi_u32_b32 %0, -1, %0" : "=v"(lane)); const int tid = wave * 64 + lane; (void)tid
        unsigned char* const ws = arg_ws();
        bf16* const H = (bf16*)(ws + WS_H); bf16* const BIG = (bf16*)(ws + WS_BIG);
        if (IN(pb + 0)) { FRESH_TID();
            const float* Win; const float* Wout; int Nin;
            if (even) { Win = arg_in(4) + (size_t)i * D * EVEN_N; Wout = arg_in(16) + (size_t)i * D * D; Nin = EVEN_N; } else { Win = arg_in(17) + (size_t)i * D * 4096; Wout = arg_in(22) + (size_t)i * D * D; Nin = 4096; }
            const float* x0 = nullptr; if (L == 0) x0 = arg_in(0);
            DUP(0) prep_phase(Win, Nin, Wout, arg_in(23) + (size_t)L * D * FF, arg_in(24) + (size_t)L * FF * D, x0, arg_in(1) + (size_t)L * D, arg_in(2) + (size_t)L * D, ws, even, lds, wave, lane, tid, G); SEAM(pb + 0); }
        if (IN(pb + 1)) { FRESH_TID();
            bf16* const WA = (bf16*)(ws + WS_WA);
            bf16* const XB = (bf16*)(ws + WS_XB); const float* const SSQ = (const float*)(ws + WS_SSQ);
            if (even) { pg8::Gemm g{XB, WA, M, ZP, D}; pg8::StaticOrder S; S.init(M, ZP, G, (int)blockIdx.x, 8); const int pm0 = pg8::rs_table(SSQ, S, lds, tid); pg8::EpiActS<0> E{BIG, ZP, 4, sb::QSCALE, (const LAS float*)(lds + pg8::LX_RS), pm0};
                DUP(5) pg8::gemm_phase<pg8::EpiActS<0>, pg8::StaticOrder, true, true>(lds, g, S, E, tid); }
            else { pg8::Gemm g{XB, WA, M, 4096, D}; pg8::StaticOrder S; S.init(M, 4096, G, (int)blockIdx.x, 8); const int pm0 = pg8::rs_table(SSQ, S, lds, tid); pg8::EpiActS<1> E{BIG, 4096, 0, 1.f, (const LAS float*)(lds + pg8::LX_RS), pm0};
                DUP(5) pg8::gemm_phase<pg8::EpiActS<1>, pg8::StaticOrder, true, true>(lds, g, S, E, tid); }
            SEAM(pb + 1);
        }
        if (IN(pb + 2)) { FRESH_TID();
            if (even) { DUP(1) sb::attn_phase(BIG, H, lds, tid, G); }
            else DUP(3) sg::sgu_phase(arg_in(18) + (size_t)i * 2048, arg_in(19) + (size_t)i * 2048, arg_in(20) + (size_t)i * 131072, arg_in(21) + (size_t)i * 1024, BIG, H, lds, tid, G);
        }
        if (IN(pb + 3)) { FRESH_TID();
            if (even) { const rw::Params q{arg_in(5) + (size_t)i * RWS, arg_in(6) + (size_t)i * 65536, arg_in(7) + (size_t)i * 1024, arg_in(8) + (size_t)i * 65536, arg_in(9) + (size_t)i * 1024, arg_in(10) + (size_t)i * 163840,
                    arg_in(11) + (size_t)i * 1024, arg_in(12) + (size_t)i * 1024, arg_in(13) + (size_t)i * 1024, arg_in(14) + (size_t)i * 1024, arg_in(15) + (size_t)i * 1024};
                DUP(2) rw12::rwkv_phase(q, BIG, H, lds, tid, (int)blockIdx.x, G); }
            SEAM(pb + 3); }
        if (IN(pb + 4)) { FRESH_TID(); pg8::Gemm g{H, (bf16*)(ws + WS_WB), M, D, D}; pg8::StaticOrder S; S.init(M, D, G, (int)blockIdx.x); pg8::EpiResidB E{(bf16*)(ws + WS_XB), (float*)(ws + WS_SSQ), D, lds};
            pg8::gemm_phase<pg8::EpiResidB, pg8::StaticOrder, true, true>(lds, g, S, E, tid); SEAM(pb + 4); }
        if (IN(pb + 6)) { FRESH_TID(); pg8::Gemm g{(bf16*)(ws + WS_XB), (bf16*)(ws + WS_W1), M, FF, D}; pg8::StaticOrder S; S.init(M, FF, G, (int)blockIdx.x, 8); const int pm0 = pg8::rs_table((const float*)(ws + WS_SSQ), S, lds, tid); pg8::EpiActS<2> E{BIG, FF, 0, 1.f, (const LAS float*)(lds + pg8::LX_RS), pm0};
            DUP(6) pg8::gemm_phase<pg8::EpiActS<2>, pg8::StaticOrder, true, true>(lds, g, S, E, tid); SEAM(pb + 6); }
        if (IN(pb + 7)) { FRESH_TID(); pg8::Gemm g{BIG, (bf16*)(ws + WS_W2), M, D, FF}; pg8::StaticOrder S; S.init(M, D, G, (int)blockIdx.x); pg8::EpiResidB E{(bf16*)(ws + WS_XB), (float*)(ws + WS_SSQ), D, lds};
            pg8::gemm_phase<pg8::EpiResidB, pg8::StaticOrder, true, true>(lds, g, S, E, tid); SEAM(pb + 7); }
    }
    if (IN(32)) { const int gw = blockIdx.x * NWAVES + wave, NGW = G * NWAVES; int lane; asm volatile("v_mbcnt_lo_u32_b32 %0, -1, 0\n\tv_mbcnt_hi_u32_b32 %0, -1, %0" : "=v"(lane)); float* const xo = arg_out(); const float* gf = arg_in(3); const bf16* const XB = (const bf16*)(arg_ws() + WS_XB);
        for (int m = gw; m < M; m += NGW) rms_row_out(XB + (size_t)m * D, gf, xo + (size_t)m * D, lane); }
#undef IN
#undef SEAM
}

extern "C" void kernel_launch(void* const* d_in, const int* in_sizes, int n_in, void* d_out, int out_size, void* d_ws, size_t ws_size, hipStream_t stream) {
    static int grid = 0;
    if (grid == 0) {
        if (n_in != 25 || out_size != M * D || ws_size < WS_END) { fprintf(stderr, "kernel_launch: unexpected shapes (n_in %d, out %d, ws %zu)\n", n_in, out_size, ws_size); grid = -1; return; }
        int dev = 0, cus = 0, per_cu = 0;
        if (hipGetDevice(&dev) != hipSuccess || hipDeviceGetAttribute(&cus, hipDeviceAttributeMultiprocessorCount, dev) != hipSuccess) { grid = -1; return; }
        if (hipFuncSetAttribute((const void*)fwd, hipFuncAttributeMaxDynamicSharedMemorySize, LDS_BYTES) != hipSuccess) { fprintf(stderr, "kernel_launch: hipFuncSetAttribute failed\n"); grid = -1; return; }
        if (hipOccupancyMaxActiveBlocksPerMultiprocessor(&per_cu, (const void*)fwd, NWAVES * 64, LDS_BYTES) != hipSuccess || per_cu < 1) fprintf(stderr, "kernel_launch: occupancy query reports %d\n", per_cu);
        (void)hipGetLastError();
        grid = cus;
    }
    if (grid < 0) return;
    (void)hipMemsetAsync((char*)d_ws + WS_CTL, 0, CTL_ZERO_BYTES, stream);
    Args a{};
    for (int i = 0; i < 25; ++i) a.in[i] = (const float*)d_in[i];
    a.out = (float*)d_out; a.ws = (unsigned char*)d_ws;
#if MK_ONE_LAUNCH
    a.ph_lo = 0; a.ph_hi = NPH;
    hipLaunchKernelGGL(fwd, dim3(grid), dim3(NWAVES * 64), LDS_BYTES, stream, a);
#else
    for (int p = 0; p < NPH; ++p) { a.ph_lo = p; a.ph_hi = p + 1;
        hipLaunchKernelGGL(fwd, dim3(grid), dim3(NWAVES * 64), LDS_BYTES, stream, a); }
#endif
}
```

```cpp
#include <hip/hip_runtime.h>
#include <cstdio>
#include <cstdint>
namespace pg8 {
#define PG8_LAS __attribute__((address_space(3)))
typedef unsigned short bf16_t;
typedef short bf16x8 __attribute__((ext_vector_type(8)));
typedef float f32x4 __attribute__((ext_vector_type(4)));
typedef unsigned u32x4 __attribute__((ext_vector_type(4)));
constexpr int BM = 256, BK = 64, HALF = 128, HTB = HALF * BK * 2  , STAGE_BYTES = 8 * HTB, NXCD = 8, WGM = 8;

__host__ __device__ __forceinline__ int lds_byte(int r, int c) { const int st = (r >> 4) * 2 + (c >> 5), rr = r & 15, cc = c & 31, ob = rr * 64 + cc * 2; return st * 1024 + (ob ^ (((ob >> 9) & 1) << 5)); }
__host__ __device__ __forceinline__ void stage_rc(int b, int& R, int& C) { const int st = b / 1024, sb = b % 1024, swz = sb ^ (((sb >> 9) & 1) << 5); R = (st >> 1) * 16 + swz / 64; C = (st & 1) * 32 + (swz % 64) / 2; }
__host__ __device__ __forceinline__ int perm32(int rho) { const int n = rho >> 4, i = rho & 15; return 8 * (i >> 2) + 4 * n + (i & 3); }

struct Unit { int pm, pn; };
struct Gemm { const bf16_t* A; const bf16_t* Bt; int M, N, K; };

struct StaticOrder {
    int nM, nN, nwg, G, c;
    int wgm = 4;
    __host__ __device__ void init(int M, int N, int G_, int c_, int wgm_ = 4) { nM = M / BM; nN = N / BM; nwg = nM * nN; G = G_; c = c_; wgm = wgm_; }
    __host__ __device__ bool next(int i, Unit& u) const {
        const long L = (long)i * G + c; if (L >= nwg) return false;
        int wgid = (int)L; { const int q = nwg / NXCD, r = nwg % NXCD, xcd = wgid % NXCD, off = wgid / NXCD; wgid = (xcd < r ? xcd * (q + 1) : r * (q + 1) + (xcd - r) * q) + off; }
        const int nig = wgm * nN, gid = wgid / nig, fm = gid * wgm, gsz = (nM - fm) < wgm ? (nM - fm) : wgm;
        u.pm = fm + ((wgid % nig) % gsz); u.pn = (wgid % nig) / gsz; return true;
    }
    __device__ __forceinline__ void a_ready(const Unit&) const {}
    __device__ __forceinline__ void done(const Unit&) const {}
};

__device__ __forceinline__ unsigned cvt_pk_bf16(float lo, float hi) { unsigned r; asm volatile("v_cvt_pk_bf16_f32 %0, %1, %2" : "=v"(r) : "v"(lo), "v"(hi)); return r; }
typedef float f32x2 __attribute__((ext_vector_type(2)));
__device__ __forceinline__ f32x2 gelu_pk(f32x2 v) {
    const f32x2 av = __builtin_elementwise_abs(v), d = av * 0.2316418882f + 1.0f;
    f32x2 t; t.x = __builtin_amdgcn_rcpf(d.x); t.y = __builtin_amdgcn_rcpf(d.y);
    f32x2 q = t * 0.5307027145f + (-0.7265760135f); q = q * t + 0.7107068705f; q = q * t + (-0.142248368f); q = q * t + 0.127414796f; q = q * t;
    const f32x2 s = (v * v) * (-0.72134752044f);
    f32x2 e; e.x = __builtin_amdgcn_exp2f(s.x); e.y = __builtin_amdgcn_exp2f(s.y);
    const f32x2 m = v * (q * e), r = v - m;
    f32x2 o; o.x = v.x < 0.f ? m.x : r.x; o.y = v.y < 0.f ? m.y : r.y; return o;
}
constexpr int LX_RED = 135168;
constexpr int LX_RS = 139264;
template <class Sched> __device__ __forceinline__ int rs_table(const float* ssq, const Sched& S, PG8_LAS unsigned char* lds0, int tid) {
    Unit ua, ub; if (!S.next(0, ua)) return 0;
    ub = ua; S.next((S.nwg - 1 - S.c) / S.G, ub);
    const int row = ((tid < BM) ? ua.pm : ub.pm) * BM + (tid & (BM - 1));
    const f32x4* p = (const f32x4*)(ssq + (size_t)row * 8); const f32x4 a = p[0], b = p[1];
    ((PG8_LAS float*)(lds0 + LX_RS))[tid] = __builtin_amdgcn_rsqf((((a[0] + a[1]) + (a[2] + a[3])) + ((b[0] + b[1]) + (b[2] + b[3]))) * (1.0f / 2048.0f) + 1e-6f);
    return ua.pm;
}
template <int ACT> struct EpiActS {
    static constexpr bool PERM = true, AFTER_DRAIN = false;
    bf16_t* O; int ldc; int nscale; float scale0; const PG8_LAS float* rs_tab; int pm0;
    __device__ __forceinline__ void operator()(const f32x4 (&acc)[2][2][4][2], const Unit& u, int wr, int wc, int fr, int fq) const {
        const int row0 = u.pm * BM + wr * 64 + fr; const int col0 = u.pn * BM + wc * 32 + 8 * fq;
        const float sc = (u.pn < nscale) ? scale0 : 1.f;
        float rs[2][4];
        const PG8_LAS float* rt = rs_tab + ((u.pm == pm0) ? 0 : BM) + wr * 64 + fr;
#pragma unroll
        for (int ai = 0; ai < 2; ++ai)
#pragma unroll
            for (int m = 0; m < 4; ++m) rs[ai][m] = rt[ai * HALF + m * 16];
#pragma unroll
        for (int ai = 0; ai < 2; ++ai)
#pragma unroll
            for (int m = 0; m < 4; ++m) { bf16_t* rowp = O + (size_t)(row0 + ai * HALF + m * 16) * ldc + col0; const float rsv = rs[ai][m];
#pragma unroll
                for (int bj = 0; bj < 2; ++bj) { f32x4 v0 = acc[ai][bj][m][0] * rsv, v1 = acc[ai][bj][m][1] * rsv;
                    if (ACT == 1) { f32x2 a = gelu_pk((f32x2){v0[0], v0[1]}), b = gelu_pk((f32x2){v0[2], v0[3]}), c = gelu_pk((f32x2){v1[0], v1[1]}), d = gelu_pk((f32x2){v1[2], v1[3]});
                        v0 = (f32x4){a.x, a.y, b.x, b.y}; v1 = (f32x4){c.x, c.y, d.x, d.y}; }
                    if (ACT == 2) { const f32x4 z = {0.f, 0.f, 0.f, 0.f}; v0 = __builtin_elementwise_max(v0, z); v1 = __builtin_elementwise_max(v1, z); v0 = v0 * v0; v1 = v1 * v1; }
                    if (ACT == 0) { v0 = v0 * sc; v1 = v1 * sc; }
                    u32x4 w; w.x = cvt_pk_bf16(v0[0], v0[1]); w.y = cvt_pk_bf16(v0[2], v0[3]); w.z = cvt_pk_bf16(v1[0], v1[1]); w.w = cvt_pk_bf16(v1[2], v1[3]);
                    *(u32x4*)(rowp + bj * HALF) = w; } }
    }
};
struct EpiResidB {
    static constexpr bool PERM = true, AFTER_DRAIN = false;
    bf16_t* xb; float* ssq; int ldc; PG8_LAS unsigned char* lds0;
    __device__ __forceinline__ void operator()(const f32x4 (&acc)[2][2][4][2], const Unit& u, int wr, int wc, int fr, int fq) const {
        const int col0 = u.pn * BM + wc * 32 + 8 * fq;
        PG8_LAS float* RED = (PG8_LAS float*)(lds0 + LX_RED);
#pragma unroll
        for (int ai = 0; ai < 2; ++ai)
#pragma unroll
            for (int m = 0; m < 4; ++m) { const int rl = ai * HALF + wr * 64 + m * 16 + fr; const size_t off = (size_t)(u.pm * BM + rl) * ldc + col0;
                u32x4 b[2];
#pragma unroll
                for (int bj = 0; bj < 2; ++bj) b[bj] = *(const u32x4*)(xb + off + bj * HALF);
                float q = 0.f;
#pragma unroll
                for (int bj = 0; bj < 2; ++bj) {
                    f32x4 o0 = {__uint_as_float(b[bj].x << 16), __uint_as_float(b[bj].x & 0xffff0000u), __uint_as_float(b[bj].y << 16), __uint_as_float(b[bj].y & 0xffff0000u)};
                    f32x4 o1 = {__uint_as_float(b[bj].z << 16), __uint_as_float(b[bj].z & 0xffff0000u), __uint_as_float(b[bj].w << 16), __uint_as_float(b[bj].w & 0xffff0000u)};
                    o0 = o0 + acc[ai][bj][m][0]; o1 = o1 + acc[ai][bj][m][1];
                    q += ((o0[0] * o0[0] + o0[1] * o0[1]) + (o0[2] * o0[2] + o0[3] * o0[3])) + ((o1[0] * o1[0] + o1[1] * o1[1]) + (o1[2] * o1[2] + o1[3] * o1[3]));
                    u32x4 w; w.x = cvt_pk_bf16(o0[0], o0[1]); w.y = cvt_pk_bf16(o0[2], o0[3]); w.z = cvt_pk_bf16(o1[0], o1[1]); w.w = cvt_pk_bf16(o1[2], o1[3]);
                    *(u32x4*)(xb + off + bj * HALF) = w; }
                { auto r16 = __builtin_amdgcn_permlane16_swap(__float_as_uint(q), __float_as_uint(q), false, false); q = __uint_as_float(r16[0]) + __uint_as_float(r16[1]);
                  auto r32 = __builtin_amdgcn_permlane32_swap(__float_as_uint(q), __float_as_uint(q), false, false); q = __uint_as_float(r32[0]) + __uint_as_float(r32[1]); }
                if (fq == 0) RED[rl * 4 + wc] = q;
                if (m & 1) asm volatile("" ::: "memory"); }
        asm volatile("s_waitcnt lgkmcnt(0)\n\ts_barrier" ::: "memory");
        const int t = (wr * 4 + wc) * 64 + fq * 16 + fr;
        if (t < BM) { const f32x4 r4 = *(const PG8_LAS f32x4*)(RED + t * 4); ssq[(size_t)(u.pm * BM + t) * 8 + u.pn] = (r4[0] + r4[1]) + (r4[2] + r4[3]); }
    }
};
template <class Epi, class Sched, bool ALIGN_EPI = false, bool SP2 = false>
__device__ __forceinline__ void gemm_phase(PG8_LAS unsigned char* lds, const Gemm g, const Sched& S, const Epi& E, int tid_in) {
    int tid_ = tid_in; const bf16_t* gA_ = g.A; const bf16_t* gB_ = g.Bt; asm volatile("" : "+v"(tid_), "+s"(gA_), "+s"(gB_));
    const int tid = tid_, wid = __builtin_amdgcn_readfirstlane(tid >> 6), lane = tid & 63, wr = wid >> 2, wc = wid & 3, fr = lane & 15, fq = lane >> 4;
    const int K = g.K, nt = K / BK;
    unsigned voffA[2], voffB[2];
#pragma unroll
    for (int i = 0; i < 2; ++i) { int R, C; stage_rc(tid * 16 + i * 8192, R, C); const int Rb = Epi::PERM ? ((R & ~31) + perm32(R & 31)) : R;
        voffA[i] = (unsigned)(R * K + C) * 2u; voffB[i] = (unsigned)(Rb * K + C) * 2u; }
    const size_t kstep = (size_t)(BK * 2);
    const size_t hstep = (size_t)HALF * K * 2;
    const size_t tstep = 2 * hstep;
    const unsigned ldsw = (unsigned)wid * 1024u;
    const int aoff = lds_byte(wr * 64 + fr, fq * 8), boff = lds_byte(wc * 32 + fr, fq * 8);
#define PG8_SA(b, h) (((b) * 2 + (h)) * HTB)
#define PG8_SB(b, h) ((4 + (b) * 2 + (h)) * HTB)
#define PG8_STAGE(bufoff, gbase, voff) do { _Pragma("unroll") for (int _i = 0; _i < 2; ++_i) \
        __builtin_amdgcn_global_load_lds((const unsigned*)((const char*)(gbase) + (voff)[_i]), (PG8_LAS unsigned*)(lds + (bufoff) + ldsw + _i * 8192), 16, 0, 0); } while (0)
#define PG8_LDA(dst, b, h) do { _Pragma("unroll") for (int m = 0; m < 4; ++m) _Pragma("unroll") for (int k = 0; k < 2; ++k) dst[m][k] = *(const PG8_LAS bf16x8*)(lds + PG8_SA(b, h) + aoff + m * 2048 + k * 1024); } while (0)
#define PG8_LDB(dst, b, h) do { _Pragma("unroll") for (int n = 0; n < 2; ++n) _Pragma("unroll") for (int k = 0; k < 2; ++k) dst[n][k] = *(const PG8_LAS bf16x8*)(lds + PG8_SB(b, h) + boff + n * 2048 + k * 1024); } while (0)
#define PG8_MMA(ai, bj, At, Bt) do { __builtin_amdgcn_s_setprio(1); _Pragma("unroll") for (int m = 0; m < 4; ++m) _Pragma("unroll") for (int n = 0; n < 2; ++n) _Pragma("unroll") for (int k = 0; k < 2; ++k) \
        acc[ai][bj][m][n] = __builtin_amdgcn_mfma_f32_16x16x32_bf16(Bt[n][k], At[m][k], acc[ai][bj][m][n], 0, 0, 0); __builtin_amdgcn_s_setprio(0); } while (0)
#define PG8_WAIT_V(n) asm volatile("s_waitcnt vmcnt(" #n ")" ::: "memory")
#define PG8_WAIT_L(n) asm volatile("s_waitcnt lgkmcnt(" #n ")" ::: "memory")
#define PG8_BAR __builtin_amdgcn_s_barrier()
#define PG8_SCHED __builtin_amdgcn_sched_barrier(0)
    Unit cur, nxt; int ui = 0;
    if (!S.next(0, cur)) return;
    f32x4 acc[2][2][4][2];
#pragma unroll
    for (int a = 0; a < 2; ++a)
#pragma unroll
        for (int b = 0; b < 2; ++b)
#pragma unroll
            for (int m = 0; m < 4; ++m)
#pragma unroll
                for (int n = 0; n < 2; ++n) acc[a][b][m][n] = (f32x4){0.f, 0.f, 0.f, 0.f};
    bf16x8 At[4][2], B0[2][2], B1[2][2];
    const char* cA = (const char*)gA_ + (size_t)cur.pm * tstep; const char* cB = (const char*)gB_ + (size_t)cur.pn * tstep;
    S.a_ready(cur);
    if constexpr (SP2) {
        PG8_STAGE(PG8_SB(0, 0), cB, voffB); PG8_STAGE(PG8_SB(0, 1), cB + hstep, voffB); PG8_STAGE(PG8_SA(0, 0), cA, voffA); PG8_STAGE(PG8_SA(0, 1), cA + hstep, voffA);
        if (wr == 1) PG8_BAR;
        PG8_WAIT_V(2); PG8_BAR;
        PG8_STAGE(PG8_SB(1, 0), cB + kstep, voffB); PG8_STAGE(PG8_SA(1, 0), cA + kstep, voffA); PG8_STAGE(PG8_SB(1, 1), cB + hstep + kstep, voffB);
        PG8_WAIT_V(6); PG8_BAR;
    } else {
        PG8_STAGE(PG8_SB(0, 0), cB, voffB); PG8_STAGE(PG8_SA(0, 0), cA, voffA); PG8_STAGE(PG8_SB(0, 1), cB + hstep, voffB); PG8_STAGE(PG8_SA(0, 1), cA + hstep, voffA);
        if (wr == 1) PG8_BAR;
        PG8_WAIT_V(4); PG8_BAR;
        PG8_STAGE(PG8_SB(1, 0), cB + kstep, voffB); PG8_STAGE(PG8_SA(1, 0), cA + kstep, voffA); PG8_STAGE(PG8_SB(1, 1), cB + hstep + kstep, voffB);
        PG8_WAIT_V(6); PG8_BAR;
    }
    for (;;) {
        const bool has_next = S.next(ui + 1, nxt);
        const char* nA = has_next ? (const char*)gA_ + (size_t)nxt.pm * tstep : cA; const char* nB = has_next ? (const char*)gB_ + (size_t)nxt.pn * tstep : cB;
        for (int t = 0; t < nt; t += 2) {
            const bool last = (t == nt - 2);
            const char* a1 = cA + (size_t)(t + 1) * kstep;
            const char* a2 = last ? nA : cA + (size_t)(t + 2) * kstep; const char* b2 = last ? nB : cB + (size_t)(t + 2) * kstep;
            const char* a3 = a2 + kstep; const char* b3 = b2 + kstep;
            if (last && has_next) S.a_ready(nxt);
            if constexpr (SP2) {
            PG8_LDB(B0, 0, 0); PG8_LDB(B1, 0, 1); PG8_SCHED; PG8_LDA(At, 0, 0); PG8_STAGE(PG8_SA(1, 1), a1 + hstep, voffA);
            PG8_WAIT_V(8); PG8_WAIT_L(0); PG8_BAR; PG8_MMA(0, 0, At, B0); PG8_MMA(0, 1, At, B1); PG8_BAR; PG8_SCHED;
            PG8_LDA(At, 0, 1); PG8_STAGE(PG8_SB(0, 0), b2, voffB); PG8_STAGE(PG8_SB(0, 1), b2 + hstep, voffB); PG8_STAGE(PG8_SA(0, 0), a2, voffA);
            PG8_WAIT_V(8); PG8_WAIT_L(0); PG8_BAR; PG8_MMA(1, 0, At, B0); PG8_MMA(1, 1, At, B1); PG8_BAR; PG8_SCHED;
            PG8_LDB(B0, 1, 0); PG8_LDB(B1, 1, 1); PG8_SCHED; PG8_LDA(At, 1, 0); PG8_STAGE(PG8_SA(0, 1), a2 + hstep, voffA);
            PG8_WAIT_V(8); PG8_WAIT_L(0); PG8_BAR; PG8_MMA(0, 0, At, B0); PG8_MMA(0, 1, At, B1); PG8_BAR; PG8_SCHED;
            PG8_LDA(At, 1, 1); PG8_STAGE(PG8_SB(1, 0), b3, voffB); PG8_STAGE(PG8_SB(1, 1), b3 + hstep, voffB); PG8_STAGE(PG8_SA(1, 0), a3, voffA);
            PG8_WAIT_V(8); PG8_WAIT_L(0); PG8_BAR; PG8_MMA(1, 0, At, B0); PG8_MMA(1, 1, At, B1); PG8_BAR; PG8_SCHED;
            } else {
            PG8_LDB(B0, 0, 0); PG8_SCHED; PG8_LDA(At, 0, 0); PG8_STAGE(PG8_SA(1, 1), a1 + hstep, voffA);
            PG8_WAIT_L(8); PG8_BAR; PG8_WAIT_L(0); PG8_MMA(0, 0, At, B0); PG8_BAR; PG8_SCHED;
            PG8_LDB(B1, 0, 1); PG8_STAGE(PG8_SB(0, 0), b2, voffB);
            PG8_BAR; PG8_WAIT_L(0); PG8_MMA(0, 1, At, B1); PG8_BAR;
            PG8_LDA(At, 0, 1); PG8_STAGE(PG8_SA(0, 0), a2, voffA);
            PG8_BAR; PG8_WAIT_L(0); PG8_MMA(1, 0, At, B0); PG8_BAR; PG8_SCHED;
            PG8_STAGE(PG8_SB(0, 1), b2 + hstep, voffB);
            PG8_WAIT_V(6); PG8_BAR; PG8_MMA(1, 1, At, B1); PG8_BAR;
            PG8_LDB(B0, 1, 0); PG8_SCHED; PG8_LDA(At, 1, 0); PG8_STAGE(PG8_SA(0, 1), a2 + hstep, voffA);
            PG8_WAIT_L(8); PG8_BAR; PG8_WAIT_L(0); PG8_MMA(0, 0, At, B0); PG8_BAR; PG8_SCHED;
            PG8_LDB(B1, 1, 1); PG8_STAGE(PG8_SB(1, 0), b3, voffB);
            PG8_BAR; PG8_WAIT_L(0); PG8_MMA(0, 1, At, B1); PG8_BAR;
            PG8_LDA(At, 1, 1); PG8_STAGE(PG8_SA(1, 0), a3, voffA);
            PG8_BAR; PG8_WAIT_L(0); PG8_MMA(1, 0, At, B0); PG8_BAR; PG8_SCHED;
            PG8_STAGE(PG8_SB(1, 1), b3 + hstep, voffB);
            PG8_WAIT_V(6); PG8_BAR; PG8_MMA(1, 1, At, B1); PG8_BAR;
            }
        }
        if constexpr (ALIGN_EPI) { if (wr == 0) PG8_BAR; }
        if constexpr (!Epi::AFTER_DRAIN) { E(acc, cur, wr, wc, fr, fq); S.done(cur); }
        if (!has_next) break;
#pragma unroll
        for (int a = 0; a < 2; ++a)
#pragma unroll
            for (int b = 0; b < 2; ++b)
#pragma unroll
                for (int m = 0; m < 4; ++m)
#pragma unroll
                    for (int n = 0; n < 2; ++n) acc[a][b][m][n] = (f32x4){0.f, 0.f, 0.f, 0.f};
        cur = nxt; cA = nA; cB = nB; ++ui;
        if constexpr (ALIGN_EPI) { if (wr == 1) PG8_BAR; }
    }
    PG8_WAIT_V(0);
    if constexpr (!ALIGN_EPI) { if (wr == 0) PG8_BAR; }
    PG8_BAR;
    if constexpr (Epi::AFTER_DRAIN) { E.fused(acc, cur, wr, wc, fr, fq, lds, wid, lane); S.done(cur); }
#undef PG8_SA
#undef PG8_SB
#undef PG8_STAGE
#undef PG8_LDA
#undef PG8_LDB
#undef PG8_MMA
#undef PG8_WAIT_V
#undef PG8_WAIT_L
#undef PG8_BAR
#undef PG8_SCHED
}
}
#define GAS __attribute__((address_space(1)))
#define LAS __attribute__((address_space(3)))
typedef unsigned short bf16;
typedef unsigned v4u __attribute__((ext_vector_type(4)));
typedef float f32x4 __attribute__((ext_vector_type(4)));
typedef short bf16x8 __attribute__((ext_vector_type(8)));
typedef GAS unsigned gu32;
typedef GAS unsigned long long gu64;
#define RLX_AGENT __ATOMIC_RELAXED, __HIP_MEMORY_SCOPE_AGENT
#define LDS_WAIT() asm volatile("s_waitcnt lgkmcnt(0)" ::: "memory")
#define VM_WAIT() asm volatile("s_waitcnt vmcnt(0)" ::: "memory")
__device__ __forceinline__ unsigned long long rt() { return __builtin_amdgcn_s_memrealtime(); }
typedef __bf16 bfx2_t __attribute__((ext_vector_type(2)));
typedef float f32x2_t __attribute__((ext_vector_type(2)));
__device__ __forceinline__ unsigned pk2(float lo, float hi) { return __builtin_bit_cast(unsigned, __builtin_convertvector((f32x2_t){lo, hi}, bfx2_t)); }
__device__ __forceinline__ unsigned f2bf(float f) { return pk2(f, 0.f) & 0xffffu; }

#define XB_TMO      128
#define XB_XCNT(j)  (256  + 64 * (j))
#define XB_XSUB(j)  (1280 + 64 * (j))
#define XB_XGEN(j)  (2304 + 64 * (j))
#define XB_TOP      3328
#define XB_TOPGEN   3392
#define XCD_BAR_WORDS 3456
#define XB_SPIN_CAP (1u << 18)

__device__ __forceinline__ unsigned xb_ld(unsigned* p)              { return __hip_atomic_load(p, __ATOMIC_RELAXED, __HIP_MEMORY_SCOPE_AGENT); }
__device__ __forceinline__ unsigned xb_add(unsigned* p, unsigned v) { return __hip_atomic_fetch_add(p, v, __ATOMIC_RELAXED, __HIP_MEMORY_SCOPE_AGENT); }
__device__ __forceinline__ unsigned xb_xcc_id() { return (unsigned)__builtin_amdgcn_s_getreg((3 << 11) | 20) & 0xFu; }
#define XB_SPIN(cond, bar) do { unsigned _sp = 0; while (cond) { __builtin_amdgcn_s_sleep(1); \
    if ((++_sp & 255u) == 0u) { if (xb_ld(&(bar)[XB_TMO])) break; if (_sp > XB_SPIN_CAP) { atomicAdd(&(bar)[XB_TMO], 1u); break; } } } } while (0)

struct XcdBarrier {
    unsigned* bar; unsigned x;
    volatile LAS unsigned* st;
};

__device__ __forceinline__ XcdBarrier xcd_barrier_post(unsigned* bar, volatile LAS unsigned* st) {
    XcdBarrier b; b.bar = bar; b.x = xb_xcc_id(); b.st = st;
    if (threadIdx.x == 0) (void)xb_add(&bar[XB_XCNT(b.x)], 1u);
    return b;
}
__device__ __forceinline__ void xcd_barrier_complete(unsigned* bar, unsigned x, unsigned& nloc, unsigned& nx) {
    const unsigned G = gridDim.x * gridDim.y * gridDim.z;
    unsigned sum, cnt, mine, sp = 0u;
    for (;;) {
        sum = 0u; cnt = 0u; mine = 0u;
#pragma unroll
        for (unsigned j = 0; j < 16; ++j) { const unsigned c = xb_ld(&bar[XB_XCNT(j)]); sum += c; cnt += (c > 0u) ? 1u : 0u; mine = (j == x) ? c : mine; }
        if (sum == G) break;
        __builtin_amdgcn_s_sleep(1);
        if ((++sp & 255u) == 0u) { if (xb_ld(&bar[XB_TMO])) break; if (sp > XB_SPIN_CAP) { atomicAdd(&bar[XB_TMO], 1u); break; } }
    }
    nloc = mine > 0u ? mine : 1u; nx = cnt > 0u ? cnt : 1u;
}

__device__ __forceinline__ void xcd_barrier(const XcdBarrier& b) {
    asm volatile("s_waitcnt vmcnt(0)" ::: "memory");
    __syncthreads();
    if (threadIdx.x == 0) {
        unsigned* bar = b.bar;
        __builtin_amdgcn_s_waitcnt(0);
        unsigned nloc = b.st[0], nx = b.st[1];
        if (nloc == 0u) { xcd_barrier_complete(bar, b.x, nloc, nx); b.st[0] = nloc; b.st[1] = nx; }
        const unsigned old = xb_add(&bar[XB_XSUB(b.x)], 1u);
        const unsigned gen = old / nloc;
        if (old + 1u == (gen + 1u) * nloc) {
            __builtin_amdgcn_fence(__ATOMIC_RELEASE, "agent");
            asm volatile("s_waitcnt vmcnt(0)" ::: "memory");
            const unsigned og = xb_add(&bar[XB_TOP], 1u);
            const unsigned tg = og / nx;
            if (og + 1u == (tg + 1u) * nx) xb_add(&bar[XB_TOPGEN], 1u);
            else XB_SPIN(xb_ld(&bar[XB_TOPGEN]) == tg, bar);
            __builtin_amdgcn_fence(__ATOMIC_ACQUIRE, "agent");
            xb_add(&bar[XB_XGEN(b.x)], 1u);
            asm volatile("s_waitcnt vmcnt(0)" ::: "memory");
        } else {
            XB_SPIN(xb_ld(&bar[XB_XGEN(b.x)]) == gen, bar);
            __builtin_amdgcn_fence(__ATOMIC_ACQUIRE, "agent");
            asm volatile("s_waitcnt vmcnt(0)" ::: "memory");
        }
    }
    __syncthreads();
}
template <int CTRL> __device__ __forceinline__ float dpp_mov(float x) { return __int_as_float(__builtin_amdgcn_update_dpp(0, __float_as_int(x), CTRL, 0xF, 0xF, true)); }
__device__ __forceinline__ float sum_xor16(float x) { auto r = __builtin_amdgcn_permlane16_swap(__float_as_uint(x), __float_as_uint(x), false, false); return __uint_as_float(r[0]) + __uint_as_float(r[1]); }
__device__ __forceinline__ float sum_xor32(float x) { auto r = __builtin_amdgcn_permlane32_swap(__float_as_uint(x), __float_as_uint(x), false, false); return __uint_as_float(r[0]) + __uint_as_float(r[1]); }
__device__ __forceinline__ float wave_sum(float v) {
    v += dpp_mov<0xB1>(v); v += dpp_mov<0x4E>(v); v += dpp_mov<0x141>(v); v += dpp_mov<0x140>(v);
    return sum_xor32(sum_xor16(v));
}
__device__ __forceinline__ void transpose64_item(const float* W, int K, int N, bf16* WT, LAS unsigned char* img, int item, int lane, const float* gk) {
    const int nblk = (N + 63) >> 6, kb = item / nblk, nb = item - kb * nblk, k0 = 64 * kb, n0 = 64 * nb;
    const int kl = lane >> 4, n4 = (lane & 15) * 4; const bool live = n0 + n4 < N;
    f32x4 v[16];
#pragma unroll
    for (int j = 0; j < 16; ++j) v[j] = live ? *(const GAS f32x4*)(W + (size_t)(k0 + 4 * j + kl) * N + n0 + n4) : (f32x4){0.f, 0.f, 0.f, 0.f};
#pragma unroll
    for (int j = 0; j < 16; ++j) { const int kk = 4 * j + kl; const float g = gk ? gk[k0 + kk] : 1.0f; const f32x4 x = v[j] * g;
        LAS unsigned char* p = img + n4 * 132 + kk * 2;
        *(LAS unsigned short*)(p) = (unsigned short)f2bf(x.x); *(LAS unsigned short*)(p + 132) = (unsigned short)f2bf(x.y); *(LAS unsigned short*)(p + 264) = (unsigned short)f2bf(x.z); *(LAS unsigned short*)(p + 396) = (unsigned short)f2bf(x.w); }
    LDS_WAIT(); asm volatile("" ::: "memory");
    const int c = lane & 7;
#pragma unroll
    for (int jj = 0; jj < 8; ++jj) { const int n = (lane >> 3) + 8 * jj;
        const LAS unsigned* q = (const LAS unsigned*)(img + n * 132 + c * 16); v4u o; o.x = q[0]; o.y = q[1]; o.z = q[2]; o.w = q[3];
        if (n0 + n < N) *(GAS v4u*)(WT + (size_t)(n0 + n) * K + k0 + 8 * c) = o; }
    LDS_WAIT(); asm volatile("" ::: "memory");
}
constexpr int NWAVES = 8;
constexpr int BATCH = 16, T = 2048, D = 2048, M = BATCH * T, DEPTH = 4, FF = 8192;
constexpr int EVEN_N = 6432, ZP = 6656;
constexpr int ZC_Q = 0, ZC_K = 1024, ZC_V = 2048, ZC_R = 3072, ZC_RK = 4096, ZC_RV = 5120, ZC_XW = 6144, ZC_XA = 6208, ZC_XG = 6272;
constexpr int RWS = 3360;
constexpr int NPH = 33;

constexpr size_t MiB = 1u << 20;
constexpr size_t WS_CTL = 0, CTL_ZERO_BYTES = 1 * MiB;
constexpr size_t WS_WA = 2 * MiB;
constexpr size_t WS_WB = 28 * MiB;
constexpr size_t WS_W1 = 36 * MiB;
constexpr size_t WS_W2 = 68 * MiB;
constexpr size_t WS_H = 104 * MiB;
constexpr size_t WS_BIG = 232 * MiB;
constexpr size_t WS_SSQ = 101 * MiB;
constexpr size_t WS_XB = 744 * MiB;
constexpr size_t WS_END = 872 * MiB;
constexpr int CW_BAR = 4096;

constexpr int RING_BYTES = 131072, LDSCTL_OFF = RING_BYTES, MISC_OFF = LDSCTL_OFF + 320, LDS_BYTES = 147456;

struct Args { const float* in[25]; float* out; unsigned char* ws; int ph_lo, ph_hi; };

__device__ __forceinline__ v4u zero4() { unsigned z; asm volatile("v_mov_b32 %0, 0" : "=v"(z)); return (v4u){z, z, z, z}; }
__device__ __forceinline__ float bf2f(bf16 h) { return __uint_as_float((unsigned)h << 16); }
__device__ __forceinline__ float bflo(unsigned w) { return __uint_as_float(w << 16); }
__device__ __forceinline__ float bfhi(unsigned w) { return __uint_as_float(w & 0xffff0000u); }

__device__ __forceinline__ void rms_row_out(const bf16* xrow, const float* g, float* orow, int lane) {
    const GAS v4u* xr = (const GAS v4u*)xrow + lane; const GAS f32x4* gr = (const GAS f32x4*)g + 2 * lane; GAS f32x4* o = (GAS f32x4*)orow + 2 * lane;
    f32x4 v[8]; float s = 0.f;
#pragma unroll
    for (int j = 0; j < 4; ++j) { const v4u w = xr[64 * j]; v[2 * j] = (f32x4){bflo(w.x), bfhi(w.x), bflo(w.y), bfhi(w.y)}; v[2 * j + 1] = (f32x4){bflo(w.z), bfhi(w.z), bflo(w.w), bfhi(w.w)};
        s += ((v[2 * j].x * v[2 * j].x + v[2 * j].y * v[2 * j].y) + (v[2 * j].z * v[2 * j].z + v[2 * j].w * v[2 * j].w)) + ((v[2 * j + 1].x * v[2 * j + 1].x + v[2 * j + 1].y * v[2 * j + 1].y) + (v[2 * j + 1].z * v[2 * j + 1].z + v[2 * j + 1].w * v[2 * j + 1].w)); }
    const float r = 1.0f / sqrtf(wave_sum(s) * (1.f / D) + 1e-6f);
#pragma unroll
    for (int j = 0; j < 4; ++j) { o[128 * j] = v[2 * j] * r * gr[128 * j]; o[128 * j + 1] = v[2 * j + 1] * r * gr[128 * j + 1]; }
}
__device__ __forceinline__ void prep_phase(const float* Win, int Nin, const float* Wout, const float* w1, const float* w2, const float* x0, const float* gmix, const float* gffn, unsigned char* ws, bool even, LAS unsigned char* lds, int wave, int lane, int tid, int G) {
    const int gw = blockIdx.x * NWAVES + wave, NGW = G * NWAVES;
    bf16* WA = (bf16*)(ws + WS_WA); bf16* WB = (bf16*)(ws + WS_WB); bf16* W1 = (bf16*)(ws + WS_W1); bf16* W2 = (bf16*)(ws + WS_W2);
    const int I_in = (D / 64) * ((Nin + 63) / 64), I_out = (D / 64) * (D / 64), I_1 = (D / 64) * (FF / 64), I_2 = (FF / 64) * (D / 64);
    LAS unsigned char* const img = lds + wave * 16384;
    const int total = I_in + I_out + I_1 + I_2;
    for (int it = gw; it < total; it += NGW) {
        int r = it;
        if (r < I_in) { transpose64_item(Win, D, Nin, WA, img, r, lane, gmix); continue; } r -= I_in;
        if (r < I_out) { transpose64_item(Wout, D, D, WB, img, r, lane, nullptr); continue; } r -= I_out;
        if (r < I_1) { transpose64_item(w1, D, FF, W1, img, r, lane, gffn); continue; } r -= I_1;
        transpose64_item(w2, FF, D, W2, img, r, lane, nullptr);
    }
    if (even) {
        GAS v4u* p = (GAS v4u*)(WA + (size_t)EVEN_N * D); const int n16 = (ZP - EVEN_N) * D * 2 / 16;
        for (int k = blockIdx.x * (NWAVES * 64) + tid; k < n16; k += G * NWAVES * 64) p[k] = zero4();
    }
    if (x0) {
        bf16* XB = (bf16*)(ws + WS_XB); float* SSQ = (float*)(ws + WS_SSQ);
        for (int m = gw; m < M; m += NGW) {
            const GAS f32x4* xr = (const GAS f32x4*)(x0 + (size_t)m * D) + lane; GAS unsigned long long* o8 = (GAS unsigned long long*)(XB + (size_t)m * D) + lane;
            float s = 0.f;
#pragma unroll
            for (int j = 0; j < 8; ++j) { const f32x4 v = xr[64 * j]; s += (v.x * v.x + v.y * v.y) + (v.z * v.z + v.w * v.w);
                o8[64 * j] = (unsigned long long)pk2(v.x, v.y) | ((unsigned long long)pk2(v.z, v.w) << 32); }
            s = wave_sum(s);
            if (lane < 8) SSQ[(size_t)m * 8 + lane] = lane == 0 ? s : 0.f;
        }
    }
}

__device__ __forceinline__ float rl(float x, int j) { return __int_as_float(__builtin_amdgcn_readlane(__float_as_int(x), j)); }

namespace rw {
constexpr int CH = 32;
constexpr int L_X = 0, L_RKV = 32768, L_DAG = 57344, L_ACT = 81920, L_SC = 101888, L_PREV = 102400, L_MU = 104320, L_CST = 106240;
constexpr int ACT_WS = 144, ACT_GS = 336;
constexpr int L_ACTW = L_ACT, L_ACTA = L_ACT + 32 * ACT_WS, L_ACTG = L_ACT + 64 * ACT_WS, L_Y = L_ACT;
constexpr float LOG2E = 1.4426950408889634f, LN2 = 0.6931471805599453f;
typedef float f32x2 __attribute__((ext_vector_type(2)));
__device__ __forceinline__ float ex2(float x) { return __builtin_amdgcn_exp2f(x); }
__device__ __forceinline__ float lg2(float x) { return __builtin_amdgcn_logf(x); }
__device__ __forceinline__ float rcp(float x) { return __builtin_amdgcn_rcpf(x); }
__device__ __forceinline__ float sigmoid_f(float x) { return rcp(1.0f + ex2(-x * LOG2E)); }
template <int CTRL> __device__ __forceinline__ float dppf(float x) { return __int_as_float(__builtin_amdgcn_update_dpp(0, __float_as_int(x), CTRL, 0xF, 0xF, true)); }
__device__ __forceinline__ float row16_sum(float x) { x += dppf<0xB1>(x); x += dppf<0x4E>(x); x += dppf<0x141>(x); x += dppf<0x140>(x); return x; }
#define FMUL(a, b) ({ float d_; asm("v_mul_f32 %0, %1, %2" : "=v"(d_) : "v"(a), "v"(b)); d_; })
#define FFMA(a, b, c) ({ float d_; asm("v_fma_f32 %0, %1, %2, %3" : "=v"(d_) : "v"(a), "v"(b), "v"(c)); d_; })
#define RW_BAR() asm volatile("s_waitcnt lgkmcnt(0)\n\ts_barrier" ::: "memory")
struct Params { const float *mu, *w_up, *w0, *a_up, *a0, *g_up, *k_k, *k_a, *r_k, *lnx_w, *lnx_b; };

__device__ __forceinline__ bf16x8 load_bfrag(const float* W, int k0, int col) {
    float w[8];
#pragma unroll
    for (int j = 0; j < 8; ++j) w[j] = W[(size_t)(k0 + j) * 1024 + col];
    v4u p; p.x = pk2(w[0], w[1]); p.y = pk2(w[2], w[3]); p.z = pk2(w[4], w[5]); p.w = pk2(w[6], w[7]);
    return __builtin_bit_cast(bf16x8, p);
}
__device__ __forceinline__ int colbase(int chunk, int hc) { return chunk < 24 ? ZC_R + (chunk >> 3) * 1024 + hc + 8 * (chunk & 7) : ZC_XW + 8 * (chunk - 24); }
}
namespace rw2 {
constexpr int CH = 16;
constexpr int L_X = 0, L_RKV = 15360, L_E1 = 27648, L_ACT = 44032, L_OPS = 54016, L_BKT = 63232, L_SVT = 68352, L_LB = 73472, L_LKA = 74496, L_LRA = 75776, L_S0 = 77056,
              L_RHS = 86272, L_Y = 90368, L_SC = 94464, L_PREV = 94720, L_MU = 96640, L_CST = 98560;
constexpr int ACT_WS = 144, ACT_GS = 336, OPS = 144, T32S = 80;
constexpr int L_ACTW = L_ACT, L_ACTA = L_ACT + 16 * ACT_WS, L_ACTG = L_ACT + 32 * ACT_WS;
constexpr int L_KT = L_OPS, L_BT = L_OPS + 2304, L_KK = L_OPS + 4608, L_RT = L_OPS + 6912;
using rw::LOG2E; using rw::LN2; using rw::ex2; using rw::lg2; using rw::rcp; using rw::sigmoid_f; using rw::row16_sum; using rw::load_bfrag; using rw::colbase; using rw::Params;
#define RW2_BAR() asm volatile("s_waitcnt lgkmcnt(0)\n\ts_barrier" ::: "memory")
__device__ __forceinline__ bf16x8 ldfrag(const LAS unsigned char* p) { return *(const LAS bf16x8*)p; }
__device__ __forceinline__ void st16(LAS unsigned char* p, float x) { *(LAS unsigned short*)p = (unsigned short)f2bf(x); }
}
namespace rw12 {
typedef short s16x4 __attribute__((ext_vector_type(4)));
typedef __bf16 bfx4 __attribute__((ext_vector_type(4)));
__device__ __forceinline__ s16x4 pk4(const f32x4 x) { return __builtin_bit_cast(s16x4, __builtin_convertvector(x, bfx4)); }
constexpr int CH = 16, NCH = T / CH;
constexpr int A_RK = 0  , A_E1 = 12288  , A_ACT = 28672, A_MU = 38656, A_CST = 40576, A_END = 41856;
constexpr int H_OPS = 0, H_BKT = 9216, H_SVT = 14336, H_VF = 19456, H_GV = 23552, H_DC = 27648, H_SC = 27904, H_SIZE = 28160;
constexpr int H_BASE = A_END;
constexpr int B_S0 = H_BASE + 2 * H_SIZE, B_RHS = B_S0 + 9216  , B_Y = B_RHS + 4096, B_RK2 = B_Y + 4096  , B_END = B_RK2 + 12288;
static_assert(B_END <= 131072, "RWKV LDS map");
constexpr int ACT_WS = 144, ACT_GS = 336, OPS = 144, T32S = 80;
constexpr int A_ACTW = A_ACT, A_ACTA = A_ACT + 16 * ACT_WS, A_ACTG = A_ACT + 32 * ACT_WS;
using rw::LOG2E; using rw::LN2; using rw::ex2; using rw::lg2; using rw::rcp; using rw::sigmoid_f; using rw::row16_sum; using rw::load_bfrag; using rw::colbase; using rw::Params;
using rw2::ldfrag; using rw2::st16;
#define RW12_BAR() asm volatile("s_waitcnt lgkmcnt(0)\n\ts_barrier" ::: "memory")

__device__ __forceinline__ void rwkv_phase(const Params p, const bf16* Z, bf16* O, LAS unsigned char* lds, int tid_in, int u0, int ustep) {
    const int wave = __builtin_amdgcn_readfirstlane(tid_in >> 6);
    LAS float* E1 = (LAS float*)(lds + A_E1); LAS float* CUM = E1 + 1024; LAS float* AV = E1 + 2048; LAS float* GVa = E1 + 3072;
    LAS float* MU = (LAS float*)(lds + A_MU); LAS float* CST = (LAS float*)(lds + A_CST);
    LAS float* Yf = (LAS float*)(lds + B_Y); LAS float* Yf1 = (LAS float*)(lds + B_RHS);
    for (int u = u0; u < BATCH * 16; u += ustep) {
        const int b = u >> 4, h = u & 15, hc = h * 64;
        int tid = tid_in; asm volatile("" : "+v"(tid)); int lane = tid & 63;
        const int ct = wave & 3;
        bf16x8 Bw[2], Ba[2], Bg[5];
        { const int fn = lane & 15, fq = lane >> 4;
          if (wave < 4) {
#pragma unroll
              for (int ks = 0; ks < 2; ++ks) { Bw[ks] = load_bfrag(p.w_up, 32 * ks + 8 * fq, hc + 16 * ct + fn); Ba[ks] = load_bfrag(p.a_up, 32 * ks + 8 * fq, hc + 16 * ct + fn); }
          } else {
#pragma unroll
              for (int ks = 0; ks < 5; ++ks) Bg[ks] = load_bfrag(p.g_up, 32 * ks + 8 * fq, hc + 16 * ct + fn);
          } }
        const float w0c = p.w0[hc + 16 * ct + (lane & 15)], a0c = p.a0[hc + 16 * ct + (lane & 15)];
        if (tid < 480) { const int chunk = tid >> 3, j = tid & 7; const int mi = chunk < 24 ? (chunk >> 3) * 1024 + hc + 8 * (chunk & 7) + j : 3072 + 8 * (chunk - 24) + j; MU[tid] = p.mu[mi]; }
        if (tid < 320) { const int a = tid >> 6, j = tid & 63; const float* src = a == 0 ? p.k_k : a == 1 ? p.k_a : a == 2 ? p.r_k : a == 3 ? p.lnx_w : p.lnx_b; CST[tid] = src[hc + j]; }
        for (int q = tid; q < 576 + 640; q += NWAVES * 64) {
            const int off = q < 576 ? B_S0 + q * 16 : (q < 896 ? H_BASE + H_SVT + (q - 576) * 16 : H_BASE + H_SIZE + H_SVT + (q - 896) * 16); *(LAS v4u*)(lds + off) = zero4(); }
        f32x4 sacc0 = {0.f, 0.f, 0.f, 0.f}, sacc1 = {0.f, 0.f, 0.f, 0.f};
        v4u own[2], prv[2];
        const bf16* zb = Z + (size_t)(b * T) * ZP;
#define RW12_ITEMS() int it_t[2], it_c[2]; bool it_ok[2]; \
        if (tid < 384) { it_t[0] = tid / 24; it_c[0] = tid - 24 * it_t[0]; } else { it_t[0] = (tid - 384) >> 3; it_c[0] = 24 + (tid & 7); } it_ok[0] = true; \
        if (tid < 128) { it_t[1] = tid >> 3; it_c[1] = 32 + (tid & 7); it_ok[1] = true; } else { const int q_ = tid - 128; it_t[1] = q_ / 20; it_c[1] = 40 + q_ - 20 * it_t[1]; it_ok[1] = tid < 448; if (!it_ok[1]) { it_t[1] = 0; it_c[1] = 40; } }
#define RW12_FETCH(cc) _Pragma("unroll") for (int i = 0; i < 2; ++i) { const int ta = (cc) * CH + it_t[i]; const int cb = colbase(it_c[i], hc); \
            own[i] = it_ok[i] ? *(const GAS v4u*)(zb + (size_t)ta * ZP + cb) : zero4(); prv[i] = (it_ok[i] && ta > 0) ? *(const GAS v4u*)(zb + (size_t)(ta - 1) * ZP + cb) : zero4(); }
        { RW12_ITEMS(); RW12_FETCH(0); }
        f32x4 yacc = {0.f, 0.f, 0.f, 0.f}, racc = {0.f, 0.f, 0.f, 0.f};
        RW12_BAR();
        for (int it = -1; it <= NCH + 1; ++it) {
            lane = tid & 63;
            const int fn = lane & 15, fq = lane >> 4, c4 = (tid & 15) * 4, tq = tid >> 4;
            const bool doA = it >= 0 && it < NCH, doB = it >= 1 && it <= NCH, doP2 = it + 1 < NCH, doPost = it >= 2;
            LAS unsigned char* const HA = lds + H_BASE + (it & 1) * H_SIZE;
            LAS unsigned char* const HB = lds + H_BASE + ((it & 1) ^ 1) * H_SIZE;
            if (doA) {
                if (wave < 4) {
                    f32x4 aw = {0.f, 0.f, 0.f, 0.f}, aa = aw;
#pragma unroll
                    for (int ks = 0; ks < 2; ++ks) {
                        aw = __builtin_amdgcn_mfma_f32_16x16x32_bf16(ldfrag(lds + A_ACTW + fn * ACT_WS + (32 * ks + 8 * fq) * 2), Bw[ks], aw, 0, 0, 0);
                        aa = __builtin_amdgcn_mfma_f32_16x16x32_bf16(ldfrag(lds + A_ACTA + fn * ACT_WS + (32 * ks + 8 * fq) * 2), Ba[ks], aa, 0, 0, 0); }
                    float e[4], cs[4];
#pragma unroll
                    for (int r = 0; r < 4; ++r) e[r] = 0.6065306597126334f * rcp(1.0f + ex2(-(aw[r] + w0c) * LOG2E));
                    cs[0] = e[0]; cs[1] = cs[0] + e[1]; cs[2] = cs[1] + e[2]; cs[3] = cs[2] + e[3];
                    const float run = cs[3];
                    float offs;
                    { auto r16 = __builtin_amdgcn_permlane16_swap(__float_as_uint(run), __float_as_uint(run), false, false);
                      const float ev = __uint_as_float(r16[0]), od = __uint_as_float(r16[1]);
                      const float ps = ev + od; auto r32 = __builtin_amdgcn_permlane32_swap(__float_as_uint(ps), __float_as_uint(ps), false, false);
                      offs = ((fq & 1) ? ev : 0.f) + ((fq & 2) ? __uint_as_float(r32[0]) : 0.f); }
#pragma unroll
                    for (int r = 0; r < 4; ++r) { const int idx = (4 * fq + r) * 64 + 16 * ct + fn; E1[idx] = e[r]; CUM[idx] = cs[r] + offs; AV[idx] = sigmoid_f(aa[r] + a0c); }
                } else {
                    f32x4 ag = {0.f, 0.f, 0.f, 0.f};
#pragma unroll
                    for (int ks = 0; ks < 5; ++ks) ag = __builtin_amdgcn_mfma_f32_16x16x32_bf16(ldfrag(lds + A_ACTG + fn * ACT_GS + (32 * ks + 8 * fq) * 2), Bg[ks], ag, 0, 0, 0);
                    #pragma unroll
                    for (int r = 0; r < 4; ++r) GVa[(4 * fq + r) * 64 + 16 * ct + fn] = ag[r];
                }
            }
            if (doB) {
                if (wave >= 4) {
                    const int vt = wave - 4;
                    f32x4 gkt = {0.f, 0.f, 0.f, 0.f}, grbt = gkt, grkt = gkt, gb = gkt, gbt = gkt; yacc = gkt; racc = gkt;
#pragma unroll
                    for (int ks = 0; ks < 2; ++ks) {
                        const bf16x8 fkt = ldfrag(HB + H_OPS + fn * OPS + (32 * ks + 8 * fq) * 2), fbt = ldfrag(HB + H_OPS + 2304 + fn * OPS + (32 * ks + 8 * fq) * 2);
                        const bf16x8 fkk = ldfrag(HB + H_OPS + 4608 + fn * OPS + (32 * ks + 8 * fq) * 2), frt = ldfrag(HB + H_OPS + 6912 + fn * OPS + (32 * ks + 8 * fq) * 2);
                        const bf16x8 sb_ = ldfrag(lds + B_S0 + (16 * vt + fn) * OPS + (32 * ks + 8 * fq) * 2);
                        gkt = __builtin_amdgcn_mfma_f32_16x16x32_bf16(fkk, fkt, gkt, 0, 0, 0);
                        grbt = __builtin_amdgcn_mfma_f32_16x16x32_bf16(fbt, frt, grbt, 0, 0, 0);
                        grkt = __builtin_amdgcn_mfma_f32_16x16x32_bf16(fkk, frt, grkt, 0, 0, 0);
                        yacc = __builtin_amdgcn_mfma_f32_16x16x32_bf16(frt, sb_, yacc, 0, 0, 0);
                        racc = __builtin_amdgcn_mfma_f32_16x16x32_bf16(fkt, sb_, racc, 0, 0, 0);
                        gb = __builtin_amdgcn_mfma_f32_16x16x32_bf16(fkt, fbt, gb, 0, 0, 0);
                        gbt = __builtin_amdgcn_mfma_f32_16x16x32_bf16(fbt, fkt, gbt, 0, 0, 0); }
                    racc = -racc;
                    f32x4 lkA, lrbA, lrkA;
#pragma unroll
                    for (int r = 0; r < 4; ++r) { const int i_ = 4 * fq + r; lkA[r] = (i_ < fn) ? -gkt[r] : 0.f; lrbA[r] = (i_ <= fn) ? grbt[r] : 0.f; lrkA[r] = (i_ <= fn) ? grkt[r] : 0.f; }
                    const s16x4 vB = *(const LAS s16x4*)(HB + H_SVT + (16 * vt + fn) * T32S + 32 + 8 * fq);
                    racc = __builtin_amdgcn_mfma_f32_16x16x16bf16_1k(pk4(lkA), vB, racc, 0, 0, 0);
                    { f32x4 Lm, Lt, Im;
#pragma unroll
                      for (int r = 0; r < 4; ++r) { const int t = 4 * fq + r; Lm[r] = (fn < t) ? gb[r] : 0.f; Lt[r] = (t < fn) ? gbt[r] : 0.f; Im[r] = (t == fn) ? 1.f : 0.f; }
                      const f32x4 z4 = {0.f, 0.f, 0.f, 0.f};
#define RW12_MM(MT, N) __builtin_amdgcn_mfma_f32_16x16x16bf16_1k(pk4(MT), pk4(N), z4, 0, 0, 0)
                      const f32x4 L2 = RW12_MM(Lt, Lm), L2t = RW12_MM(Lm, Lt);
                      const f32x4 L4 = RW12_MM(L2t, L2), L4t = RW12_MM(L2, L2t);
                      const f32x4 L8 = RW12_MM(L4t, L4);
                      const f32x4 F = RW12_MM(Im + L4t, Im + L8);
                      const f32x4 E = RW12_MM(Im + L2t, F) - Im;
                      const f32x4 ImLt = Im - Lt;
                      const f32x4 TT = ImLt + RW12_MM(E, ImLt);
#undef RW12_MM
                      f32x4 sa = z4;
#pragma unroll
                      for (int r = 0; r < 4; ++r) sa = __builtin_amdgcn_mfma_f32_16x16x4f32(TT[r], racc[r], sa, 0, 0, 0);
                      const s16x4 saB = pk4(sa);
                      yacc = __builtin_amdgcn_mfma_f32_16x16x16bf16_1k(pk4(lrbA), saB, yacc, 0, 0, 0);
                      yacc = __builtin_amdgcn_mfma_f32_16x16x16bf16_1k(pk4(lrkA), vB, yacc, 0, 0, 0);
                      LAS float* Yw = (it & 1) ? Yf1 : Yf;
#pragma unroll
                      for (int r = 0; r < 4; ++r) Yw[(4 * fq + r) * 64 + 16 * vt + fn] = yacc[r];
                      *(LAS s16x4*)(HB + H_SVT + (16 * vt + fn) * T32S + 8 * fq) = saB; }
                }
            }
            if (doPost && wave < 4) {
                const f32x4 lw = *(const LAS f32x4*)(CST + 192 + c4), lb = *(const LAS f32x4*)(CST + 256 + c4);
                const f32x4 y4 = *(const LAS f32x4*)(((it & 1) ? Yf : Yf1) + tq * 64 + c4), v4 = *(const LAS f32x4*)((LAS float*)(HA + H_VF) + tq * 64 + c4), g4 = *(const LAS f32x4*)((LAS float*)(HA + H_GV) + tq * 64 + c4);
                const float bo = ((const LAS float*)(HA + H_SC))[tq];
                const float mean = row16_sum((y4.x + y4.y) + (y4.z + y4.w)) * (1.f / 64.f);
                const f32x4 d = y4 - mean;
                const float var = row16_sum((d.x * d.x + d.y * d.y) + (d.z * d.z + d.w * d.w)) * (1.f / 64.f);
                const float rstd = __builtin_amdgcn_rsqf(var + 64e-5f);
                const f32x4 o = (d * rstd * lw + lb + v4 * bo) * g4;
                GAS unsigned long long* dst = (GAS unsigned long long*)(O + (size_t)(b * T + (it - 2) * CH + tq) * D + 1024 + hc + c4);
                *dst = (unsigned long long)pk2(o.x, o.y) | ((unsigned long long)pk2(o.z, o.w) << 32);
            }
            RW12_BAR();
            if (doA && wave < 4) {
                const LAS float* Rf = (const LAS float*)(lds + ((it & 1) ? B_RK2 : A_RK)); const LAS float* Kf = Rf + 1024; const LAS float* Vfa = Rf + 2048;
                const f32x4 kkc = *(const LAS f32x4*)(CST + c4), kac = *(const LAS f32x4*)(CST + 64 + c4), rkc = *(const LAS f32x4*)(CST + 128 + c4);
                const f32x4 k4 = *(const LAS f32x4*)(Kf + tq * 64 + c4), r4 = *(const LAS f32x4*)(Rf + tq * 64 + c4), v4 = *(const LAS f32x4*)(Vfa + tq * 64 + c4);
                *(LAS f32x4*)((LAS float*)(HA + H_VF) + tq * 64 + c4) = v4; *(LAS f32x4*)((LAS float*)(HA + H_GV) + tq * 64 + c4) = *(const LAS f32x4*)(GVa + tq * 64 + c4);
                const f32x4 e4 = *(const LAS f32x4*)(E1 + tq * 64 + c4), cm = *(const LAS f32x4*)(CUM + tq * 64 + c4), a4 = *(const LAS f32x4*)(AV + tq * 64 + c4);
                f32x4 kk = k4 * kkc;
                const float ss = row16_sum((kk.x * kk.x + kk.y * kk.y) + (kk.z * kk.z + kk.w * kk.w));
                const float inv = ss > 1e-24f ? __builtin_amdgcn_rsqf(ss) : 1e12f;
                kk = kk * inv;
                const f32x4 kmod = k4 * (1.0f + (a4 - 1.0f) * kac);
                const f32x4 bv = kk * a4;
                const f32x4 bo4 = kmod * r4 * rkc;
                const float bo = row16_sum((bo4.x + bo4.y) + (bo4.z + bo4.w));
                if ((tid & 15) == 0) ((LAS float*)(HA + H_SC))[tq] = bo;
                f32x4 em, ep, emx;
#pragma unroll
                for (int j = 0; j < 4; ++j) { em[j] = ex2(-cm[j] * LOG2E); ep[j] = rcp(em[j]); emx[j] = ex2((e4[j] - cm[j]) * LOG2E); }
                if (tq == CH - 1) *(LAS f32x4*)((LAS float*)(HA + H_DC) + c4) = em;
                const f32x4 okt = kk * emx, obt = bv * ep, okk = kmod * ep, ort = r4 * em;
                typedef unsigned u32x2 __attribute__((ext_vector_type(2)));
                *(LAS u32x2*)(HA + H_OPS + tq * OPS + c4 * 2) = (u32x2){pk2(okt.x, okt.y), pk2(okt.z, okt.w)};
                *(LAS u32x2*)(HA + H_OPS + 2304 + tq * OPS + c4 * 2) = (u32x2){pk2(obt.x, obt.y), pk2(obt.z, obt.w)};
                *(LAS u32x2*)(HA + H_OPS + 4608 + tq * OPS + c4 * 2) = (u32x2){pk2(okk.x, okk.y), pk2(okk.z, okk.w)};
                *(LAS u32x2*)(HA + H_OPS + 6912 + tq * OPS + c4 * 2) = (u32x2){pk2(ort.x, ort.y), pk2(ort.z, ort.w)};
#pragma unroll
                for (int j = 0; j < 4; ++j) { st16(HA + H_BKT + (c4 + j) * T32S + tq * 2, obt[j]); st16(HA + H_BKT + (c4 + j) * T32S + 32 + tq * 2, okk[j]); st16(HA + H_SVT + (c4 + j) * T32S + 32 + tq * 2, v4[j]); }
            }
            if (doB) {
                const int id0 = 2 * wave, vt = id0 >> 2, kt0 = id0 & 3;
                const bf16x8 af = ldfrag(HB + H_SVT + (16 * vt + fn) * T32S + fq * 16);
                const LAS float* DC = (const LAS float*)(HB + H_DC);
                sacc0 = __builtin_amdgcn_mfma_f32_16x16x32_bf16(af, ldfrag(HB + H_BKT + (16 * kt0 + fn) * T32S + fq * 16), sacc0, 0, 0, 0);
                sacc1 = __builtin_amdgcn_mfma_f32_16x16x32_bf16(af, ldfrag(HB + H_BKT + (16 * kt0 + 16 + fn) * T32S + fq * 16), sacc1, 0, 0, 0);
                sacc0 = sacc0 * DC[16 * kt0 + fn]; sacc1 = sacc1 * DC[16 * kt0 + 16 + fn];
#pragma unroll
                for (int r = 0; r < 4; ++r) { st16(lds + B_S0 + (16 * vt + 4 * fq + r) * OPS + (16 * kt0 + fn) * 2, sacc0[r]); st16(lds + B_S0 + (16 * vt + 4 * fq + r) * OPS + (16 * kt0 + 16 + fn) * 2, sacc1[r]); }
            }
            if (doP2) {
                LAS float* Rf = (LAS float*)(lds + ((it & 1) ? A_RK : B_RK2)); LAS float* Vfa = Rf + 2048;
                RW12_ITEMS();
#pragma unroll
                for (int i = 0; i < 2; ++i) if (it_ok[i]) {
                    const int t = it_t[i], chunk = it_c[i];
                    const f32x4 m0 = *(const LAS f32x4*)(MU + chunk * 8), m1 = *(const LAS f32x4*)(MU + chunk * 8 + 4);
                    float x[8];
                    { const unsigned cw[4] = {own[i].x, own[i].y, own[i].z, own[i].w}; const unsigned pw[4] = {prv[i].x, prv[i].y, prv[i].z, prv[i].w}; const float mm[8] = {m0.x, m0.y, m0.z, m0.w, m1.x, m1.y, m1.z, m1.w};
#pragma unroll
                      for (int j = 0; j < 4; ++j) { const float a0 = bflo(cw[j]), a1 = bfhi(cw[j]), q0 = bflo(pw[j]), q1 = bfhi(pw[j]);
                          x[2 * j] = a0 + (q0 - a0) * mm[2 * j]; x[2 * j + 1] = a1 + (q1 - a1) * mm[2 * j + 1]; } }
                    if (chunk < 24) { LAS float* dst = (chunk < 16 ? Rf + (chunk >> 3) * 1024 : Vfa) + t * 64 + 8 * (chunk & 7);
                        *(LAS f32x4*)dst = (f32x4){x[0], x[1], x[2], x[3]}; *(LAS f32x4*)(dst + 4) = (f32x4){x[4], x[5], x[6], x[7]}; }
                    else {
                        float y[8];
                        if (chunk < 32) {
#pragma unroll
                            for (int j = 0; j < 8; ++j) y[j] = 1.0f - 2.0f * rcp(ex2(x[j] * (2.0f * LOG2E)) + 1.0f);
                        } else if (chunk < 40) {
#pragma unroll
                            for (int j = 0; j < 8; ++j) y[j] = x[j];
                        } else {
#pragma unroll
                            for (int j = 0; j < 8; ++j) y[j] = sigmoid_f(x[j]);
                        }
                        v4u o; o.x = pk2(y[0], y[1]); o.y = pk2(y[2], y[3]); o.z = pk2(y[4], y[5]); o.w = pk2(y[6], y[7]);
                        const int off = chunk < 32 ? A_ACTW + t * ACT_WS + (chunk - 24) * 16 : chunk < 40 ? A_ACTA + t * ACT_WS + (chunk - 32) * 16 : A_ACTG + t * ACT_GS + (chunk - 40) * 16;
                        *(LAS v4u*)(lds + off) = o;
                    }
                }
                if (it + 2 < NCH) { RW12_FETCH(it + 2); }
            }
            RW12_BAR();
        }
    }
}
}
namespace sb {
using f32x16 = __attribute__((ext_vector_type(16))) float;
using s16x4 = __attribute__((ext_vector_type(4))) short;
constexpr int NSLOT = 3, SLOTB = 16384;
constexpr int LDS_K = 0, LDS_V = NSLOT * SLOTB, LDS_OST = 2 * NSLOT * SLOTB, LDS_CNT = LDS_OST + 8 * 4096;
constexpr float QSCALE = 0.125f * 1.4426950408889634f;
__device__ __forceinline__ int crow(int r, int hi) { return (r & 3) + 8 * (r >> 2) + 4 * hi; }
__device__ __forceinline__ void glds16(const void* gsrc, unsigned lds_dst) { unsigned keep;
    asm volatile("s_mov_b32 %0, m0\n\ts_mov_b32 m0, %2\n\ts_nop 0\n\tglobal_load_lds_dwordx4 %1, off\n\ts_mov_b32 m0, %0" : "=&s"(keep) : "v"(gsrc), "s"(lds_dst) : "memory"); }
#define SB_WAIT_BAR(N) asm volatile("s_waitcnt vmcnt(" #N ") lgkmcnt(0)\n\ts_barrier" ::: "memory")

__device__ __forceinline__ void qkt(f32x16& p0, f32x16& p1, const LAS unsigned char* Kslot, const bf16x8* qr, int r32, int hi) {
    const LAS unsigned char* kb = Kslot + hi * 1024 + r32 * 16;
    p0 = f32x16{}; p1 = f32x16{};
#pragma unroll
    for (int d0 = 0; d0 < 4; ++d0) {
        const bf16x8 b0 = *(const LAS bf16x8*)(kb + d0 * 2048);
        const bf16x8 b1 = *(const LAS bf16x8*)(kb + d0 * 2048 + 512);
        p0 = __builtin_amdgcn_mfma_f32_32x32x16_bf16(b0, qr[d0], p0, 0, 0, 0);
        p1 = __builtin_amdgcn_mfma_f32_32x32x16_bf16(b1, qr[d0], p1, 0, 0, 0);
    }
}
__device__ __forceinline__ void pv(f32x16* o, unsigned vb, bf16x8 pa0, bf16x8 pa1, bf16x8 pa2, bf16x8 pa3) {
#pragma unroll
    for (int d0 = 0; d0 < 2; ++d0) { s16x4 lo[4], hi[4];
#pragma unroll
        for (int ks = 0; ks < 4; ++ks) {
            asm volatile("ds_read_b64_tr_b16 %0,%1 offset:%c2" : "=&v"(lo[ks]) : "v"(vb), "i"(d0 * 4096 + ks * 1024) : "memory");
            asm volatile("ds_read_b64_tr_b16 %0,%1 offset:%c2" : "=&v"(hi[ks]) : "v"(vb), "i"(d0 * 4096 + ks * 1024 + 512) : "memory"); }
        asm volatile("s_waitcnt lgkmcnt(0)" ::: "memory"); __builtin_amdgcn_sched_barrier(0);
#define SB_PK(k) (bf16x8){lo[k][0], lo[k][1], lo[k][2], lo[k][3], hi[k][0], hi[k][1], hi[k][2], hi[k][3]}
        o[d0] = __builtin_amdgcn_mfma_f32_32x32x16_bf16(pa0, SB_PK(0), o[d0], 0, 0, 0);
        o[d0] = __builtin_amdgcn_mfma_f32_32x32x16_bf16(pa1, SB_PK(1), o[d0], 0, 0, 0);
        o[d0] = __builtin_amdgcn_mfma_f32_32x32x16_bf16(pa2, SB_PK(2), o[d0], 0, 0, 0);
        o[d0] = __builtin_amdgcn_mfma_f32_32x32x16_bf16(pa3, SB_PK(3), o[d0], 0, 0, 0);
#undef SB_PK
    }
}
__device__ __forceinline__ unsigned cvtpk(float lo, float hi) { unsigned r; asm("v_cvt_pk_bf16_f32 %0, %1, %2" : "=v"(r) : "v"(lo), "v"(hi)); return r; }

template <bool MASK> __device__ __forceinline__ void sb_weights(f32x16& P0, f32x16& P1, float& Pr, int kvrel0, int hi) {
#pragma unroll
    for (int r = 0; r < 32; ++r) {
        const float z = r < 16 ? P0[r] : P1[r - 16];
        float kp = __builtin_amdgcn_rcpf(1.0f + __builtin_amdgcn_exp2f(z));
        if (MASK) { if (kvrel0 >= -((r & 3) + 8 * ((r & 15) >> 2) + 32 * (r >> 4))) kp = 1.0f; }
        if (r < 16) P0[r] = kp; else P1[r - 16] = kp;
    }
#define SB_KP(r) ((r) < 16 ? P0[(r)] : P1[(r) - 16])
    float gt[8];
#pragma unroll
    for (int g = 0; g < 8; ++g) gt[g] = (SB_KP(4 * g + 3) * SB_KP(4 * g + 2)) * (SB_KP(4 * g + 1) * SB_KP(4 * g));
    float sg[8]; float run = Pr;
#pragma unroll
    for (int g = 7; g >= 0; --g) {
        auto rr = __builtin_amdgcn_permlane32_swap(__float_as_uint(gt[g]), __float_as_uint(gt[g]), false, false);
        const float lo_t = __uint_as_float(rr[0]), up_t = __uint_as_float(rr[1]);
        const float s_up = run;
        const float s_lo = run * up_t;
        run = s_lo * lo_t;
        sg[g] = hi ? s_up : s_lo;
    }
    Pr = run;
#pragma unroll
    for (int g = 0; g < 8; ++g) {
        const float t4 = sg[g], t3 = t4 * SB_KP(4 * g + 3), t2 = t3 * SB_KP(4 * g + 2), t1 = t2 * SB_KP(4 * g + 1), t0 = t1 * SB_KP(4 * g);
        const float w3 = t4 - t3, w2 = t3 - t2, w1 = t2 - t1, w0 = t1 - t0;
        if (g < 4) { P0[4 * g] = w0; P0[4 * g + 1] = w1; P0[4 * g + 2] = w2; P0[4 * g + 3] = w3; } else { P1[4 * g - 16] = w0; P1[4 * g - 15] = w1; P1[4 * g - 14] = w2; P1[4 * g - 13] = w3; }
    }
#undef SB_KP
}

__device__ __forceinline__ void attn_unit(int b, int h, int qb, const bf16* Z, bf16* O, LAS unsigned char* lds, int tid_in) {
    int tid = tid_in; asm volatile("" : "+v"(tid));
    const int lane = tid & 63, r32 = lane & 31, hi = lane >> 5; const int wid = __builtin_amdgcn_readfirstlane(tid >> 6);
    const size_t rowbase = (size_t)b * T; const int q0 = qb * 256;
    const bf16* Qw = Z + (rowbase + q0 + wid * 32) * ZP + ZC_Q + h * 64;
    const bf16* Kh = Z + rowbase * ZP + ZC_K + h * 64; const bf16* Vh = Z + rowbase * ZP + ZC_V + h * 64;
    const unsigned lds0 = (unsigned)(size_t)lds;
    LAS unsigned* CNT = (LAS unsigned*)(lds + LDS_CNT);
    if (tid < 3) CNT[tid] = 0u;
    const bf16* ksrc = Kh + (size_t)lane * ZP + wid * 8;
    const bf16* vsrc = Vh + (size_t)(16 * (wid & 3) + (lane >> 2)) * ZP + (wid >> 2) * 32 + (lane & 3) * 8;
    const unsigned kdst = lds0 + LDS_K + wid * 1024, vdst = lds0 + LDS_V + wid * 1024;
#define SB_DMA_K(j, so) glds16(ksrc + (size_t)(j) * 64 * ZP, (unsigned)__builtin_amdgcn_readfirstlane(kdst + (so)))
#define SB_DMA_V(j, so) glds16(vsrc + (size_t)(j) * 64 * ZP, (unsigned)__builtin_amdgcn_readfirstlane(vdst + (so)))
    const int NT = (q0 + 256) / 128;
#define SB_DMA2(J, so) do { SB_DMA_K(2 * (J) + 1, (so)); SB_DMA_V(2 * (J) + 1, (so)); SB_DMA_K(2 * (J), (so) + 8192); SB_DMA_V(2 * (J), (so) + 8192); } while (0)
    SB_DMA2(NT - 1, 0); if (NT > 1) SB_DMA2(NT - 2, SLOTB);
    bf16x8 qr[4];
#pragma unroll
    for (int d0 = 0; d0 < 4; ++d0) qr[d0] = *(const GAS bf16x8*)(Qw + (size_t)r32 * ZP + d0 * 16 + hi * 8);
    asm volatile("" : "+v"(qr[0]), "+v"(qr[1]), "+v"(qr[2]), "+v"(qr[3]));
    f32x16 o[2]; o[0] = f32x16{}; o[1] = f32x16{};
    float Pr = 1.0f; bool wdone = false;
    const int tq = q0 + wid * 32 + r32, tmin = q0 + wid * 32, tmax = tmin + 31;
    const unsigned vb0 = lds0 + LDS_V + ((lane >> 4) & 1) * 32 + (lane & 3) * 8 + (4 * hi + ((lane & 15) >> 2)) * 64;
    int so_cur = 0, so_n2 = 2 * SLOTB;
    for (int i = 0; i < NT; ++i) {
        const int j = NT - 1 - i;
        if (i + 1 < NT) { SB_WAIT_BAR(4); } else { SB_WAIT_BAR(0); }
        if (i > 0) { const unsigned votes = CNT[(i - 1) % 3]; if (votes == 8u) break; }
        if (tid == 0) CNT[(i + 1) % 3] = 0u;
        if (i + 2 < NT) SB_DMA2(j - 2, so_n2);
#pragma unroll
        for (int sub = 0; sub < 2; ++sub) {
            const int kv0 = 128 * j + 64 * (1 - sub), so_t = so_cur + sub * 8192;
            if (kv0 < tmax && !wdone) {
                f32x16 P0, P1;
                qkt(P0, P1, lds + LDS_K + so_t, qr, r32, hi);
                if (kv0 + 63 >= tmin) sb_weights<true>(P0, P1, Pr, kv0 - tq + 4 * hi, hi); else sb_weights<false>(P0, P1, Pr, 0, hi);
                v4u pw0, pw1, pw2, pw3;
                pw0.x = cvtpk(P0[0], P0[1]); pw0.y = cvtpk(P0[2], P0[3]); pw0.z = cvtpk(P0[4], P0[5]); pw0.w = cvtpk(P0[6], P0[7]);
                pw1.x = cvtpk(P0[8], P0[9]); pw1.y = cvtpk(P0[10], P0[11]); pw1.z = cvtpk(P0[12], P0[13]); pw1.w = cvtpk(P0[14], P0[15]);
                pw2.x = cvtpk(P1[0], P1[1]); pw2.y = cvtpk(P1[2], P1[3]); pw2.z = cvtpk(P1[4], P1[5]); pw2.w = cvtpk(P1[6], P1[7]);
                pw3.x = cvtpk(P1[8], P1[9]); pw3.y = cvtpk(P1[10], P1[11]); pw3.z = cvtpk(P1[12], P1[13]); pw3.w = cvtpk(P1[14], P1[15]);
                pv(o, vb0 + so_t, __builtin_bit_cast(bf16x8, pw0), __builtin_bit_cast(bf16x8, pw1), __builtin_bit_cast(bf16x8, pw2), __builtin_bit_cast(bf16x8, pw3));
                wdone = __all(Pr == 0.0f);
            }
        }
        if (wdone && lane == 0) __hip_atomic_fetch_add(CNT + (i % 3), 1u, __ATOMIC_RELAXED, __HIP_MEMORY_SCOPE_WORKGROUP);
        so_cur = (so_cur == 2 * SLOTB) ? 0 : so_cur + SLOTB; so_n2 = (so_n2 == 2 * SLOTB) ? 0 : so_n2 + SLOTB;
    }
    asm volatile("s_waitcnt vmcnt(0)" ::: "memory");
    { LAS bf16* stg = (LAS bf16*)(lds + LDS_OST) + wid * 2048;
#pragma unroll
      for (int r = 0; r < 16; ++r) { const int orow = crow(r, hi);
#pragma unroll
          for (int d0 = 0; d0 < 2; ++d0) stg[orow * 64 + d0 * 32 + r32] = (bf16)f2bf(o[d0][r]); }
      asm volatile("s_waitcnt lgkmcnt(0)" ::: "memory");
      bf16* Ow = O + (rowbase + q0 + wid * 32) * D + h * 64;
#pragma unroll
      for (int i = 0; i < 4; ++i) { const int row = i * 8 + (lane >> 3), ch = lane & 7; const v4u v = *(const LAS v4u*)(stg + row * 64 + ch * 8); *(GAS v4u*)(Ow + (size_t)row * D + ch * 8) = v; } }
    asm volatile("s_waitcnt lgkmcnt(0)\n\ts_barrier" ::: "memory");
#undef SB_DMA2
#undef SB_DMA_K
#undef SB_DMA_V
}
__device__ __forceinline__ void attn_phase(const bf16* Z, bf16* O, LAS unsigned char* lds, int tid, int G) {
    for (int bh = blockIdx.x; bh < BATCH * 16; bh += G)
        for (int qb = 7; qb >= 0; --qb) attn_unit(bh >> 4, bh & 15, qb, Z, O, lds, tid);
}
}
namespace sg {
using f32x16 = __attribute__((ext_vector_type(16))) float;
using s16x4 = __attribute__((ext_vector_type(4))) short;
typedef unsigned u32x2 __attribute__((ext_vector_type(2)));
constexpr int XS_STRIDE = 576, WS_STRIDE = 272, PT_STRIDE = 36  ;
static_assert(8 * 64 * PT_STRIDE * 4 <= 128 * XS_STRIDE, "patches fit the X image");
constexpr int L_XS = 0, L_WS = 128 * XS_STRIDE, L_STAT = L_WS + 128 * WS_STRIDE, L_BS = L_STAT + 1024;
#define SG_BAR() asm volatile("s_waitcnt lgkmcnt(0)\n\ts_barrier" ::: "memory")
__device__ __forceinline__ int crow(int r, int hi) { return (r & 3) + 8 * (r >> 2) + 4 * hi; }

__device__ __forceinline__ void sgu_phase(const float* ln_g, const float* ln_b, const float* w_s, const float* b_s, const bf16* ZC, bf16* O, LAS unsigned char* lds, int tid_in, int G) {
    LAS float* STAT = (LAS float*)(lds + L_STAT); LAS float* BS = (LAS float*)(lds + L_BS);
    for (int bn = blockIdx.x; bn < BATCH * 16; bn += G) {
        int tid = tid_in; asm volatile("" : "+v"(tid));
        const int lane = tid & 63, wave = __builtin_amdgcn_readfirstlane(tid >> 6), r32 = lane & 31, hi = lane >> 5;
        const size_t rowbase = (size_t)bn * 128;
#pragma unroll 4
        for (int rr = 0; rr < 16; ++rr) {
            const int row = 16 * wave + rr;
            const GAS v4u* vr = (const GAS v4u*)(ZC + (rowbase + row) * 4096 + 2048) + lane;
            float x[32]; float s = 0.f;
#pragma unroll
            for (int j = 0; j < 4; ++j) { const v4u w = vr[64 * j];
                x[8 * j + 0] = bflo(w.x); x[8 * j + 1] = bfhi(w.x); x[8 * j + 2] = bflo(w.y); x[8 * j + 3] = bfhi(w.y); x[8 * j + 4] = bflo(w.z); x[8 * j + 5] = bfhi(w.z); x[8 * j + 6] = bflo(w.w); x[8 * j + 7] = bfhi(w.w); }
#pragma unroll
            for (int j = 0; j < 32; ++j) s += x[j];
            const float mean = wave_sum(s) * (1.f / 2048.f); float q = 0.f;
#pragma unroll
            for (int j = 0; j < 32; ++j) { const float d = x[j] - mean; q += d * d; }
            const float rstd = 1.0f / sqrtf(wave_sum(q) * (1.f / 2048.f) + 1e-5f);
            if (lane == 0) { STAT[2 * row] = mean; STAT[2 * row + 1] = rstd; }
        }
        SG_BAR();
        const int cc = tid & 31;
        v4u xv[8];
#define SG_FETCH(gg) do { unsigned vo_ = (unsigned)(((tid >> 5) * 4096 + 8 * cc) * 2); asm volatile("" : "+v"(vo_));     \
            const GAS unsigned char* zb_ = (const GAS unsigned char*)(ZC + rowbase * 4096 + 2048 + 256 * (gg)); \
            _Pragma("unroll") for (int i = 0; i < 8; ++i) xv[i] = *(const GAS v4u*)(zb_ + (size_t)i * (16 * 4096 * 2) + vo_); } while (0)
        SG_FETCH(0);
#pragma unroll 1
        for (int g = 0; g < 8; ++g) {
            f32x4 wv[8];
#pragma unroll
            for (int i = 0; i < 8; ++i) { const int id = tid + 512 * i, s = id >> 5; wv[i] = *(const GAS f32x4*)(w_s + ((size_t)g * 128 + s) * 128 + 4 * cc); }
            const f32x4 lg0 = *(const GAS f32x4*)(ln_g + 256 * g + 8 * cc), lg1 = *(const GAS f32x4*)(ln_g + 256 * g + 8 * cc + 4);
            const f32x4 lb0 = *(const GAS f32x4*)(ln_b + 256 * g + 8 * cc), lb1 = *(const GAS f32x4*)(ln_b + 256 * g + 8 * cc + 4);
            if (tid < 128) BS[tid] = b_s[g * 128 + tid];
#pragma unroll
            for (int i = 0; i < 8; ++i) { const int id = tid + 512 * i, s = id >> 5;
                const float mean = STAT[2 * s], rstd = STAT[2 * s + 1];
                const v4u w = xv[i];
                const f32x4 a0 = ((f32x4){bflo(w.x), bfhi(w.x), bflo(w.y), bfhi(w.y)} - mean) * rstd * lg0 + lb0;
                const f32x4 a1 = ((f32x4){bflo(w.z), bfhi(w.z), bflo(w.w), bfhi(w.w)} - mean) * rstd * lg1 + lb1;
                v4u o; o.x = pk2(a0.x, a0.y); o.y = pk2(a0.z, a0.w); o.z = pk2(a1.x, a1.y); o.w = pk2(a1.z, a1.w);
                *(LAS v4u*)(lds + L_XS + s * XS_STRIDE + cc * 16) = o;
                u32x2 p; p.x = pk2(wv[i].x, wv[i].y); p.y = pk2(wv[i].z, wv[i].w);
                *(LAS u32x2*)(lds + L_WS + s * WS_STRIDE + cc * 8) = p; }
            SG_BAR();
            if (g < 7) SG_FETCH(g + 1);
            f32x16 acc[4];
#pragma unroll
            for (int tt = 0; tt < 4; ++tt) acc[tt] = f32x16{};
            const unsigned xb = (unsigned)(size_t)(lds + L_XS) + (8 * hi + ((lane & 15) >> 2)) * XS_STRIDE + (32 * wave + 16 * ((lane >> 4) & 1) + 4 * (lane & 3)) * 2;
            const unsigned xb4 = xb + 4 * XS_STRIDE;
            const LAS unsigned char* wb = lds + L_WS + r32 * WS_STRIDE + 16 * hi;
#pragma unroll
            for (int ks = 0; ks < 8; ++ks) {
                s16x4 lo, up;
                asm volatile("ds_read_b64_tr_b16 %0,%1 offset:%c2" : "=&v"(lo) : "v"(xb), "i"(ks * 16 * XS_STRIDE) : "memory");
                asm volatile("ds_read_b64_tr_b16 %0,%1 offset:%c2" : "=&v"(up) : "v"(xb4), "i"(ks * 16 * XS_STRIDE) : "memory");
                bf16x8 af[4];
#pragma unroll
                for (int tt = 0; tt < 4; ++tt) if (tt >= 2 || ks < 4) af[tt] = *(const LAS bf16x8*)(wb + tt * 32 * WS_STRIDE + ks * 32);
                asm volatile("s_waitcnt lgkmcnt(0)" ::: "memory"); __builtin_amdgcn_sched_barrier(0);
                const bf16x8 bfr = (bf16x8){lo[0], lo[1], lo[2], lo[3], up[0], up[1], up[2], up[3]};
#pragma unroll
                for (int tt = 0; tt < 4; ++tt) if (tt >= 2 || ks < 4) acc[tt] = __builtin_amdgcn_mfma_f32_32x32x16_bf16(af[tt], bfr, acc[tt], 0, 0, 0);
            }
            const size_t ccol = (size_t)(256 * g + 32 * wave + 8 * (lane & 3));
            v4u uq[4];
#pragma unroll
            for (int j = 0; j < 4; ++j) uq[j] = *(const GAS v4u*)(ZC + (rowbase + 16 * j + (lane >> 2)) * 4096 + ccol);
            SG_BAR();
            LAS float* PT = (LAS float*)(lds + L_XS + wave * (64 * PT_STRIDE * 4));
#pragma unroll
            for (int half = 0; half < 2; ++half) {
#pragma unroll
                for (int t2 = 0; t2 < 2; ++t2)
#pragma unroll
                    for (int r = 0; r < 16; ++r) { const int tl = 32 * t2 + crow(r, hi); PT[tl * PT_STRIDE + r32] = acc[2 * half + t2][r] + BS[64 * half + tl]; }
                asm volatile("s_waitcnt lgkmcnt(0)" ::: "memory");
                v4u un[4];
                if (half == 0) {
#pragma unroll
                    for (int j = 0; j < 4; ++j) un[j] = *(const GAS v4u*)(ZC + (rowbase + 64 + 16 * j + (lane >> 2)) * 4096 + ccol); }
#pragma unroll
                for (int j = 0; j < 4; ++j) { const int tl = 16 * j + (lane >> 2);
                    const f32x4 m0 = *(const LAS f32x4*)(PT + tl * PT_STRIDE + 8 * (lane & 3)), m1 = *(const LAS f32x4*)(PT + tl * PT_STRIDE + 8 * (lane & 3) + 4);
                    const v4u w = uq[j];
                    v4u o; o.x = pk2(m0.x * bflo(w.x), m0.y * bfhi(w.x)); o.y = pk2(m0.z * bflo(w.y), m0.w * bfhi(w.y)); o.z = pk2(m1.x * bflo(w.z), m1.y * bfhi(w.z)); o.w = pk2(m1.z * bflo(w.w), m1.w * bfhi(w.w));
                    *(GAS v4u*)(O + (rowbase + 64 * half + tl) * D + ccol) = o; }
                if (half == 0) {
#pragma unroll
                    for (int j = 0; j < 4; ++j) uq[j] = un[j]; }
                asm volatile("s_waitcnt lgkmcnt(0)" ::: "memory");
            }
            SG_BAR();
        }
    }
}
}
#define AS4 __attribute__((address_space(4)))
__device__ __forceinline__ const AS4 unsigned char* kargs() { const AS4 unsigned char* kp = (const AS4 unsigned char*)__builtin_amdgcn_kernarg_segment_ptr(); asm volatile("" : "+s"(kp)); return kp; }
__device__ __forceinline__ const float* arg_in(int k) { return *(const float* const AS4*)(kargs() + 8 * k); }
__device__ __forceinline__ float* arg_out() { return *(float* const AS4*)(kargs() + 200); }
__device__ __forceinline__ unsigned char* arg_ws() { return *(unsigned char* const AS4*)(kargs() + 208); }
static_assert(sizeof(Args) == 224, "Args layout: in[25] | out | ws | ph_lo | ph_hi");
#ifndef MK_ONE_LAUNCH
#define MK_ONE_LAUNCH 1
#endif
#ifndef MK_PROBE_DUP
#define MK_PROBE_DUP 0
#endif
#define DUP(k) for (int rep_ = 0; rep_ < 1 + ((MK_PROBE_DUP >> (k)) & 1); ++rep_)
__global__ void __launch_bounds__(NWAVES * 64, 2) fwd(Args a) {
    extern __shared__ __attribute__((aligned(16))) unsigned char lds_raw[];
    LAS unsigned char* lds = (LAS unsigned char*)lds_raw;
    const int wave = __builtin_amdgcn_readfirstlane((int)threadIdx.x >> 6), G = gridDim.x;
    for (int u = threadIdx.x; u < (LDS_BYTES - LDSCTL_OFF) / 4; u += NWAVES * 64) ((LAS unsigned*)(lds + LDSCTL_OFF))[u] = 0u;
    __syncthreads();
    XcdBarrier bar; bar.bar = (unsigned*)(arg_ws() + WS_CTL) + CW_BAR; bar.x = 0; bar.st = nullptr;
    if (MK_ONE_LAUNCH) bar = xcd_barrier_post((unsigned*)(arg_ws() + WS_CTL) + CW_BAR, (volatile LAS unsigned*)(lds + MISC_OFF) + 8);
    const int lo = a.ph_lo, hi = a.ph_hi;
#define IN(k) (lo <= (k) && (k) < hi)
#define SEAM(k) do { if (MK_ONE_LAUNCH && IN(k) && IN((k) + 1)) xcd_barrier(bar); } while (0)
#pragma unroll 1
    for (int L = 0; L < DEPTH; ++L) {
        const int pb = 8 * L, i = L >> 1; const bool even = !(L & 1);
#define FRESH_TID() int lane; asm volatile("v_mbcnt_lo_u32_b32 %0, -1, 0\n\tv_mbcnt_hi_u32_b32 %0, -1, %0" : "=v"(lane)); const int tid = wave * 64 + lane; (void)tid
        unsigned char* const ws = arg_ws();
        bf16* const H = (bf16*)(ws + WS_H); bf16* const BIG = (bf16*)(ws + WS_BIG);
        if (IN(pb + 0)) { FRESH_TID();
            const float* Win; const float* Wout; int Nin;
            if (even) { Win = arg_in(4) + (size_t)i * D * EVEN_N; Wout = arg_in(16) + (size_t)i * D * D; Nin = EVEN_N; } else { Win = arg_in(17) + (size_t)i * D * 4096; Wout = arg_in(22) + (size_t)i * D * D; Nin = 4096; }
            const float* x0 = nullptr; if (L == 0) x0 = arg_in(0);
            DUP(0) prep_phase(Win, Nin, Wout, arg_in(23) + (size_t)L * D * FF, arg_in(24) + (size_t)L * FF * D, x0, arg_in(1) + (size_t)L * D, arg_in(2) + (size_t)L * D, ws, even, lds, wave, lane, tid, G); SEAM(pb + 0); }
        if (IN(pb + 1)) { FRESH_TID();
            bf16* const WA = (bf16*)(ws + WS_WA);
            bf16* const XB = (bf16*)(ws + WS_XB); const float* const SSQ = (const float*)(ws + WS_SSQ);
            if (even) { pg8::Gemm g{XB, WA, M, ZP, D}; pg8::StaticOrder S; S.init(M, ZP, G, (int)blockIdx.x, 8); const int pm0 = pg8::rs_table(SSQ, S, lds, tid); pg8::EpiActS<0> E{BIG, ZP, 4, sb::QSCALE, (const LAS float*)(lds + pg8::LX_RS), pm0};
                DUP(5) pg8::gemm_phase<pg8::EpiActS<0>, pg8::StaticOrder, true, true>(lds, g, S, E, tid); }
            else { pg8::Gemm g{XB, WA, M, 4096, D}; pg8::StaticOrder S; S.init(M, 4096, G, (int)blockIdx.x, 8); const int pm0 = pg8::rs_table(SSQ, S, lds, tid); pg8::EpiActS<1> E{BIG, 4096, 0, 1.f, (const LAS float*)(lds + pg8::LX_RS), pm0};
                DUP(5) pg8::gemm_phase<pg8::EpiActS<1>, pg8::StaticOrder, true, true>(lds, g, S, E, tid); }
            SEAM(pb + 1);
        }
        if (IN(pb + 2)) { FRESH_TID();
            if (even) { DUP(1) sb::attn_phase(BIG, H, lds, tid, G); }
            else DUP(3) sg::sgu_phase(arg_in(18) + (size_t)i * 2048, arg_in(19) + (size_t)i * 2048, arg_in(20) + (size_t)i * 131072, arg_in(21) + (size_t)i * 1024, BIG, H, lds, tid, G);
        }
        if (IN(pb + 3)) { FRESH_TID();
            if (even) { const rw::Params q{arg_in(5) + (size_t)i * RWS, arg_in(6) + (size_t)i * 65536, arg_in(7) + (size_t)i * 1024, arg_in(8) + (size_t)i * 65536, arg_in(9) + (size_t)i * 1024, arg_in(10) + (size_t)i * 163840,
                    arg_in(11) + (size_t)i * 1024, arg_in(12) + (size_t)i * 1024, arg_in(13) + (size_t)i * 1024, arg_in(14) + (size_t)i * 1024, arg_in(15) + (size_t)i * 1024};
                DUP(2) rw12::rwkv_phase(q, BIG, H, lds, tid, (int)blockIdx.x, G); }
            SEAM(pb + 3); }
        if (IN(pb + 4)) { FRESH_TID(); pg8::Gemm g{H, (bf16*)(ws + WS_WB), M, D, D}; pg8::StaticOrder S; S.init(M, D, G, (int)blockIdx.x); pg8::EpiResidB E{(bf16*)(ws + WS_XB), (float*)(ws + WS_SSQ), D, lds};
            pg8::gemm_phase<pg8::EpiResidB, pg8::StaticOrder, true, true>(lds, g, S, E, tid); SEAM(pb + 4); }
        if (IN(pb + 6)) { FRESH_TID(); pg8::Gemm g{(bf16*)(ws + WS_XB), (bf16*)(ws + WS_W1), M, FF, D}; pg8::StaticOrder S; S.init(M, FF, G, (int)blockIdx.x, 8); const int pm0 = pg8::rs_table((const float*)(ws + WS_SSQ), S, lds, tid); pg8::EpiActS<2> E{BIG, FF, 0, 1.f, (const LAS float*)(lds + pg8::LX_RS), pm0};
            DUP(6) pg8::gemm_phase<pg8::EpiActS<2>, pg8::StaticOrder, true, true>(lds, g, S, E, tid); SEAM(pb + 6); }
        if (IN(pb + 7)) { FRESH_TID(); pg8::Gemm g{BIG, (bf16*)(ws + WS_W2), M, D, FF}; pg8::StaticOrder S; S.init(M, D, G, (int)blockIdx.x); pg8::EpiResidB E{(bf16*)(ws + WS_XB), (float*)(ws + WS_SSQ), D, lds};
            pg8::gemm_phase<pg8::EpiResidB, pg8::StaticOrder, true, true>(lds, g, S, E, tid); SEAM(pb + 7); }
    }
    if (IN(32)) { const int gw = blockIdx.x * NWAVES + wave, NGW = G * NWAVES; int lane; asm volatile("v_mbcnt_lo_u32_b32 %0, -1, 0\n\tv_mbcnt_hi_u32_b32 %0, -1, %0" : "=v"(lane)); float* const xo = arg_out(); const float* gf = arg_in(3); const bf16* const XB = (const bf16*)(arg_ws() + WS_XB);
        for (int m = gw; m < M; m += NGW) rms_row_out(XB + (size_t)m * D, gf, xo + (size_t)m * D, lane); }
#undef IN
#undef SEAM
}

extern "C" void kernel_launch(void* const* d_in, const int* in_sizes, int n_in, void* d_out, int out_size, void* d_ws, size_t ws_size, hipStream_t stream) {
    static int grid = 0;
    if (grid == 0) {
        if (n_in != 25 || out_size != M * D || ws_size < WS_END) { fprintf(stderr, "kernel_launch: unexpected shapes (n_in %d, out %d, ws %zu)\n", n_in, out_size, ws_size); grid = -1; return; }
        int dev = 0, cus = 0, per_cu = 0;
        if (hipGetDevice(&dev) != hipSuccess || hipDeviceGetAttribute(&cus, hipDeviceAttributeMultiprocessorCount, dev) != hipSuccess) { grid = -1; return; }
        if (hipFuncSetAttribute((const void*)fwd, hipFuncAttributeMaxDynamicSharedMemorySize, LDS_BYTES) != hipSuccess) { fprintf(stderr, "kernel_launch: hipFuncSetAttribute failed\n"); grid = -1; return; }
        if (hipOccupancyMaxActiveBlocksPerMultiprocessor(&per_cu, (const void*)fwd, NWAVES * 64, LDS_BYTES) != hipSuccess || per_cu < 1) fprintf(stderr, "kernel_launch: occupancy query reports %d\n", per_cu);
        (void)hipGetLastError();
        grid = cus;
    }
    if (grid < 0) return;
    (void)hipMemsetAsync((char*)d_ws + WS_CTL, 0, CTL_ZERO_BYTES, stream);
    Args a{};
    for (int i = 0; i < 25; ++i) a.in[i] = (const float*)d_in[i];
    a.out = (float*)d_out; a.ws = (unsigned char*)d_ws;
#if MK_ONE_LAUNCH
    a.ph_lo = 0; a.ph_hi = NPH;
    hipLaunchKernelGGL(fwd, dim3(grid), dim3(NWAVES * 64), LDS_BYTES, stream, a);
#else
    for (int p = 0; p < NPH; ++p) { a.ph_lo = p; a.ph_hi = p + 1;
        hipLaunchKernelGGL(fwd, dim3(grid), dim3(NWAVES * 64), LDS_BYTES, stream, a); }
#endif
}
```
